# Optimizing an MI355X kernel written in HIP

```python
import math
import jax, jax.numpy as jnp
from jax import lax
import numpy as np

D_MODEL = 2048
BATCH = 2
SEQ = 4096
DEPTH = 1
DEC_BATCH = 8
DEC_SEQ = 4
PAST_LEN = 16384
PAGE_SIZE = 128

N_META = 16
POOL_WIDTH = D_MODEL // 2
POOL_WINDOWS = (2, 4, 8, 16)
N_POOL_GROUPS = len(POOL_WINDOWS)
POOL_GROUP_DIM = POOL_WIDTH // N_POOL_GROUPS
POOL_BUF = max(POOL_WINDOWS) - 1
ATTN_WIDTH = D_MODEL - POOL_WIDTH
N_HEADS = 8
HEAD_DIM = ATTN_WIDTH // N_HEADS
QK_HALF = HEAD_DIM // 2
D_FF = ((8 * D_MODEL // 3 + 255) // 256) * 256
Q_BLOCK = 128
EPS = 1e-6
NEG_INF = -1e30

kernel_name = 'hymba_pool_diffattn_macaron_step'


def rmsnorm(x, g):
    xf = x.astype(jnp.float32)
    y = xf * lax.rsqrt(jnp.mean(xf * xf, axis=-1, keepdims=True) + EPS)
    return (y * g.astype(jnp.float32)).astype(x.dtype)


def swiglu_half(x, g, w_gate, w_up, w_down):
    h = rmsnorm(x, g)
    return x + 0.5 * ((jax.nn.silu(h @ w_gate) * (h @ w_up)) @ w_down)


def alibi_slopes():
    return jnp.asarray(2.0 ** (-8.0 * np.arange(1, N_HEADS + 1) / N_HEADS), dtype=jnp.float32)


def multiscale_pool(p, buf, pos0, w_pool, pool_scale):
    B, T, _ = p.shape
    xp = jnp.concatenate([buf.astype(p.dtype), p], axis=1)
    cs = jnp.cumsum(xp.astype(jnp.float32), axis=1)
    cs = jnp.concatenate([jnp.zeros((B, 1, POOL_WIDTH), jnp.float32), cs], axis=1)
    cs = cs.reshape(B, POOL_BUF + T + 1, N_POOL_GROUPS, POOL_GROUP_DIM)
    end = cs[:, POOL_BUF + 1:]
    start = jnp.stack([cs[:, POOL_BUF + 1 - w:POOL_BUF + 1 - w + T, gi]
                       for gi, w in enumerate(POOL_WINDOWS)], axis=2)
    pos = pos0 + jnp.arange(T)
    win = jnp.asarray(POOL_WINDOWS, jnp.float32)
    count = jnp.minimum((pos + 1).astype(jnp.float32)[:, None], win[None, :])
    feat = (end - start) / count[None, :, :, None] - p.astype(jnp.float32).reshape(B, T, N_POOL_GROUPS, POOL_GROUP_DIM)
    out = jnp.einsum('btgc,gcd->btgd', feat.astype(p.dtype), w_pool).reshape(B, T, POOL_WIDTH) * pool_scale
    return out.astype(p.dtype), xp[:, -POOL_BUF:]


def diff_attention(q, k, v, q_pos, k_pos, lam, lam_init, subln_gain):
    scale = QK_HALF ** -0.5
    s1 = jnp.einsum('bqhd,bkhd->bhqk', q[..., :QK_HALF], k[..., :QK_HALF]).astype(jnp.float32) * scale
    s2 = jnp.einsum('bqhd,bkhd->bhqk', q[..., QK_HALF:], k[..., QK_HALF:]).astype(jnp.float32) * scale
    dist = q_pos[:, None] - k_pos[None, :]
    bias = -alibi_slopes()[:, None, None] * dist.astype(jnp.float32)[None]
    mask = (dist >= 0)[None, None]
    a1 = jax.nn.softmax(jnp.where(mask, s1 + bias, NEG_INF), axis=-1)
    a2 = jax.nn.softmax(jnp.where(mask, s2 + bias, NEG_INF), axis=-1)
    o = jnp.einsum('bhqk,bkhd->bqhd', a1 - lam * a2, v.astype(jnp.float32))
    o = rmsnorm(o, subln_gain) * (1.0 - lam_init)
    return o.astype(q.dtype)


def token_mixer(h, pos0, pool_buf, past_k, past_v, lam_init, w_in, w_pool, pool_scale,
                lambda_q1, lambda_k1, lambda_q2, lambda_k2, subln_gain, w_out):
    B, T, _ = h.shape
    proj = h @ w_in
    p = proj[..., :POOL_WIDTH]
    q = proj[..., POOL_WIDTH:POOL_WIDTH + ATTN_WIDTH].reshape(B, T, N_HEADS, HEAD_DIM)
    k = proj[..., POOL_WIDTH + ATTN_WIDTH:POOL_WIDTH + 2 * ATTN_WIDTH].reshape(B, T, N_HEADS, HEAD_DIM)
    v = proj[..., POOL_WIDTH + 2 * ATTN_WIDTH:].reshape(B, T, N_HEADS, HEAD_DIM)
    pool_out, new_buf = multiscale_pool(p, pool_buf, pos0, w_pool, pool_scale)
    if past_k is None:
        keys, values = k, v
    else:
        keys = jnp.concatenate([past_k.astype(k.dtype), k], axis=1)
        values = jnp.concatenate([past_v.astype(v.dtype), v], axis=1)
    k_pos = jnp.arange(keys.shape[1])
    lam = (jnp.exp(jnp.sum(lambda_q1.astype(jnp.float32) * lambda_k1.astype(jnp.float32)))
           - jnp.exp(jnp.sum(lambda_q2.astype(jnp.float32) * lambda_k2.astype(jnp.float32))) + lam_init)
    qblk = min(Q_BLOCK, T)
    n_blk = -(-T // qblk)
    pad = n_blk * qblk - T
    qb = jnp.pad(q, ((0, 0), (0, pad), (0, 0), (0, 0))).reshape(B, n_blk, qblk, N_HEADS, HEAD_DIM).transpose(1, 0, 2, 3, 4)
    posb = (pos0 + jnp.arange(n_blk * qblk)).reshape(n_blk, qblk)

    def attend(args):
        q_blk, q_pos = args
        return diff_attention(q_blk, keys, values, q_pos, k_pos, lam, lam_init, subln_gain)

    ob = lax.map(attend, (qb, posb))
    o = ob.transpose(1, 0, 2, 3, 4).reshape(B, n_blk * qblk, ATTN_WIDTH)[:, :T]
    mixed = jnp.concatenate([pool_out, o.astype(h.dtype)], axis=-1) @ w_out
    return mixed, k, v, new_buf


def decoder_layer(x, pos0, pool_buf, past_k, past_v, lam_init,
                  norm_ffn1, w_gate1, w_up1, w_down1, norm_mix, w_in, w_pool, pool_scale,
                  lambda_q1, lambda_k1, lambda_q2, lambda_k2, subln_gain, w_out,
                  norm_ffn2, w_gate2, w_up2, w_down2):
    x = swiglu_half(x, norm_ffn1, w_gate1, w_up1, w_down1)
    mixed, k_new, v_new, new_buf = token_mixer(rmsnorm(x, norm_mix), pos0, pool_buf, past_k, past_v, lam_init,
                                               w_in, w_pool, pool_scale, lambda_q1, lambda_k1, lambda_q2,
                                               lambda_k2, subln_gain, w_out)
    x = x + mixed
    x = swiglu_half(x, norm_ffn2, w_gate2, w_up2, w_down2)
    return x, k_new, v_new, new_buf


def setup_inputs(seed: int = 0) -> dict:
    key = jax.random.key(seed)
    ks = jax.random.split(key, 32)
    f32 = jnp.float32

    def nrm(k, shape, scale):
        return jax.random.normal(k, shape, f32) * scale

    n_pages = PAST_LEN // PAGE_SIZE
    n_used = DEC_BATCH * n_pages
    n_pool = n_used + max(1, n_used // 4)
    page_table = jax.random.permutation(ks[0], n_pool)[:n_used].reshape(DEC_BATCH, n_pages).astype(jnp.int32)
    return {
        'x_prompt': nrm(ks[1], (BATCH, SEQ, D_MODEL), 1.0),
        'x_sample': nrm(ks[2], (DEC_BATCH, DEC_SEQ, D_MODEL), 1.0),
        'cache_k': nrm(ks[3], (DEPTH, n_pool, PAGE_SIZE, N_HEADS, HEAD_DIM), 1.0),
        'cache_v': nrm(ks[4], (DEPTH, n_pool, PAGE_SIZE, N_HEADS, HEAD_DIM), 1.0),
        'state_pool': nrm(ks[5], (DEPTH, DEC_BATCH, POOL_BUF, POOL_WIDTH), 1.0),
        'page_table': page_table,
        'meta_tokens': nrm(ks[6], (N_META, D_MODEL), 1.0),
        'norm_ffn1': 1.0 + nrm(ks[7], (DEPTH, D_MODEL), 0.02),
        'w_gate1': nrm(ks[8], (DEPTH, D_MODEL, D_FF), D_MODEL ** -0.5),
        'w_up1': nrm(ks[9], (DEPTH, D_MODEL, D_FF), D_MODEL ** -0.5),
        'w_down1': nrm(ks[10], (DEPTH, D_FF, D_MODEL), D_FF ** -0.5),
        'norm_mix': 1.0 + nrm(ks[11], (DEPTH, D_MODEL), 0.02),
        'w_in': nrm(ks[12], (DEPTH, D_MODEL, POOL_WIDTH + 3 * ATTN_WIDTH), D_MODEL ** -0.5),
        'w_pool': nrm(ks[13], (DEPTH, N_POOL_GROUPS, POOL_GROUP_DIM, POOL_GROUP_DIM), POOL_GROUP_DIM ** -0.5),
        'pool_scale': 1.0 + nrm(ks[14], (DEPTH, POOL_WIDTH), 0.02),
        'lambda_q1': nrm(ks[15], (DEPTH, QK_HALF), 0.1),
        'lambda_k1': nrm(ks[16], (DEPTH, QK_HALF), 0.1),
        'lambda_q2': nrm(ks[17], (DEPTH, QK_HALF), 0.1),
        'lambda_k2': nrm(ks[18], (DEPTH, QK_HALF), 0.1),
        'subln_gain': 1.0 + nrm(ks[19], (DEPTH, HEAD_DIM), 0.02),
        'w_out': nrm(ks[20], (DEPTH, POOL_WIDTH + ATTN_WIDTH, D_MODEL), (POOL_WIDTH + ATTN_WIDTH) ** -0.5),
        'norm_ffn2': 1.0 + nrm(ks[21], (DEPTH, D_MODEL), 0.02),
        'w_gate2': nrm(ks[22], (DEPTH, D_MODEL, D_FF), D_MODEL ** -0.5),
        'w_up2': nrm(ks[23], (DEPTH, D_MODEL, D_FF), D_MODEL ** -0.5),
        'w_down2': nrm(ks[24], (DEPTH, D_FF, D_MODEL), D_FF ** -0.5),
        'norm_final': 1.0 + nrm(ks[25], (D_MODEL,), 0.02),
    }


def reference(x_prompt, x_sample, cache_k, cache_v, state_pool, page_table, meta_tokens,
              norm_ffn1, w_gate1, w_up1, w_down1, norm_mix, w_in, w_pool, pool_scale,
              lambda_q1, lambda_k1, lambda_q2, lambda_k2, subln_gain, w_out,
              norm_ffn2, w_gate2, w_up2, w_down2, norm_final):
    b_prompt = x_prompt.shape[0]
    b_sample, n_pages = page_table.shape
    xp = jnp.concatenate([jnp.broadcast_to(meta_tokens.astype(x_prompt.dtype)[None], (b_prompt, N_META, D_MODEL)),
                          x_prompt], axis=1)
    xs = x_sample
    kp_l, vp_l, bp_l, ks_l, vs_l, bs_l = [], [], [], [], [], []
    for i in range(DEPTH):
        lam_init = 0.8 - 0.6 * math.exp(-0.3 * i)
        lw = (norm_ffn1[i], w_gate1[i], w_up1[i], w_down1[i], norm_mix[i], w_in[i], w_pool[i], pool_scale[i],
              lambda_q1[i], lambda_k1[i], lambda_q2[i], lambda_k2[i], subln_gain[i], w_out[i],
              norm_ffn2[i], w_gate2[i], w_up2[i], w_down2[i])
        zero_buf = jnp.zeros((b_prompt, POOL_BUF, POOL_WIDTH), xp.dtype)
        xp, kp, vp, bp = decoder_layer(xp, 0, zero_buf, None, None, lam_init, *lw)
        past_k = cache_k[i, page_table].reshape(b_sample, n_pages * PAGE_SIZE, N_HEADS, HEAD_DIM)
        past_v = cache_v[i, page_table].reshape(b_sample, n_pages * PAGE_SIZE, N_HEADS, HEAD_DIM)
        xs, kn, vn, bn = decoder_layer(xs, PAST_LEN, state_pool[i], past_k, past_v, lam_init, *lw)
        kp_l.append(kp); vp_l.append(vp); bp_l.append(bp)
        ks_l.append(kn); vs_l.append(vn); bs_l.append(bn)
    y_prompt = rmsnorm(xp[:, N_META:], norm_final)
    y_sample = rmsnorm(xs, norm_final)
    k_prompt = jnp.stack(kp_l)
    v_prompt = jnp.stack(vp_l)
    pool_prompt = jnp.stack(bp_l)
    k_sample = jnp.stack(ks_l)
    v_sample = jnp.stack(vs_l)
    pool_sample = jnp.stack(bs_l)
    return (y_prompt, y_sample, k_prompt, v_prompt, pool_prompt, k_sample, v_sample, pool_sample)
```

```cpp
#include <hip/hip_runtime.h>
#include <cstdio>
#include <cstdint>
#define MK_N_LAUNCHES 1
#define MK_FAST_GEMM 1
#define MK_FAST_ATTN 1
namespace pg8 {
#define PG8_LAS __attribute__((address_space(3)))
typedef unsigned short bf16_t;
typedef short bf16x8 __attribute__((ext_vector_type(8)));
typedef float f32x4 __attribute__((ext_vector_type(4)));
typedef unsigned u32x4 __attribute__((ext_vector_type(4)));
constexpr int BM = 256, BK = 64, HALF = 128, HTB = HALF * BK * 2  , STAGE_BYTES = 8 * HTB, NXCD = 8, WGM = 8;

__host__ __device__ __forceinline__ int lds_byte(int r, int c) { const int st = (r >> 4) * 2 + (c >> 5), rr = r & 15, cc = c & 31, ob = rr * 64 + cc * 2; return st * 1024 + (ob ^ (((ob >> 9) & 1) << 5)); }
__host__ __device__ __forceinline__ void stage_rc(int b, int& R, int& C) { const int st = b / 1024, sb = b % 1024, swz = sb ^ (((sb >> 9) & 1) << 5); R = (st >> 1) * 16 + swz / 64; C = (st & 1) * 32 + (swz % 64) / 2; }
__host__ __device__ __forceinline__ int perm32(int rho) { const int n = rho >> 4, i = rho & 15; return 8 * (i >> 2) + 4 * n + (i & 3); }

struct Unit { int pm, pn; };
struct Gemm { const bf16_t* A; const bf16_t* Bt; int M, N, K; };

struct StaticOrder {
    int nM, nN, nwg, G, c;
    __host__ __device__ void init(int M, int N, int G_, int c_) { nM = M / BM; nN = N / BM; nwg = nM * nN; G = G_; c = c_; }
    __host__ __device__ bool next(int i, Unit& u) const {
        const long L = (long)i * G + c; if (L >= nwg) return false;
        int wgid = (int)L; { const int q = nwg / NXCD, r = nwg % NXCD, xcd = wgid % NXCD, off = wgid / NXCD; wgid = (xcd < r ? xcd * (q + 1) : r * (q + 1) + (xcd - r) * q) + off; }
        const int nig = WGM * nN, gid = wgid / nig, fm = gid * WGM, gsz = (nM - fm) < WGM ? (nM - fm) : WGM;
        u.pm = fm + ((wgid % nig) % gsz); u.pn = (wgid % nig) / gsz; return true;
    }
    __device__ __forceinline__ void a_ready(const Unit&) const {}
    __device__ __forceinline__ void done(const Unit&) const {}
};
__device__ __forceinline__ unsigned cvt_pk_bf16(float lo, float hi) { unsigned r; asm volatile("v_cvt_pk_bf16_f32 %0, %1, %2" : "=v"(r) : "v"(lo), "v"(hi)); return r; }
template <class Epi, class Sched, bool ALIGN_EPI = false, bool SP2 = false>
__device__ __forceinline__ void gemm_phase(PG8_LAS unsigned char* lds, const Gemm g, const Sched& S, const Epi& E) {
    const int tid = threadIdx.x, wid = __builtin_amdgcn_readfirstlane(tid >> 6), lane = tid & 63, wr = wid >> 2, wc = wid & 3, fr = lane & 15, fq = lane >> 4;
    const int K = g.K, nt = K / BK;
    unsigned voffA[2], voffB[2];
#pragma unroll
    for (int i = 0; i < 2; ++i) { int R, C; stage_rc(tid * 16 + i * 8192, R, C); const int Rb = Epi::PERM ? ((R & ~31) + perm32(R & 31)) : R;
        voffA[i] = (unsigned)(R * K + C) * 2u; voffB[i] = (unsigned)(Rb * K + C) * 2u; }
    const size_t kstep = (size_t)(BK * 2);
    const size_t hstep = (size_t)HALF * K * 2;
    const size_t tstep = 2 * hstep;
    const unsigned ldsw = (unsigned)wid * 1024u;
    const int aoff = lds_byte(wr * 64 + fr, fq * 8), boff = lds_byte(wc * 32 + fr, fq * 8);
#define PG8_SA(b, h) (((b) * 2 + (h)) * HTB)
#define PG8_SB(b, h) ((4 + (b) * 2 + (h)) * HTB)
#define PG8_STAGE(bufoff, gbase, voff) do { _Pragma("unroll") for (int _i = 0; _i < 2; ++_i) \
        __builtin_amdgcn_global_load_lds((const unsigned*)((const char*)(gbase) + (voff)[_i]), (PG8_LAS unsigned*)(lds + (bufoff) + ldsw + _i * 8192), 16, 0, 0); } while (0)
#define PG8_LDA(dst, b, h) do { _Pragma("unroll") for (int m = 0; m < 4; ++m) _Pragma("unroll") for (int k = 0; k < 2; ++k) dst[m][k] = *(const PG8_LAS bf16x8*)(lds + PG8_SA(b, h) + aoff + m * 2048 + k * 1024); } while (0)
#define PG8_LDB(dst, b, h) do { _Pragma("unroll") for (int n = 0; n < 2; ++n) _Pragma("unroll") for (int k = 0; k < 2; ++k) dst[n][k] = *(const PG8_LAS bf16x8*)(lds + PG8_SB(b, h) + boff + n * 2048 + k * 1024); } while (0)
#define PG8_MMA(ai, bj, At, Bt) do { __builtin_amdgcn_s_setprio(1); _Pragma("unroll") for (int m = 0; m < 4; ++m) _Pragma("unroll") for (int n = 0; n < 2; ++n) _Pragma("unroll") for (int k = 0; k < 2; ++k) \
        acc[ai][bj][m][n] = __builtin_amdgcn_mfma_f32_16x16x32_bf16(Bt[n][k], At[m][k], acc[ai][bj][m][n], 0, 0, 0); __builtin_amdgcn_s_setprio(0); } while (0)
#define PG8_WAIT_V(n) asm volatile("s_waitcnt vmcnt(" #n ")" ::: "memory")
#define PG8_WAIT_L(n) asm volatile("s_waitcnt lgkmcnt(" #n ")" ::: "memory")
#define PG8_BAR __builtin_amdgcn_s_barrier()
#define PG8_SCHED __builtin_amdgcn_sched_barrier(0)
    Unit cur, nxt; int ui = 0;
    if (!S.next(0, cur)) return;
    f32x4 acc[2][2][4][2];
#pragma unroll
    for (int a = 0; a < 2; ++a)
#pragma unroll
        for (int b = 0; b < 2; ++b)
#pragma unroll
            for (int m = 0; m < 4; ++m)
#pragma unroll
                for (int n = 0; n < 2; ++n) acc[a][b][m][n] = (f32x4){0.f, 0.f, 0.f, 0.f};
    bf16x8 At[4][2], B0[2][2], B1[2][2];
    const char* cA = (const char*)g.A + (size_t)cur.pm * tstep; const char* cB = (const char*)g.Bt + (size_t)cur.pn * tstep;
    S.a_ready(cur);
    if constexpr (SP2) {
        PG8_STAGE(PG8_SB(0, 0), cB, voffB); PG8_STAGE(PG8_SB(0, 1), cB + hstep, voffB); PG8_STAGE(PG8_SA(0, 0), cA, voffA); PG8_STAGE(PG8_SA(0, 1), cA + hstep, voffA);
        if (wr == 1) PG8_BAR;
        PG8_WAIT_V(2); PG8_BAR;
        PG8_STAGE(PG8_SB(1, 0), cB + kstep, voffB); PG8_STAGE(PG8_SA(1, 0), cA + kstep, voffA); PG8_STAGE(PG8_SB(1, 1), cB + hstep + kstep, voffB);
        PG8_WAIT_V(6); PG8_BAR;
    } else {
        PG8_STAGE(PG8_SB(0, 0), cB, voffB); PG8_STAGE(PG8_SA(0, 0), cA, voffA); PG8_STAGE(PG8_SB(0, 1), cB + hstep, voffB); PG8_STAGE(PG8_SA(0, 1), cA + hstep, voffA);
        if (wr == 1) PG8_BAR;
        PG8_WAIT_V(4); PG8_BAR;
        PG8_STAGE(PG8_SB(1, 0), cB + kstep, voffB); PG8_STAGE(PG8_SA(1, 0), cA + kstep, voffA); PG8_STAGE(PG8_SB(1, 1), cB + hstep + kstep, voffB);
        PG8_WAIT_V(6); PG8_BAR;
    }
    for (;;) {
        const bool has_next = S.next(ui + 1, nxt);
        const char* nA = has_next ? (const char*)g.A + (size_t)nxt.pm * tstep : cA; const char* nB = has_next ? (const char*)g.Bt + (size_t)nxt.pn * tstep : cB;
        for (int t = 0; t < nt; t += 2) {
            const bool last = (t == nt - 2);
            const char* a1 = cA + (size_t)(t + 1) * kstep;
            const char* a2 = last ? nA : cA + (size_t)(t + 2) * kstep; const char* b2 = last ? nB : cB + (size_t)(t + 2) * kstep;
            const char* a3 = a2 + kstep; const char* b3 = b2 + kstep;
            if (last && has_next) S.a_ready(nxt);
            if constexpr (SP2) {
            PG8_LDB(B0, 0, 0); PG8_LDB(B1, 0, 1); PG8_SCHED; PG8_LDA(At, 0, 0); PG8_STAGE(PG8_SA(1, 1), a1 + hstep, voffA);
            PG8_WAIT_V(8); PG8_WAIT_L(0); PG8_BAR; PG8_MMA(0, 0, At, B0); PG8_MMA(0, 1, At, B1); PG8_BAR; PG8_SCHED;
            PG8_LDA(At, 0, 1); PG8_STAGE(PG8_SB(0, 0), b2, voffB); PG8_STAGE(PG8_SB(0, 1), b2 + hstep, voffB); PG8_STAGE(PG8_SA(0, 0), a2, voffA);
            PG8_WAIT_V(8); PG8_WAIT_L(0); PG8_BAR; PG8_MMA(1, 0, At, B0); PG8_MMA(1, 1, At, B1); PG8_BAR; PG8_SCHED;
            PG8_LDB(B0, 1, 0); PG8_LDB(B1, 1, 1); PG8_SCHED; PG8_LDA(At, 1, 0); PG8_STAGE(PG8_SA(0, 1), a2 + hstep, voffA);
            PG8_WAIT_V(8); PG8_WAIT_L(0); PG8_BAR; PG8_MMA(0, 0, At, B0); PG8_MMA(0, 1, At, B1); PG8_BAR; PG8_SCHED;
            PG8_LDA(At, 1, 1); PG8_STAGE(PG8_SB(1, 0), b3, voffB); PG8_STAGE(PG8_SB(1, 1), b3 + hstep, voffB); PG8_STAGE(PG8_SA(1, 0), a3, voffA);
            PG8_WAIT_V(8); PG8_WAIT_L(0); PG8_BAR; PG8_MMA(1, 0, At, B0); PG8_MMA(1, 1, At, B1); PG8_BAR; PG8_SCHED;
            } else {
            PG8_LDB(B0, 0, 0); PG8_SCHED; PG8_LDA(At, 0, 0); PG8_STAGE(PG8_SA(1, 1), a1 + hstep, voffA);
            PG8_WAIT_L(8); PG8_BAR; PG8_WAIT_L(0); PG8_MMA(0, 0, At, B0); PG8_BAR; PG8_SCHED;
            PG8_LDB(B1, 0, 1); PG8_STAGE(PG8_SB(0, 0), b2, voffB);
            PG8_BAR; PG8_WAIT_L(0); PG8_MMA(0, 1, At, B1); PG8_BAR;
            PG8_LDA(At, 0, 1); PG8_STAGE(PG8_SA(0, 0), a2, voffA);
            PG8_BAR; PG8_WAIT_L(0); PG8_MMA(1, 0, At, B0); PG8_BAR; PG8_SCHED;
            PG8_STAGE(PG8_SB(0, 1), b2 + hstep, voffB);
            PG8_WAIT_V(6); PG8_BAR; PG8_MMA(1, 1, At, B1); PG8_BAR;
            PG8_LDB(B0, 1, 0); PG8_SCHED; PG8_LDA(At, 1, 0); PG8_STAGE(PG8_SA(0, 1), a2 + hstep, voffA);
            PG8_WAIT_L(8); PG8_BAR; PG8_WAIT_L(0); PG8_MMA(0, 0, At, B0); PG8_BAR; PG8_SCHED;
            PG8_LDB(B1, 1, 1); PG8_STAGE(PG8_SB(1, 0), b3, voffB);
            PG8_BAR; PG8_WAIT_L(0); PG8_MMA(0, 1, At, B1); PG8_BAR;
            PG8_LDA(At, 1, 1); PG8_STAGE(PG8_SA(1, 0), a3, voffA);
            PG8_BAR; PG8_WAIT_L(0); PG8_MMA(1, 0, At, B0); PG8_BAR; PG8_SCHED;
            PG8_STAGE(PG8_SB(1, 1), b3 + hstep, voffB);
            PG8_WAIT_V(6); PG8_BAR; PG8_MMA(1, 1, At, B1); PG8_BAR;
            }
        }
        if constexpr (ALIGN_EPI) { if (wr == 0) PG8_BAR; }
        if constexpr (!Epi::AFTER_DRAIN) { E(acc, cur, wr, wc, fr, fq); S.done(cur); }
        if (!has_next) break;
#pragma unroll
        for (int a = 0; a < 2; ++a)
#pragma unroll
            for (int b = 0; b < 2; ++b)
#pragma unroll
                for (int m = 0; m < 4; ++m)
#pragma unroll
                    for (int n = 0; n < 2; ++n) acc[a][b][m][n] = (f32x4){0.f, 0.f, 0.f, 0.f};
        cur = nxt; cA = nA; cB = nB; ++ui;
        if constexpr (ALIGN_EPI) { if (wr == 1) PG8_BAR; }
    }
    PG8_WAIT_V(0);
    if constexpr (!ALIGN_EPI) { if (wr == 0) PG8_BAR; }
    PG8_BAR;
    if constexpr (Epi::AFTER_DRAIN) { E.fused(acc, cur, wr, wc, fr, fq, lds, wid, lane); S.done(cur); }
#undef PG8_SA
#undef PG8_SB
#undef PG8_STAGE
#undef PG8_LDA
#undef PG8_LDB
#undef PG8_MMA
#undef PG8_WAIT_V
#undef PG8_WAIT_L
#undef PG8_BAR
#undef PG8_SCHED
}
}
constexpr int DM = 2048, FF = 5632, NQKV = 4096, SEQ = 4096, NMETA = 16, SP = SEQ + NMETA  , SKP = 4160  , NB = 2;
constexpr int MAIN = NB * SEQ;
constexpr int ROW_META = MAIN, ROW_SAMP = MAIN + 16, MROWS = MAIN + 64;
constexpr int DB = 8, DS = 4, PAST = 16384, PAGE = 128, NPAGE = PAST / PAGE, NH = 8, HD = 128, AW = 1024, PW = 1024;
constexpr float EPS = 1e-6f;
constexpr int NWAVES = 8;
#ifndef MK_N_LAUNCHES
#define MK_N_LAUNCHES 1
#endif
constexpr int NPH = 10;
constexpr int N_LAUNCHES = MK_N_LAUNCHES;
#ifndef MK_FAST_GEMM
#define MK_FAST_GEMM 1
#endif
#ifndef MK_FAST_ATTN
#define MK_FAST_ATTN 1
#endif
constexpr bool FAST_GEMM = MK_FAST_GEMM;

constexpr size_t O_YP = 0, O_YS = O_YP + (size_t)MAIN * DM, O_KP = O_YS + (size_t)32 * DM, O_VP = O_KP + (size_t)NB * SP * 1024, O_PP = O_VP + (size_t)NB * SP * 1024,
                 O_KS = O_PP + (size_t)NB * 15 * 1024, O_VS = O_KS + (size_t)32 * 1024, O_PS = O_VS + (size_t)32 * 1024, O_END = O_PS + (size_t)DB * 15 * 1024;

constexpr size_t MiB = 1u << 20;
#ifndef MK_XSYNC
#define MK_XSYNC 0
#endif
#ifndef MK_REPEAT
#define MK_REPEAT 0
#endif
#ifndef MK_ROLES
#define MK_ROLES 0x55888888u
#define MK_LFIRST 0xF000u
#endif
constexpr size_t WS_CTL = 0, CTL_ZERO_BYTES = MK_XSYNC ? 256 * 1024 : 64 * 1024;
constexpr size_t WS_WGU1 = 2 * MiB, WS_WD1 = 46 * MiB, WS_WIN = 68 * MiB, WS_WOUT = 84 * MiB, WS_WGU2 = 92 * MiB, WS_WD2 = 136 * MiB;
constexpr size_t WS_XA = 158 * MiB, WS_ACT = 191 * MiB, WS_X1 = 280 * MiB, WS_Q = 345 * MiB, WS_QS = 361 * MiB, WS_KB = 362 * MiB, WS_VB = 379 * MiB, WS_PB = 396 * MiB;
constexpr size_t WS_KS = 413 * MiB, WS_VS = 415 * MiB, WS_PSN = 417 * MiB, WS_CAT = 418 * MiB, WS_OPART = 451 * MiB, WS_SSQ = 470 * MiB, WS_SLAB = 476 * MiB, WS_END = 486 * MiB;
static_assert(WS_WGU1 + (size_t)2 * FF * DM * 2 <= WS_WD1 && WS_WD1 + (size_t)DM * FF * 2 <= WS_WIN && WS_WIN + (size_t)NQKV * DM * 2 <= WS_WOUT && WS_WOUT + (size_t)DM * DM * 2 <= WS_WGU2, "ws map 1");
static_assert(WS_XA + (size_t)MROWS * DM * 2 <= WS_ACT && WS_ACT + (size_t)MROWS * FF * 2 <= WS_X1 && WS_X1 + (size_t)MROWS * DM * 4 <= WS_Q && WS_Q + (size_t)MAIN * 1024 * 2 <= WS_QS, "ws map 2");
static_assert(WS_KB + (size_t)NB * SKP * 1024 * 2 <= WS_VB && WS_VB + (size_t)NB * SKP * 1024 * 2 <= WS_PB && WS_PB + (size_t)NB * SP * 1024 * 2 <= WS_KS && WS_CAT + (size_t)MROWS * DM * 2 <= WS_OPART, "ws map 3");
constexpr int SSQ_PAD = 1;
constexpr size_t SSQ_BYTES = (size_t)4 * MROWS * SSQ_PAD * 4;
static_assert(WS_SSQ + SSQ_BYTES <= WS_SLAB, "ssq");
constexpr int CW_TMO = 0, CW_CODE = 1, CW_BAR = 4096, CW_SSQ = 16384, CW_DCNT = 14336;


constexpr int RING_OFF = 0, RING_BYTES = 131072;
constexpr int LDSCTL_OFF = RING_BYTES, MISC_OFF = LDSCTL_OFF + 320;
constexpr int LDS_BYTES = 147456;

#define GAS __attribute__((address_space(1)))
#define LAS __attribute__((address_space(3)))
typedef unsigned short bf16;
typedef unsigned v4u __attribute__((ext_vector_type(4)));
typedef unsigned v2u __attribute__((ext_vector_type(2)));
typedef float f32x4 __attribute__((ext_vector_type(4)));
typedef short bf16x8 __attribute__((ext_vector_type(8)));
typedef GAS unsigned gu32;
#define RLX_AGENT __ATOMIC_RELAXED, __HIP_MEMORY_SCOPE_AGENT
#define LDS_WAIT() asm volatile("s_waitcnt lgkmcnt(0)" ::: "memory")
#define VM_WAIT() asm volatile("s_waitcnt vmcnt(0)" ::: "memory")
__device__ __forceinline__ unsigned f2bf(float f) { unsigned u = __builtin_bit_cast(unsigned, f); return (u + 0x7fffu + ((u >> 16) & 1u)) >> 16; }
__device__ __forceinline__ unsigned pk2(float lo, float hi) { unsigned r; asm volatile("v_cvt_pk_bf16_f32 %0, %1, %2" : "=v"(r) : "v"(lo), "v"(hi)); return r; }
__device__ __forceinline__ float bf2f(unsigned short x) { return __builtin_bit_cast(float, (unsigned)x << 16); }
__device__ __forceinline__ float bflo(unsigned w) { return __builtin_bit_cast(float, w << 16); }
__device__ __forceinline__ float bfhi(unsigned w) { return __builtin_bit_cast(float, w & 0xffff0000u); }
__device__ __forceinline__ float wave_sum(float v) {
#pragma unroll
    for (int o = 1; o < 64; o <<= 1) v += __shfl_xor(v, o);
    return v;
}
__device__ __forceinline__ float wave_max(float v) {
#pragma unroll
    for (int o = 1; o < 64; o <<= 1) v = fmaxf(v, __shfl_xor(v, o));
    return v;
}
__device__ __forceinline__ unsigned lane_now() { unsigned l; asm volatile("v_mbcnt_lo_u32_b32 %0, -1, 0\n\tv_mbcnt_hi_u32_b32 %0, -1, %0" : "=v"(l)); return l; }
#define XB_TMO      128
#define XB_XCNT(j)  (256  + 64 * (j))
#define XB_XSUB(j)  (1280 + 64 * (j))
#define XB_XGEN(j)  (2304 + 64 * (j))
#define XB_TOP      3328
#define XB_TOPGEN   3392
#define XCD_BAR_WORDS 3456
#define XB_SPIN_CAP (1u << 18)

__device__ __forceinline__ unsigned xb_ld(unsigned* p)              { return __hip_atomic_load(p, __ATOMIC_RELAXED, __HIP_MEMORY_SCOPE_AGENT); }
__device__ __forceinline__ unsigned xb_add(unsigned* p, unsigned v) { return __hip_atomic_fetch_add(p, v, __ATOMIC_RELAXED, __HIP_MEMORY_SCOPE_AGENT); }
__device__ __forceinline__ unsigned xb_xcc_id() { return (unsigned)__builtin_amdgcn_s_getreg((3 << 11) | 20) & 0xFu; }
#define XB_SPIN(cond, bar) do { unsigned _sp = 0; while (cond) { __builtin_amdgcn_s_sleep(1); \
    if ((++_sp & 255u) == 0u) { if (xb_ld(&(bar)[XB_TMO])) break; if (_sp > XB_SPIN_CAP) { atomicAdd(&(bar)[XB_TMO], 1u); break; } } } } while (0)

struct XcdBarrier {
    unsigned* bar; unsigned x;
    volatile LAS unsigned* st;
};

__device__ __forceinline__ XcdBarrier xcd_barrier_post(unsigned* bar, volatile LAS unsigned* st) {
    XcdBarrier b; b.bar = bar; b.x = xb_xcc_id(); b.st = st;
    if (threadIdx.x == 0) (void)xb_add(&bar[XB_XCNT(b.x)], 1u);
    return b;
}
__device__ __forceinline__ void xcd_barrier_complete(unsigned* bar, unsigned x, unsigned& nloc, unsigned& nx) {
    const unsigned G = gridDim.x * gridDim.y * gridDim.z;
    unsigned sum, cnt, mine, sp = 0u;
    for (;;) {
        sum = 0u; cnt = 0u; mine = 0u;
#pragma unroll
        for (unsigned j = 0; j < 16; ++j) { const unsigned c = xb_ld(&bar[XB_XCNT(j)]); sum += c; cnt += (c > 0u) ? 1u : 0u; mine = (j == x) ? c : mine; }
        if (sum == G) break;
        __builtin_amdgcn_s_sleep(1);
        if ((++sp & 255u) == 0u) { if (xb_ld(&bar[XB_TMO])) break; if (sp > XB_SPIN_CAP) { atomicAdd(&bar[XB_TMO], 1u); break; } }
    }
    nloc = mine > 0u ? mine : 1u; nx = cnt > 0u ? cnt : 1u;
}

__device__ __forceinline__ void xcd_barrier(const XcdBarrier& b) {
    asm volatile("s_waitcnt vmcnt(0)" ::: "memory");
    __syncthreads();
    if (threadIdx.x == 0) {
        unsigned* bar = b.bar;
        __builtin_amdgcn_s_waitcnt(0);
        unsigned nloc = b.st[0], nx = b.st[1];
        if (nloc == 0u) { xcd_barrier_complete(bar, b.x, nloc, nx); b.st[0] = nloc; b.st[1] = nx; }
        const unsigned old = xb_add(&bar[XB_XSUB(b.x)], 1u);
        const unsigned gen = old / nloc;
        if (old + 1u == (gen + 1u) * nloc) {
            __builtin_amdgcn_fence(__ATOMIC_RELEASE, "agent");
            asm volatile("s_waitcnt vmcnt(0)" ::: "memory");
            const unsigned og = xb_add(&bar[XB_TOP], 1u);
            const unsigned tg = og / nx;
            if (og + 1u == (tg + 1u) * nx) xb_add(&bar[XB_TOPGEN], 1u);
            else XB_SPIN(xb_ld(&bar[XB_TOPGEN]) == tg, bar);
            __builtin_amdgcn_fence(__ATOMIC_ACQUIRE, "agent");
            xb_add(&bar[XB_XGEN(b.x)], 1u);
            asm volatile("s_waitcnt vmcnt(0)" ::: "memory");
        } else {
            XB_SPIN(xb_ld(&bar[XB_XGEN(b.x)]) == gen, bar);
            __builtin_amdgcn_fence(__ATOMIC_ACQUIRE, "agent");
            asm volatile("s_waitcnt vmcnt(0)" ::: "memory");
        }
    }
    __syncthreads();
}
struct Frame {
    LAS unsigned char* lds;
    volatile LAS unsigned* MISC;
    gu32* ctl;
    unsigned tid, lane; int wave, vcu, G;
    float* out; unsigned char* ws;
};
enum { I_XP = 0, I_XS, I_CK, I_CV, I_SPOOL, I_PT, I_META, I_NF1, I_WG1, I_WU1, I_WD1, I_NMIX, I_WIN, I_WPOOL, I_PSCALE, I_LQ1, I_LK1, I_LQ2, I_LK2, I_SUBLN, I_WOUT, I_NF2, I_WG2, I_WU2, I_WD2, I_NFIN };
#define WSP(T, off) ((T*)(F.ws + (off)))
__device__ __forceinline__ const float* inp(const Frame& F, int i) {
    volatile LAS unsigned* t = (volatile LAS unsigned*)(F.lds + LDSCTL_OFF);
    const unsigned lo = __builtin_amdgcn_readfirstlane(t[2 * i]), hi = __builtin_amdgcn_readfirstlane(t[2 * i + 1]);
    return (const float*)(const GAS float*)(((unsigned long long)hi << 32) | lo);
}
__device__ __forceinline__ float* ssq_ptr(const Frame& F, int k) { return (float*)(F.ws + WS_SSQ) + (size_t)k * MROWS * SSQ_PAD; }
__device__ __forceinline__ const float* x0_row(const Frame& F, int row) {
    if (row < MAIN) return inp(F, I_XP) + (size_t)row * DM;
    if (row < ROW_SAMP) return inp(F, I_META) + (size_t)(row - ROW_META) * DM;
    if (row < ROW_SAMP + 32) return inp(F, I_XS) + (size_t)(row - ROW_SAMP) * DM;
    return nullptr;
}
__device__ __forceinline__ float lam_get(const Frame& F) { return __builtin_bit_cast(float, (unsigned)F.MISC[16]); }
__device__ __forceinline__ float lam_value(const Frame& F) {
    const float a = wave_sum(inp(F, I_LQ1)[F.lane] * inp(F, I_LK1)[F.lane]), b = wave_sum(inp(F, I_LQ2)[F.lane] * inp(F, I_LK2)[F.lane]);
    return __expf(a) - __expf(b) + 0.2f;
}

struct TrItem { const float* W; bf16* WT; const float* gain; int N, ldk, koff, map, k0, n0; };
__device__ __forceinline__ int rowmap_rt(int map, int n) { return map == 0 ? n : (n >> 7) * 256 + (n & 127) + (map == 2 ? 128 : 0); }
__device__ __forceinline__ void tr_load(const TrItem& P, float (&wv)[32], unsigned lane) {
    const float* wp = P.W + (size_t)(P.k0 + (lane >> 5)) * P.N + P.n0 + (lane & 31);
#pragma unroll
    for (int i = 0; i < 32; ++i) wv[i] = __builtin_nontemporal_load(wp + (size_t)(2 * i) * P.N);
}
__device__ __forceinline__ void tr_store(const TrItem& P, const float (&wv)[32], LAS float* scr, unsigned lane) {
#pragma unroll
    for (int i = 0; i < 32; ++i) scr[(2 * i + (lane >> 5)) * 33 + (lane & 31)] = wv[i];
    LDS_WAIT(); asm volatile("" ::: "memory");
    const int c = lane & 7;
    f32x4 g0 = {1.f, 1.f, 1.f, 1.f}, g1 = g0;
    if (P.gain) { g0 = *(const GAS f32x4*)(P.gain + P.k0 + 8 * c); g1 = *(const GAS f32x4*)(P.gain + P.k0 + 8 * c + 4); }
#pragma unroll
    for (int j = 0; j < 4; ++j) { const int n = (lane >> 3) + 8 * j; const LAS float* s = scr + (8 * c) * 33 + n;
        v4u o; o.x = pk2(s[0 * 33] * g0.x, s[1 * 33] * g0.y); o.y = pk2(s[2 * 33] * g0.z, s[3 * 33] * g0.w); o.z = pk2(s[4 * 33] * g1.x, s[5 * 33] * g1.y); o.w = pk2(s[6 * 33] * g1.z, s[7 * 33] * g1.w);
        *(GAS v4u*)(P.WT + (size_t)rowmap_rt(P.map, P.n0 + n) * P.ldk + P.koff + P.k0 + 8 * c) = o; }
    LDS_WAIT(); asm volatile("" ::: "memory");
}
__device__ __forceinline__ void poolfold_tile(Frame& F, int tile) {
    const float* wp = inp(F, I_WPOOL); const float* ps = inp(F, I_PSCALE); const float* wout = inp(F, I_WOUT); bf16* WOUT = WSP(bf16, WS_WOUT);
    const int kb = tile >> 3, nb = tile & 7, k0 = kb * 32, g = k0 >> 8, i0 = k0 & 255, n0 = nb * 256;
    const unsigned tid = F.tid;
    LAS float* AT = (LAS float*)(F.lds + RING_OFF);
    LAS float* Bs = AT + 256 * 32;
    { const int i = tid >> 4, j0 = (tid & 15) * 16; const float* src = wp + ((size_t)(g * 256 + i0 + i)) * 256 + j0; const float* sc = ps + g * 256 + j0;
#pragma unroll
      for (int q = 0; q < 4; ++q) { const f32x4 a = *(const GAS f32x4*)(src + 4 * q), s4 = *(const GAS f32x4*)(sc + 4 * q);
          AT[(j0 + 4 * q + 0) * 32 + i] = a.x * s4.x; AT[(j0 + 4 * q + 1) * 32 + i] = a.y * s4.y; AT[(j0 + 4 * q + 2) * 32 + i] = a.z * s4.z; AT[(j0 + 4 * q + 3) * 32 + i] = a.w * s4.w; } }
    const float* bsrc = wout + (size_t)(g * 256) * DM + n0;
    f32x4 st[4];
#define PF_LOAD(c) do { _Pragma("unroll") for (int q = 0; q < 4; ++q) st[q] = *(const GAS f32x4*)(bsrc + (size_t)(32 * (c) + (tid >> 6) + 8 * q) * DM + (tid & 63) * 4); } while (0)
#define PF_WRITE(buf) do { _Pragma("unroll") for (int q = 0; q < 4; ++q) *(LAS f32x4*)(Bs + (buf) * 8192 + ((tid >> 6) + 8 * q) * 256 + (tid & 63) * 4) = st[q]; } while (0)
    PF_LOAD(0); PF_WRITE(0); PF_LOAD(1);
    __syncthreads();
    float acc[8][2];
#pragma unroll
    for (int r = 0; r < 8; ++r) { acc[r][0] = 0.f; acc[r][1] = 0.f; }
    const int ig = tid >> 7, np = tid & 127;
#pragma unroll 1
    for (int c = 0; c < 8; ++c) {
        const LAS float* Bc = Bs + (c & 1) * 8192 + np * 2; const LAS float* Ac = AT + (32 * c) * 32 + ig * 8;
#pragma unroll 8
        for (int j = 0; j < 32; ++j) { const f32x4 a0 = *(const LAS f32x4*)(Ac + j * 32), a1 = *(const LAS f32x4*)(Ac + j * 32 + 4); const float b0 = Bc[j * 256], b1 = Bc[j * 256 + 1];
            acc[0][0] += a0.x * b0; acc[0][1] += a0.x * b1; acc[1][0] += a0.y * b0; acc[1][1] += a0.y * b1; acc[2][0] += a0.z * b0; acc[2][1] += a0.z * b1; acc[3][0] += a0.w * b0; acc[3][1] += a0.w * b1;
            acc[4][0] += a1.x * b0; acc[4][1] += a1.x * b1; acc[5][0] += a1.y * b0; acc[5][1] += a1.y * b1; acc[6][0] += a1.z * b0; acc[6][1] += a1.z * b1; acc[7][0] += a1.w * b0; acc[7][1] += a1.w * b1; }
        if (c + 1 < 8) { PF_WRITE((c + 1) & 1); if (c + 2 < 8) PF_LOAD(c + 2); }
        __syncthreads();
    }
#undef PF_LOAD
#undef PF_WRITE
#pragma unroll
    for (int q = 0; q < 2; ++q) { v4u o; o.x = pk2(acc[0][q], acc[1][q]); o.y = pk2(acc[2][q], acc[3][q]); o.z = pk2(acc[4][q], acc[5][q]); o.w = pk2(acc[6][q], acc[7][q]);
        *(GAS v4u*)(WOUT + (size_t)(n0 + np * 2 + q) * DM + k0 + ig * 8) = o; }
}
__device__ __forceinline__ void rms_row_to_bf16(const float* xrow, const float* g, bf16* orow, int lane) {
    GAS unsigned long long* o8 = (GAS unsigned long long*)orow + lane;
    if (!xrow) {
#pragma unroll
        for (int j = 0; j < 8; ++j) o8[64 * j] = 0ull;
        return; }
    const GAS f32x4* xr = (const GAS f32x4*)xrow + lane;
    f32x4 v[8]; float s = 0.f;
#pragma unroll
    for (int j = 0; j < 8; ++j) { v[j] = xr[64 * j]; s += (v[j].x * v[j].x + v[j].y * v[j].y) + (v[j].z * v[j].z + v[j].w * v[j].w); }
    const float rs = rsqrtf(wave_sum(s) * (1.f / DM) + EPS);
#pragma unroll
    for (int j = 0; j < 8; ++j) { const f32x4 gv = ((const GAS f32x4*)g)[lane + 64 * j];
        o8[64 * j] = (unsigned long long)pk2(v[j].x * rs * gv.x, v[j].y * rs * gv.y) | ((unsigned long long)pk2(v[j].z * rs * gv.z, v[j].w * rs * gv.w) << 32); }
}
constexpr int TI_GU = (DM / 64) * (FF / 32), TI_DN = (FF / 64) * (DM / 32), TI_IN = (DM / 64) * (NQKV / 32), TI_OUT = (1024 / 64) * (DM / 32);
constexpr int TR_GU1_END = 2 * TI_GU, TR_D1_END = TR_GU1_END + TI_DN, TR_IN_END = TR_D1_END + TI_IN, TR_OUT_END = TR_IN_END + TI_OUT, TR_GU2_END = TR_OUT_END + 2 * TI_GU, TR_END = TR_GU2_END + TI_DN;
__device__ __forceinline__ TrItem tr_item(Frame& F, int it) {
    TrItem P; int r = it, nblk;
    if (r < TI_GU) { P = TrItem{inp(F, I_WG1), WSP(bf16, WS_WGU1), nullptr, FF, DM, 0, 1, 0, 0}; }
    else if ((r -= TI_GU) < TI_GU) { P = TrItem{inp(F, I_WU1), WSP(bf16, WS_WGU1), nullptr, FF, DM, 0, 2, 0, 0}; }
    else if ((r -= TI_GU) < TI_DN) { P = TrItem{inp(F, I_WD1), WSP(bf16, WS_WD1), nullptr, DM, FF, 0, 0, 0, 0}; }
    else if ((r -= TI_DN) < TI_IN) { P = TrItem{inp(F, I_WIN), WSP(bf16, WS_WIN), inp(F, I_NMIX), NQKV, DM, 0, 0, 0, 0}; }
    else if ((r -= TI_IN) < TI_OUT) { P = TrItem{inp(F, I_WOUT) + (size_t)1024 * DM, WSP(bf16, WS_WOUT), nullptr, DM, DM, 1024, 0, 0, 0}; }
    else if ((r -= TI_OUT) < TI_GU) { P = TrItem{inp(F, I_WG2), WSP(bf16, WS_WGU2), inp(F, I_NF2), FF, DM, 0, 1, 0, 0}; }
    else if ((r -= TI_GU) < TI_GU) { P = TrItem{inp(F, I_WU2), WSP(bf16, WS_WGU2), inp(F, I_NF2), FF, DM, 0, 2, 0, 0}; }
    else { r -= TI_GU; P = TrItem{inp(F, I_WD2), WSP(bf16, WS_WD2), nullptr, DM, FF, 0, 0, 0, 0}; }
    nblk = P.N / 32; P.k0 = 64 * (r / nblk); P.n0 = 32 * (r % nblk); return P;
}
__device__ __forceinline__ void tr_range(Frame& F, int first, int last, int part, int nparts) {
    LAS float* scr = (LAS float*)(F.lds + RING_OFF + F.wave * 16384);
    if (first + part < last) {
        float wv[32], wn[32];
        TrItem cur = tr_item(F, first + part); tr_load(cur, wv, F.lane);
#pragma unroll 1
        for (int it = first + part; it < last; it += nparts) {
            const bool more = it + nparts < last; TrItem nxt = cur;
            if (more) { nxt = tr_item(F, it + nparts); tr_load(nxt, wn, F.lane); }
            tr_store(cur, wv, scr, F.lane);
            if (more) { cur = nxt;
#pragma unroll
                for (int i = 0; i < 32; ++i) wv[i] = wn[i]; }
        }
    }
}
__device__ __forceinline__ void tr_window(Frame& F, int first, int last, int wg_first) {
    const int c = (int)blockIdx.x, wf = wg_first < F.G ? wg_first : 0;
    if (c >= wf) tr_range(F, first, last, (c - wf) * NWAVES + F.wave, (F.G - wf) * NWAVES);
}
__device__ __forceinline__ void p0_prologue(Frame& F) {
    const int gw = F.vcu * NWAVES + F.wave, NGW = F.G * NWAVES;
    for (int tile = F.vcu; tile < 256; tile += F.G) poolfold_tile(F, tile);
    tr_range(F, 0, TR_GU1_END, gw, NGW);
    { const int gt = F.vcu * NWAVES * 64 + F.tid, NT = F.G * NWAVES * 64; f32x4* z = (f32x4*)(F.ws + WS_SSQ);
      for (int i = gt; i < (int)(SSQ_BYTES / 16); i += NT) z[i] = (f32x4){0.f, 0.f, 0.f, 0.f}; }
    {
        const float* g = inp(F, I_NF1);
        f32x4 v[8], w[8]; const float* xr = gw < MROWS ? x0_row(F, gw) : nullptr;
        if (xr) {
#pragma unroll
            for (int j = 0; j < 8; ++j) v[j] = ((const GAS f32x4*)xr)[F.lane + 64 * j]; }
#pragma unroll 1
        for (int m = gw; m < MROWS; m += NGW) {
            const int mn = m + NGW; const float* xn = mn < MROWS ? x0_row(F, mn) : nullptr;
            if (xn) {
#pragma unroll
                for (int j = 0; j < 8; ++j) w[j] = ((const GAS f32x4*)xn)[F.lane + 64 * j]; }
            GAS unsigned long long* o8 = (GAS unsigned long long*)(WSP(bf16, WS_XA) + (size_t)m * DM) + F.lane;
            if (!xr) {
#pragma unroll
                for (int j = 0; j < 8; ++j) o8[64 * j] = 0ull;
            } else {
                float s = 0.f;
#pragma unroll
                for (int j = 0; j < 8; ++j) s += (v[j].x * v[j].x + v[j].y * v[j].y) + (v[j].z * v[j].z + v[j].w * v[j].w);
                const float rs = rsqrtf(wave_sum(s) * (1.f / DM) + EPS);
#pragma unroll
                for (int j = 0; j < 8; ++j) { const f32x4 gv = ((const GAS f32x4*)g)[F.lane + 64 * j];
                    o8[64 * j] = (unsigned long long)pk2(v[j].x * rs * gv.x, v[j].y * rs * gv.y) | ((unsigned long long)pk2(v[j].z * rs * gv.z, v[j].w * rs * gv.w) << 32); }
            }
            xr = xn;
#pragma unroll
            for (int j = 0; j < 8; ++j) v[j] = w[j];
        }
    }
    { const int gt = F.vcu * NWAVES * 64 + F.tid, NT = F.G * NWAVES * 64;
      for (int i = gt; i < DB * 11 * 256; i += NT) { const int c4 = i & 255, r = (i >> 8) % 11, b = i / (11 * 256);
          ((f32x4*)(F.out + O_PS + ((size_t)b * 15 + r) * 1024))[c4] = ((const f32x4*)(inp(F, I_SPOOL) + ((size_t)b * 15 + 4 + r) * 1024))[c4]; } }
}

struct RSwiglu {
    static constexpr bool HAS_SSQ = false;
    bf16* act; const float* ssq;
    struct Pre { float q; };
    __device__ __forceinline__ void pre(int row, int, Pre& p) const { p.q = ssq ? ssq[row * SSQ_PAD] : 0.f; }
    __device__ __forceinline__ float tile(int row, int colbase, const float (&v)[2][8], const Pre& p) const {
        const float rs = ssq ? rsqrtf(p.q * (1.f / DM) + EPS) : 1.f;
        const int ff = (colbase >> 8) * 128 + (colbase & 127);
        float a[8];
#pragma unroll
        for (int j = 0; j < 8; ++j) { const float g = v[0][j] * rs, u = v[1][j] * rs; a[j] = g * u * __builtin_amdgcn_rcpf(1.f + __builtin_amdgcn_exp2f(g * -1.4426950408889634f)); }
        v4u o; o.x = pk2(a[0], a[1]); o.y = pk2(a[2], a[3]); o.z = pk2(a[4], a[5]); o.w = pk2(a[6], a[7]);
        *(GAS v4u*)(act + (size_t)row * FF + ff) = o; return 0.f;
    }
};
struct RResid {
    static constexpr bool HAS_SSQ = true;
    const Frame* Fp; int mode;
    float alpha;
    struct Pre { f32x4 a0, a1, b0, b1; v4u w0, w1; };
    __device__ __forceinline__ float resid_inplace(float (&v)[2][8], const Pre& p) const {
        float s = 0.f;
#pragma unroll
        for (int h = 0; h < 2; ++h) { const v4u w = h ? p.w1 : p.w0; const float rr_[8] = {bflo(w.x), bfhi(w.x), bflo(w.y), bfhi(w.y), bflo(w.z), bfhi(w.z), bflo(w.w), bfhi(w.w)};
#pragma unroll
            for (int j = 0; j < 8; ++j) { v[h][j] = rr_[j] + alpha * v[h][j]; s += v[h][j] * v[h][j]; } }
        return s;
    }
    __device__ __forceinline__ void pre(int row, int colbase, Pre& p) const {
        const Frame& F = *Fp;
        if (mode == 0) { const float* res = x0_row(F, row); p.a0 = p.a1 = p.b0 = p.b1 = (f32x4){0.f, 0.f, 0.f, 0.f};
            if (res) { p.a0 = *(const GAS f32x4*)(res + colbase); p.a1 = *(const GAS f32x4*)(res + colbase + 4); p.b0 = *(const GAS f32x4*)(res + colbase + 128); p.b1 = *(const GAS f32x4*)(res + colbase + 132); } }
        else { const bf16* xa = WSP(bf16, WS_XA) + (size_t)row * DM + colbase; p.w0 = *(const GAS v4u*)xa; p.w1 = *(const GAS v4u*)(xa + 128); }
    }
    __device__ __forceinline__ float tile(int row, int colbase, const float (&v)[2][8], const Pre& p) const {
        const Frame& F = *Fp;
        bf16* xa = WSP(bf16, WS_XA) + (size_t)row * DM;
        float* dst = mode != 2 ? nullptr : (row < MAIN ? F.out + O_YP + (size_t)row * DM : (row >= ROW_SAMP && row < ROW_SAMP + 32) ? F.out + O_YS + (size_t)(row - ROW_SAMP) * DM : nullptr);
        float s = 0.f;
#pragma unroll
        for (int h = 0; h < 2; ++h) { const int col = colbase + 128 * h;
            f32x4 r0, r1;
            if (mode == 0) { r0 = h ? p.b0 : p.a0; r1 = h ? p.b1 : p.a1; }
            else { const v4u w = h ? p.w1 : p.w0; r0 = (f32x4){bflo(w.x), bfhi(w.x), bflo(w.y), bfhi(w.y)}; r1 = (f32x4){bflo(w.z), bfhi(w.z), bflo(w.w), bfhi(w.w)}; }
            f32x4 a = {r0.x + alpha * v[h][0], r0.y + alpha * v[h][1], r0.z + alpha * v[h][2], r0.w + alpha * v[h][3]};
            f32x4 b = {r1.x + alpha * v[h][4], r1.y + alpha * v[h][5], r1.z + alpha * v[h][6], r1.w + alpha * v[h][7]};
            s += (a.x * a.x + a.y * a.y) + (a.z * a.z + a.w * a.w) + (b.x * b.x + b.y * b.y) + (b.z * b.z + b.w * b.w);
            if (mode == 2) { if (dst) { *(GAS f32x4*)(dst + col) = a; *(GAS f32x4*)(dst + col + 4) = b; } }
            else { v4u o; o.x = pk2(a.x, a.y); o.y = pk2(a.z, a.w); o.z = pk2(b.x, b.y); o.w = pk2(b.z, b.w); *(GAS v4u*)(xa + col) = o; } }
        return s;
    }
};
struct RProj {
    static constexpr bool HAS_SSQ = false;
    const Frame* Fp;
    __device__ __forceinline__ void put(int row, int col, const float (&x)[8]) const {
        const Frame& F = *Fp;
        const int t = col >> 10, c = col & 1023;
        v4u o; o.x = pk2(x[0], x[1]); o.y = pk2(x[2], x[3]); o.z = pk2(x[4], x[5]); o.w = pk2(x[6], x[7]);
        const f32x4 fa = {x[0], x[1], x[2], x[3]}, fb = {x[4], x[5], x[6], x[7]};
        if (row < MAIN) {
            const int b = row >> 12, tt = row & 4095;
            if (t == 0) { *(GAS v4u*)(WSP(bf16, WS_PB) + ((size_t)b * SP + 16 + tt) * 1024 + c) = o;
                if (tt >= SEQ - 15) { float* d = F.out + O_PP + ((size_t)b * 15 + (tt - (SEQ - 15))) * 1024 + c; *(GAS f32x4*)d = fa; *(GAS f32x4*)(d + 4) = fb; } }
            else if (t == 1) { *(GAS v4u*)(WSP(bf16, WS_Q) + (size_t)row * 1024 + c) = o; }
            else { *(GAS v4u*)(WSP(bf16, t == 2 ? WS_KB : WS_VB) + ((size_t)b * SKP + 16 + tt) * 1024 + c) = o;
                float* d = F.out + (t == 2 ? O_KP : O_VP) + ((size_t)b * SP + 16 + tt) * 1024 + c; *(GAS f32x4*)d = fa; *(GAS f32x4*)(d + 4) = fb; }
        } else if (row < ROW_SAMP) {
            const int i = row - ROW_META;
#pragma unroll
            for (int b = 0; b < NB; ++b) {
                if (t == 0) { *(GAS v4u*)(WSP(bf16, WS_PB) + ((size_t)b * SP + i) * 1024 + c) = o; }
                else if (t >= 2) { *(GAS v4u*)(WSP(bf16, t == 2 ? WS_KB : WS_VB) + ((size_t)b * SKP + i) * 1024 + c) = o;
                    float* d = F.out + (t == 2 ? O_KP : O_VP) + ((size_t)b * SP + i) * 1024 + c; *(GAS f32x4*)d = fa; *(GAS f32x4*)(d + 4) = fb; } }
        } else if (row < ROW_SAMP + 32) {
            const int j = row - ROW_SAMP, b = j >> 2, tt = j & 3;
            if (t == 0) { float* d = WSP(float, WS_PSN) + (size_t)j * 1024 + c; *(GAS f32x4*)d = fa; *(GAS f32x4*)(d + 4) = fb;
                float* e = F.out + O_PS + ((size_t)b * 15 + 11 + tt) * 1024 + c; *(GAS f32x4*)e = fa; *(GAS f32x4*)(e + 4) = fb; }
            else if (t == 1) { *(GAS v4u*)(WSP(bf16, WS_QS) + (size_t)j * 1024 + c) = o; }
            else { float* d = WSP(float, t == 2 ? WS_KS : WS_VS) + ((size_t)b * 64 + tt) * 1024 + c; *(GAS f32x4*)d = fa; *(GAS f32x4*)(d + 4) = fb;
                float* e = F.out + (t == 2 ? O_KS : O_VS) + (size_t)j * 1024 + c; *(GAS f32x4*)e = fa; *(GAS f32x4*)(e + 4) = fb; }
        }
    }
    struct Pre { float q; };
    __device__ __forceinline__ void pre(int row, int, Pre& p) const { p.q = ssq_ptr(*Fp, 0)[row * SSQ_PAD]; }
    __device__ __forceinline__ float tile(int row, int colbase, const float (&v)[2][8], const Pre& p) const {
        const float rs = rsqrtf(p.q * (1.f / DM) + EPS);
        float x[8];
#pragma unroll
        for (int h = 0; h < 2; ++h) {
#pragma unroll
            for (int j = 0; j < 8; ++j) x[j] = v[h][j] * rs;
            put(row, colbase + 128 * h, x); }
        return 0.f;
    }
};
struct SyncOrder {
    pg8::StaticOrder S; unsigned* cnt; unsigned nloc, xcc; int full_rounds; mutable int ui;
    __device__ bool next(int i, pg8::Unit& u) const { return S.next(i, u); }
    __device__ __forceinline__ void a_ready(const pg8::Unit&) const {
        const int i = ui++;
        if (i >= 1 && i < full_rounds) {
            if (threadIdx.x == 0) { unsigned* c = cnt + 64 * (xcc * 8 + i); __hip_atomic_fetch_add(c, 1u, RLX_AGENT); unsigned sp = 0;
                while (__hip_atomic_load(c, RLX_AGENT) < nloc) { __builtin_amdgcn_s_sleep(1); if (++sp > (1u << 16)) break; } }
            __builtin_amdgcn_s_barrier();
        }
    }
    __device__ __forceinline__ void done(const pg8::Unit&) const {}
};
struct RepOrder {
    pg8::StaticOrder S;
    int sh;
    __device__ bool next(int i, pg8::Unit& u) const { return S.next(i >> sh, u); }
    __device__ __forceinline__ void a_ready(const pg8::Unit&) const {}
    __device__ __forceinline__ void done(const pg8::Unit&) const {}
};
template <class R, int SKIP1 = 0> struct EpiFast {
    static constexpr bool PERM = true, AFTER_DRAIN = false;
    R r; float* ssq_dst; mutable int cnt; float* ssq_dummy;
    __device__ __forceinline__ void operator()(const pg8::f32x4 (&acc)[2][2][4][2], const pg8::Unit& u, int wr, int wc, int fr, int fq) const {
        float* sdst = ssq_dst;
        if constexpr (SKIP1 == 1) { const int msk = ((MK_REPEAT >> 15) & 1) ? 3 : 1; if (((cnt++) & msk) != msk) return; }
        if constexpr (SKIP1 == 2) { if (((cnt++) & 1) == 0) sdst = ssq_dummy; }
        const int colbase = u.pn * 256 + wc * 32 + 8 * fq, rowb = u.pm * 256 + wr * 64 + fr;
        typename R::Pre pp[2];
        r.pre(rowb, colbase, pp[0]);
#pragma unroll
        for (int i = 0; i < 8; ++i) {
            const int ai = i >> 2, m = i & 3, row = rowb + ai * 128 + m * 16;
            if (i + 1 < 8) r.pre(rowb + ((i + 1) >> 2) * 128 + ((i + 1) & 3) * 16, colbase, pp[(i + 1) & 1]);
            float v[2][8];
#pragma unroll
            for (int bj = 0; bj < 2; ++bj)
#pragma unroll
                for (int n = 0; n < 2; ++n)
#pragma unroll
                    for (int j = 0; j < 4; ++j) v[bj][4 * n + j] = acc[ai][bj][m][n][j];
            float s = r.tile(row, colbase, v, pp[i & 1]);
            if constexpr (R::HAS_SSQ) { s += __shfl_xor(s, 16); s += __shfl_xor(s, 32); if (fq == 0) __hip_atomic_fetch_add(sdst + row * SSQ_PAD, s, RLX_AGENT); }
        }
    }
};
template <class R> struct EpiDrain {
    static constexpr bool PERM = true, AFTER_DRAIN = true;
    R r; float* ssq_dst;
    __device__ __forceinline__ void operator()(const pg8::f32x4 (&)[2][2][4][2], const pg8::Unit&, int, int, int, int) const {}
    __device__ __forceinline__ void fused(const pg8::f32x4 (&acc)[2][2][4][2], const pg8::Unit& u, int wr, int wc, int fr, int fq, LAS unsigned char* lds, int wid, int lane) const {
        const int colbase = u.pn * 256 + wc * 32 + 8 * fq, rowb = u.pm * 256 + wr * 64 + fr;
        LAS float* tmp = (LAS float*)lds;
        typename R::Pre pp[2];
        r.pre(rowb, colbase, pp[0]);
#pragma unroll
        for (int i = 0; i < 8; ++i) {
            const int ai = i >> 2, m = i & 3, row = rowb + ai * 128 + m * 16;
            if (i + 1 < 8) r.pre(rowb + ((i + 1) >> 2) * 128 + ((i + 1) & 3) * 16, colbase, pp[(i + 1) & 1]);
            float v[2][8];
#pragma unroll
            for (int bj = 0; bj < 2; ++bj)
#pragma unroll
                for (int n = 0; n < 2; ++n)
#pragma unroll
                    for (int j = 0; j < 4; ++j) v[bj][4 * n + j] = acc[ai][bj][m][n][j];
            float s = r.tile(row, colbase, v, pp[i & 1]);
            s += __shfl_xor(s, 16); s += __shfl_xor(s, 32);
            if (fq == 0) tmp[wc * 256 + ai * 128 + wr * 64 + m * 16 + fr] = s;
        }
        __syncthreads();
        if (threadIdx.x < 256) { const int t = threadIdx.x; __hip_atomic_fetch_add(ssq_dst + (u.pm * 256 + t) * SSQ_PAD, (tmp[t] + tmp[256 + t]) + (tmp[512 + t] + tmp[768 + t]), RLX_AGENT); }
        __syncthreads();
    }
};
struct EpiFinal {
    static constexpr bool PERM = true, AFTER_DRAIN = true;
    const Frame* Fp; float* ssq; unsigned* cnt; const float* nf;
    __device__ __forceinline__ void operator()(const pg8::f32x4 (&)[2][2][4][2], const pg8::Unit&, int, int, int, int) const {}
    __device__ __forceinline__ void fused(const pg8::f32x4 (&acc_)[2][2][4][2], const pg8::Unit& u, int wr, int wc, int fr, int fq, LAS unsigned char* lds, int wid, int lane) const {
        const Frame& F = *Fp;
        auto& acc = const_cast<pg8::f32x4 (&)[2][2][4][2]>(acc_);
        const int colbase = u.pn * 256 + wc * 32 + 8 * fq, rowb = u.pm * 256 + wr * 64 + fr;
        v4u rw[2][2];
        { const bf16* res = WSP(bf16, WS_XA) + (size_t)rowb * DM + colbase; rw[0][0] = *(const GAS v4u*)res; rw[0][1] = *(const GAS v4u*)(res + 128); }
#pragma unroll
        for (int i = 0; i < 8; ++i) {
            const int ai = i >> 2, m = i & 3, row = rowb + ai * 128 + m * 16;
            if (i + 1 < 8) { const bf16* res = WSP(bf16, WS_XA) + (size_t)(rowb + ((i + 1) >> 2) * 128 + ((i + 1) & 3) * 16) * DM + colbase; rw[(i + 1) & 1][0] = *(const GAS v4u*)res; rw[(i + 1) & 1][1] = *(const GAS v4u*)(res + 128); }
            float s = 0.f;
#pragma unroll
            for (int bj = 0; bj < 2; ++bj) { const v4u w = rw[i & 1][bj];
#pragma unroll
                for (int n = 0; n < 2; ++n) { const f32x4 r4 = n == 0 ? (f32x4){bflo(w.x), bfhi(w.x), bflo(w.y), bfhi(w.y)} : (f32x4){bflo(w.z), bfhi(w.z), bflo(w.w), bfhi(w.w)}; f32x4 x = acc[ai][bj][m][n];
                    x.x = r4.x + 0.5f * x.x; x.y = r4.y + 0.5f * x.y; x.z = r4.z + 0.5f * x.z; x.w = r4.w + 0.5f * x.w; acc[ai][bj][m][n] = x;
                    s += (x.x * x.x + x.y * x.y) + (x.z * x.z + x.w * x.w); } }
            s += __shfl_xor(s, 16); s += __shfl_xor(s, 32);
            if (fq == 0) ((LAS float*)lds)[wc * 256 + ai * 128 + wr * 64 + m * 16 + fr] = s;
        }
        __syncthreads();
        if (threadIdx.x < 256) { const int t = threadIdx.x; const LAS float* tmp = (const LAS float*)lds; __hip_atomic_fetch_add(ssq + (u.pm * 256 + t) * SSQ_PAD, (tmp[t] + tmp[256 + t]) + (tmp[512 + t] + tmp[768 + t]), RLX_AGENT); }
        asm volatile("s_waitcnt vmcnt(0)" ::: "memory");
        __syncthreads();
        if (threadIdx.x == 0) {
            unsigned* c = cnt + 64 * u.pm;
            __hip_atomic_fetch_add(c, 1u, RLX_AGENT);
            unsigned sp = 0;
            while (__hip_atomic_load(c, RLX_AGENT) < (unsigned)(DM / 256)) { __builtin_amdgcn_s_sleep(1); if (++sp > (1u << 22)) break; }
        }
        __syncthreads();
        f32x4 g[2][2];
#pragma unroll
        for (int bj = 0; bj < 2; ++bj)
#pragma unroll
            for (int n = 0; n < 2; ++n) g[bj][n] = *(const GAS f32x4*)(nf + colbase + 128 * bj + 4 * n);
        float sq[8];
#pragma unroll
        for (int i = 0; i < 8; ++i) sq[i] = __hip_atomic_load(ssq + (rowb + (i >> 2) * 128 + (i & 3) * 16) * SSQ_PAD, RLX_AGENT);
#pragma unroll
        for (int i = 0; i < 8; ++i) {
            const int ai = i >> 2, m = i & 3, row = rowb + ai * 128 + m * 16;
            const float rs = rsqrtf(sq[i] * (1.f / DM) + EPS);
            float* y = F.out + O_YP + (size_t)row * DM + colbase;
#pragma unroll
            for (int bj = 0; bj < 2; ++bj)
#pragma unroll
                for (int n = 0; n < 2; ++n) { const f32x4 x = acc[ai][bj][m][n], gg = g[bj][n]; f32x4 o = {x.x * rs * gg.x, x.y * rs * gg.y, x.z * rs * gg.z, x.w * rs * gg.w};
                    *(GAS f32x4*)(y + 128 * bj + 4 * n) = o; }
        }
    }
};
constexpr int CW_TCNT = 12288;
static_assert((CW_TCNT + 64 * 16 + 16) * 4 <= (int)CTL_ZERO_BYTES && WS_SLAB + (size_t)64 * 8 * 4096 * 4 <= WS_END, "tail slabs");
template <class R>
__device__ __forceinline__ void gemm_simple_unit(Frame& F, const bf16* A, const bf16* Bt, int K, int N, int row0, int pn, int wc, int slice, int nsl, const R& r, float* ssq_dst, bool final_tail = false) {
    const int lane = F.lane, wid = F.wave, fr = lane & 15, fq = lane >> 4;
    const int nks = K / 32 / nsl, ks0 = slice * nks;
    f32x4 acc[4][2][2];
#pragma unroll
    for (int m = 0; m < 4; ++m)
#pragma unroll
        for (int bj = 0; bj < 2; ++bj)
#pragma unroll
            for (int n = 0; n < 2; ++n) acc[m][bj][n] = (f32x4){0.f, 0.f, 0.f, 0.f};
    const bf16* ap = A + (size_t)(row0 + fr) * K + ks0 * 32 + fq * 8;
    const bf16* bp = Bt + (size_t)(pn * 256 + wc * 32 + 8 * (fr >> 2) + (fr & 3)) * K + ks0 * 32 + fq * 8;
    bf16x8 a0[4], b0[2][2], a1[4], b1[2][2];
#define GS_LOAD(a_, b_, j_) do { _Pragma("unroll") for (int m = 0; m < 4; ++m) a_[m] = *(const GAS bf16x8*)(ap + (size_t)(16 * m) * K + (j_) * 32); \
        _Pragma("unroll") for (int bj = 0; bj < 2; ++bj) _Pragma("unroll") for (int n = 0; n < 2; ++n) b_[bj][n] = *(const GAS bf16x8*)(bp + (size_t)(bj * 128 + 4 * n) * K + (j_) * 32); } while (0)
#define GS_MMA(a_, b_) do { _Pragma("unroll") for (int m = 0; m < 4; ++m) _Pragma("unroll") for (int bj = 0; bj < 2; ++bj) _Pragma("unroll") for (int n = 0; n < 2; ++n) \
        acc[m][bj][n] = __builtin_amdgcn_mfma_f32_16x16x32_bf16(b_[bj][n], a_[m], acc[m][bj][n], 0, 0, 0); } while (0)
    if (wid < nks) GS_LOAD(a0, b0, wid);
    for (int j = wid; j < nks; j += 16) {
        if (j + 8 < nks) GS_LOAD(a1, b1, j + 8);
        GS_MMA(a0, b0);
        if (j + 16 < nks) GS_LOAD(a0, b0, j + 16);
        if (j + 8 < nks) GS_MMA(a1, b1);
    }
#undef GS_LOAD
#undef GS_MMA
    LAS float* part = (LAS float*)(F.lds + RING_OFF);
#pragma unroll
    for (int m = 0; m < 4; ++m)
#pragma unroll
        for (int bj = 0; bj < 2; ++bj)
#pragma unroll
            for (int n = 0; n < 2; ++n) *(LAS f32x4*)(part + ((wid * 64 + 16 * m + fr) * 64 + bj * 32 + 8 * fq + 4 * n)) = acc[m][bj][n];
    __syncthreads();
    const int rr = F.tid >> 2, sub = F.tid & 3, colbase = pn * 256 + wc * 32 + 8 * sub;
    float v[2][8];
    if (F.tid < 256) {
#pragma unroll
        for (int bj = 0; bj < 2; ++bj)
#pragma unroll
            for (int j = 0; j < 8; ++j) v[bj][j] = 0.f;
#pragma unroll
        for (int w = 0; w < 8; ++w)
#pragma unroll
            for (int bj = 0; bj < 2; ++bj) { const f32x4 p0 = *(LAS f32x4*)(part + ((w * 64 + rr) * 64 + bj * 32 + 8 * sub)), p1 = *(LAS f32x4*)(part + ((w * 64 + rr) * 64 + bj * 32 + 8 * sub + 4));
                v[bj][0] += p0.x; v[bj][1] += p0.y; v[bj][2] += p0.z; v[bj][3] += p0.w; v[bj][4] += p1.x; v[bj][5] += p1.y; v[bj][6] += p1.z; v[bj][7] += p1.w; }
    }
    if (nsl == 1) {
        if (F.tid < 256) { typename R::Pre p_; r.pre(row0 + rr, colbase, p_); float s = r.tile(row0 + rr, colbase, v, p_); if constexpr (R::HAS_SSQ) { s += __shfl_xor(s, 1); s += __shfl_xor(s, 2); if (sub == 0) __hip_atomic_fetch_add(ssq_dst + (row0 + rr) * SSQ_PAD, s, RLX_AGENT); } }
    } else {
        const int cu = pn * 4 + wc;
        const __amdgpu_buffer_rsrc_t srs = __builtin_amdgcn_make_buffer_rsrc((void*)(F.ws + WS_SLAB), 0, 64 * 8 * 16384, 0x00020000);
        const int sbase = __builtin_amdgcn_readfirstlane(cu * 8 * 16384), tq = (int)(F.tid & 255) * 16;
        unsigned* cnt = (unsigned*)(F.ws + WS_CTL) + CW_TCNT + 16 * cu;
        if (F.tid < 256) {
#pragma unroll
            for (int q = 0; q < 4; ++q) { const f32x4 d = {v[q >> 1][(q & 1) * 4 + 0], v[q >> 1][(q & 1) * 4 + 1], v[q >> 1][(q & 1) * 4 + 2], v[q >> 1][(q & 1) * 4 + 3]};
                __builtin_amdgcn_raw_buffer_store_b128(__builtin_bit_cast(v4u, d), srs, q * 4096 + tq, sbase + slice * 16384, 16); }
        }
        asm volatile("s_waitcnt vmcnt(0)" ::: "memory");
        __syncthreads();
        if (F.tid == 0) { const unsigned old = __hip_atomic_fetch_add(cnt, 1u, RLX_AGENT); F.MISC[20] = (old == (unsigned)(nsl - 1)) ? 1u : 0u; }
        __syncthreads();
        if (F.MISC[20] != 0u) {
            if (F.tid < 256) {
#pragma unroll
                for (int bj = 0; bj < 2; ++bj)
#pragma unroll
                    for (int j = 0; j < 8; ++j) v[bj][j] = 0.f;
#pragma unroll
                for (int s4 = 0; s4 < 8; s4 += 4) {
                    v4u t_[4][4];
                    if (s4 < nsl) {
#pragma unroll
                        for (int q = 0; q < 4; ++q)
#pragma unroll
                            for (int e = 0; e < 4; ++e) t_[q][e] = __builtin_amdgcn_raw_buffer_load_b128(srs, e * 4096 + tq, sbase + (s4 + q) * 16384, 16);
#pragma unroll
                        for (int q = 0; q < 4; ++q)
#pragma unroll
                            for (int e = 0; e < 4; ++e) { const f32x4 d = __builtin_bit_cast(f32x4, t_[q][e]); v[e >> 1][(e & 1) * 4 + 0] += d.x; v[e >> 1][(e & 1) * 4 + 1] += d.y; v[e >> 1][(e & 1) * 4 + 2] += d.z; v[e >> 1][(e & 1) * 4 + 3] += d.w; }
                    }
                }
                if (final_tail) {
                    if constexpr (R::HAS_SSQ) { typename R::Pre p_; r.pre(row0 + rr, colbase, p_); float s = r.resid_inplace(v, p_); s += __shfl_xor(s, 1); s += __shfl_xor(s, 2); if (sub == 0) __hip_atomic_fetch_add(ssq_dst + (row0 + rr) * SSQ_PAD, s, RLX_AGENT); }
                } else {
                typename R::Pre p_; r.pre(row0 + rr, colbase, p_); float s = r.tile(row0 + rr, colbase, v, p_); if constexpr (R::HAS_SSQ) { s += __shfl_xor(s, 1); s += __shfl_xor(s, 2); if (sub == 0) __hip_atomic_fetch_add(ssq_dst + (row0 + rr) * SSQ_PAD, s, RLX_AGENT); }
                }
            }
            if (F.tid == 0) __hip_atomic_store(cnt, 0u, RLX_AGENT);
            if (final_tail) {
                asm volatile("s_waitcnt vmcnt(0)" ::: "memory");
                __syncthreads();
                unsigned* fc = (unsigned*)(F.ws + WS_CTL) + CW_TCNT + 64 * 16;
                if (F.tid == 0) { __hip_atomic_fetch_add(fc, 1u, RLX_AGENT); unsigned sp = 0;
                    while (__hip_atomic_load(fc, RLX_AGENT) < (unsigned)((N / 256) * 4)) { __builtin_amdgcn_s_sleep(1); if (++sp > (1u << 22)) break; } }
                __syncthreads();
                const int row = row0 + rr;
                if (F.tid < 256 && row >= ROW_SAMP && row < ROW_SAMP + 32) {
                    const float rs = rsqrtf(__hip_atomic_load(ssq_dst + row * SSQ_PAD, RLX_AGENT) * (1.f / DM) + EPS);
                    const float* nf = inp(F, I_NFIN) + colbase; float* y = F.out + O_YS + (size_t)(row - ROW_SAMP) * DM + colbase;
#pragma unroll
                    for (int h = 0; h < 2; ++h) { const f32x4 g0 = *(const GAS f32x4*)(nf + 128 * h), g1 = *(const GAS f32x4*)(nf + 128 * h + 4);
                        *(GAS f32x4*)(y + 128 * h) = (f32x4){v[h][0] * rs * g0.x, v[h][1] * rs * g0.y, v[h][2] * rs * g0.z, v[h][3] * rs * g0.w};
                        *(GAS f32x4*)(y + 128 * h + 4) = (f32x4){v[h][4] * rs * g1.x, v[h][5] * rs * g1.y, v[h][6] * rs * g1.z, v[h][7] * rs * g1.w}; }
                }
            }
        }
    }
    __syncthreads();
}
#ifndef MK_REPEAT
#define MK_REPEAT 0
#endif
#ifndef MK_XSYNC
#define MK_XSYNC 0
#endif
constexpr int CW_XS = 32768;
constexpr int CW_PCNT = 8192;
static_assert((CW_PCNT + 64 * 32) * 4 <= (int)CTL_ZERO_BYTES, "ctl counters");
__device__ __forceinline__ void run_gemm_final_main(Frame& F, const bf16* A, const bf16* Bt) {
    pg8::Gemm g{A, Bt, MAIN, DM, FF}; pg8::StaticOrder S; S.init(MAIN, DM, F.G, (int)blockIdx.x);
    EpiFinal E{&F, ssq_ptr(F, 2), (unsigned*)(F.ws + WS_CTL) + CW_PCNT, inp(F, I_NFIN)};
    pg8::gemm_phase<EpiFinal, pg8::StaticOrder, false, true>(F.lds + RING_OFF, g, S, E);
}
template <class R, int PH>
__device__ __forceinline__ void run_gemm(Frame& F, const bf16* A, const bf16* Bt, int N, int K, const R& r, float* ssq_dst, int tail_off, bool skip_main = false, bool final_tail = false) {
    const bool one_unit = (MAIN / 256) * (N / 256) <= F.G;
    if constexpr (FAST_GEMM) if (!skip_main) {
        pg8::Gemm g{A, Bt, MAIN, N, K}; pg8::StaticOrder S; S.init(MAIN, N, F.G, (int)blockIdx.x);
        float* sdum = ssq_ptr(F, 3);
        if constexpr (((MK_REPEAT >> PH) & 1) != 0) { RepOrder RS{S, ((MK_REPEAT >> 15) & 1) ? 2 : 1}; EpiFast<R, 1> E{r, ssq_dst, 0, sdum}; pg8::gemm_phase<EpiFast<R, 1>, RepOrder, true, true>(F.lds + RING_OFF, g, RS, E); }
        else if constexpr (((MK_REPEAT >> (PH + 16)) & 1) != 0) { RepOrder RS{S, 1}; EpiFast<R, 2> E{r, ssq_dst, 0, sdum}; pg8::gemm_phase<EpiFast<R, 2>, RepOrder, true, true>(F.lds + RING_OFF, g, RS, E); }
        else if constexpr (MK_XSYNC != 0 && (PH == 1 || PH == 7 || PH == 3)) {
            const unsigned nloc = F.MISC[8];
            SyncOrder SS{S, (unsigned*)(F.ws + WS_CTL) + CW_XS + (PH == 1 ? 0 : PH == 3 ? 8192 : 16384), nloc ? nloc : 1u, xb_xcc_id(), (MAIN / 256) * (N / 256) / F.G, 0};
            EpiFast<R> E{r, ssq_dst, 0, sdum}; pg8::gemm_phase<EpiFast<R>, SyncOrder, true, true>(F.lds + RING_OFF, g, SS, E); }
        else if constexpr (R::HAS_SSQ) { if (one_unit) { EpiDrain<R> E{r, ssq_dst}; pg8::gemm_phase<EpiDrain<R>, pg8::StaticOrder, false, true>(F.lds + RING_OFF, g, S, E); } }
        else { EpiFast<R> E{r, ssq_dst, 0, sdum}; pg8::gemm_phase<EpiFast<R>, pg8::StaticOrder, true, true>(F.lds + RING_OFF, g, S, E); }
    }
    const int rb0 = (FAST_GEMM && (skip_main || !R::HAS_SSQ || one_unit)) ? MAIN / 64 : 0, nrb = MROWS / 64 - rb0, ncu = (N / 256) * 4, nun = nrb * ncu;
    const int nsl = (FAST_GEMM && tail_off == 0 && rb0 != 0) ? (256 / ncu > 8 ? 8 : 256 / ncu) : 1;
    const int tfirst = tail_off < F.G ? tail_off : 0;
    _Pragma("unroll 1") for (int rep_ = 0; rep_ < ((((MK_REPEAT >> 14) & 1) != 0 && PH != 6) ? 2 : 1); ++rep_)
    if ((int)blockIdx.x >= tfirst) for (int u = (int)blockIdx.x - tfirst; u < nun * nsl; u += F.G - tfirst) {
        const int uu = u / nsl, slice = u % nsl, rb = rb0 + uu / ncu, cu = uu % ncu;
        gemm_simple_unit<R>(F, A, Bt, K, N, rb * 64, cu >> 2, cu & 3, slice, nsl, r, (((MK_REPEAT >> 14) & 1) != 0 && PH != 6 && rep_ == 0) ? ssq_ptr(F, 3) : ssq_dst, final_tail && nsl > 1);
    }
}
namespace dattn {
typedef short bf16x8 __attribute__((ext_vector_type(8)));
typedef short s16x4 __attribute__((ext_vector_type(4)));
typedef float f32x16 __attribute__((ext_vector_type(16)));
typedef float f32x4 __attribute__((ext_vector_type(4)));
typedef unsigned u32x4 __attribute__((ext_vector_type(4)));
constexpr int NW = 8, QBLK = 32, KVBLK = 64, QB = 128, D = 128, PITCH = 1024;
constexpr int SHM_V = KVBLK * D * 2, SHM_K = KVBLK * D * 2;
constexpr int LDS_X = 2 * SHM_V + 2 * SHM_K;
constexpr int LDS_WSF = MISC_OFF + 256;
static_assert(LDS_X + 65536 <= RING_BYTES && LDS_WSF + NW * 512 + 16 <= LDS_BYTES, "attention LDS map");
constexpr float SCALE = 0.125f, THR = 8.f;
constexpr int NSPLIT = 4, OPW = 132;

#define KSWZ(row, colB) ((row) * 256 + ((colB) ^ (((row) & 7) << 4)))
#define SBAR() __builtin_amdgcn_sched_barrier(0)
__device__ __forceinline__ int v_st(int k, int c) { const int kk = (k & ~0xC) | ((k & 4) << 1) | ((k & 8) >> 1); return ((kk >> 3) * 4 + (c >> 5)) * 512 + ((kk & 7) * 32 + (c & 31)) * 2; }
__device__ __forceinline__ int v_rd_base(int lane) { return ((lane & 3) << 3) | (((lane >> 2) & 3) << 6) | (((lane >> 4) & 1) << 5) | (((lane >> 5) & 1) << 8); }
constexpr int v_rd_off(int d0, int ks, int half) { return d0 * 512 + ks * 4096 + half * 2048; }
__device__ __forceinline__ int crow(int r, int hi) { return (r & 3) + 8 * (r >> 2) + 4 * hi; }
__device__ __forceinline__ unsigned cvtpk(float lo, float hi) { unsigned r; asm volatile("v_cvt_pk_bf16_f32 %0, %1, %2" : "=v"(r) : "v"(lo), "v"(hi)); return r; }
__device__ __forceinline__ bf16x8 pack8(f32x4 a, f32x4 b) { u32x4 w = {cvtpk(a[0], a[1]), cvtpk(a[2], a[3]), cvtpk(b[0], b[1]), cvtpk(b[2], b[3])}; return *reinterpret_cast<bf16x8*>(&w); }
__device__ __forceinline__ void mask_tile(f32x16& p0, f32x16& p1, int dq) {
    const float NEG = -__builtin_inff();
#pragma unroll
    for (int r = 0; r < 16; ++r) { const int c = (r & 3) + 8 * (r >> 2); if (dq - c < 0) p0[r] = NEG; if (dq - c - 32 < 0) p1[r] = NEG; }
}
__device__ __forceinline__ void partialSM(f32x16& p0, f32x16& p1, float& m_reg, float& mn, float& alpha, float T0, float T1) {
    float pm0 = p0[0], pm1 = p1[0];
#pragma unroll
    for (int r = 1; r < 16; ++r) { pm0 = fmaxf(pm0, p0[r]); pm1 = fmaxf(pm1, p1[r]); }
    float pmax = fmaxf(pm0 + T0, pm1 + T1);
    { auto rr = __builtin_amdgcn_permlane32_swap(__float_as_uint(pmax), __float_as_uint(pmax), false, false);
      pmax = fmaxf(__uint_as_float(rr[0]), __uint_as_float(rr[1])); }
    constexpr float C2 = 1.4426950408889634f * SCALE;
    if (__builtin_expect(__all((pmax - m_reg) * SCALE <= THR), 1)) { mn = m_reg; alpha = 1.f; }
    else { mn = fmaxf(m_reg, pmax); alpha = __builtin_amdgcn_exp2f((m_reg - mn) * C2); m_reg = mn; }
    const float L0 = (T0 - mn) * C2, L1 = (T1 - mn) * C2;
#pragma unroll
    for (int r = 0; r < 16; ++r) p0[r] = fmaf(p0[r], C2, L0);
#pragma unroll
    for (int r = 0; r < 16; ++r) p1[r] = fmaf(p1[r], C2, L1);
#pragma unroll
    for (int r = 0; r < 16; ++r) p0[r] = __builtin_amdgcn_exp2f(p0[r]);
}
__device__ __forceinline__ void finishSM(f32x16& p0, f32x16& p1, float alpha, float& l_reg, bf16x8& pa0, bf16x8& pa1, bf16x8& pa2, bf16x8& pa3) {
#pragma unroll
    for (int r = 0; r < 16; ++r) p1[r] = __builtin_amdgcn_exp2f(p1[r]);
    float ps = 0;
#pragma unroll
    for (int r = 0; r < 16; ++r) ps += p0[r];
#pragma unroll
    for (int r = 0; r < 16; ++r) ps += p1[r];
    { auto rr = __builtin_amdgcn_permlane32_swap(__float_as_uint(ps), __float_as_uint(ps), false, false);
      ps = __uint_as_float(rr[0]) + __uint_as_float(rr[1]); }
    l_reg = l_reg * alpha + ps;
#define PK4(P, B_, OUT) do { unsigned a0 = cvtpk(P[B_+0], P[B_+1]), a1 = cvtpk(P[B_+2], P[B_+3]);                          \
        unsigned b0 = cvtpk(P[B_+4], P[B_+5]), b1 = cvtpk(P[B_+6], P[B_+7]);                                             \
        auto r0 = __builtin_amdgcn_permlane32_swap(a0, b0, false, false); auto r1 = __builtin_amdgcn_permlane32_swap(a1, b1, false, false); \
        u32x4 w = {r0[0], r1[0], r0[1], r1[1]}; OUT = *reinterpret_cast<bf16x8*>(&w); } while (0)
    PK4(p0, 0, pa0); PK4(p0, 8, pa1); PK4(p1, 0, pa2); PK4(p1, 8, pa3);
#undef PK4
}
template <int KB>
__device__ __forceinline__ void qkt(f32x16& p0, f32x16& p1, const char* K_lds, int r32, int hi, int sub, const bf16x8* qr, const float* cvp_) {
    unsigned cvo = (unsigned)(uintptr_t)cvp_; asm volatile("" : "+v"(cvo));
    const __attribute__((address_space(3))) float* cvp = (const __attribute__((address_space(3))) float*)cvo;
    f32x16 cvec;
#pragma unroll
    for (int q4 = 0; q4 < 4; ++q4) { const f32x4 t = *(const __attribute__((address_space(3))) f32x4*)(cvp + 4 * q4); cvec[4 * q4] = t[0]; cvec[4 * q4 + 1] = t[1]; cvec[4 * q4 + 2] = t[2]; cvec[4 * q4 + 3] = t[3]; }
    const char* kb[4];
#pragma unroll
    for (int dd = 0; dd < 4; ++dd) kb[dd] = K_lds + KB * SHM_K + KSWZ(r32, (dd * 16 + hi * 8) * 2) + sub * 128;
#pragma unroll
    for (int dd = 0; dd < 4; ++dd) {
        bf16x8 b0 = *reinterpret_cast<const bf16x8*>(kb[dd]);
        bf16x8 b1 = *reinterpret_cast<const bf16x8*>(kb[dd] + 32 * 256);
        if (dd == 0) { p0 = __builtin_amdgcn_mfma_f32_32x32x16_bf16(b0, qr[0], cvec, 0, 0, 0); p1 = __builtin_amdgcn_mfma_f32_32x32x16_bf16(b1, qr[0], cvec, 0, 0, 0); }
        else { p0 = __builtin_amdgcn_mfma_f32_32x32x16_bf16(b0, qr[dd], p0, 0, 0, 0); p1 = __builtin_amdgcn_mfma_f32_32x32x16_bf16(b1, qr[dd], p1, 0, 0, 0); } }
}
template <int VB>
__device__ __forceinline__ void pv_tile(f32x16* o, int vb0, bf16x8 pa0, bf16x8 pa1, bf16x8 pa2, bf16x8 pa3) {
#define TRRD(dst, off) asm volatile("ds_read_b64_tr_b16 %0, %1 offset:%2" : "=&v"(dst) : "v"(vb0), "i"(off) : "memory")
#define PV_D0(d0) do { s16x4 l0, l1, l2, l3, h0, h1, h2, h3; constexpr int b_ = VB * SHM_V + v_rd_off(d0, 0, 0); \
        TRRD(l0, b_); TRRD(h0, b_ + 2048); TRRD(l1, b_ + 4096); TRRD(h1, b_ + 6144); TRRD(l2, b_ + 8192); TRRD(h2, b_ + 10240); TRRD(l3, b_ + 12288); TRRD(h3, b_ + 14336); \
        asm volatile("s_waitcnt lgkmcnt(0)" ::: "memory"); SBAR();   \
        o[d0] = __builtin_amdgcn_mfma_f32_32x32x16_bf16(pa0, (bf16x8){l0[0], l0[1], l0[2], l0[3], h0[0], h0[1], h0[2], h0[3]}, o[d0], 0, 0, 0);   \
        o[d0] = __builtin_amdgcn_mfma_f32_32x32x16_bf16(pa1, (bf16x8){l1[0], l1[1], l1[2], l1[3], h1[0], h1[1], h1[2], h1[3]}, o[d0], 0, 0, 0);   \
        o[d0] = __builtin_amdgcn_mfma_f32_32x32x16_bf16(pa2, (bf16x8){l2[0], l2[1], l2[2], l2[3], h2[0], h2[1], h2[2], h2[3]}, o[d0], 0, 0, 0);   \
        o[d0] = __builtin_amdgcn_mfma_f32_32x32x16_bf16(pa3, (bf16x8){l3[0], l3[1], l3[2], l3[3], h3[0], h3[1], h3[2], h3[3]}, o[d0], 0, 0, 0); } while (0)
    PV_D0(0); PV_D0(1); PV_D0(2); PV_D0(3);
#undef PV_D0
#undef TRRD
}

template <int VB>
__device__ __forceinline__ void pv_tile2(f32x16* o, int vb0, bf16x8 pa0, bf16x8 pa1, bf16x8 pa2, bf16x8 pa3) {
#define TRRD(dst, off) asm volatile("ds_read_b64_tr_b16 %0, %1 offset:%2" : "=&v"(dst) : "v"(vb0), "i"(off) : "memory")
#define PV_RD(X, d0) do { constexpr int b_ = VB * SHM_V + v_rd_off(d0, 0, 0); \
        TRRD(X##l0, b_); TRRD(X##h0, b_ + 2048); TRRD(X##l1, b_ + 4096); TRRD(X##h1, b_ + 6144); TRRD(X##l2, b_ + 8192); TRRD(X##h2, b_ + 10240); TRRD(X##l3, b_ + 12288); TRRD(X##h3, b_ + 14336); } while (0)
#define PV_MM(X, d0) do { \
        o[d0] = __builtin_amdgcn_mfma_f32_32x32x16_bf16(pa0, (bf16x8){X##l0[0], X##l0[1], X##l0[2], X##l0[3], X##h0[0], X##h0[1], X##h0[2], X##h0[3]}, o[d0], 0, 0, 0);   \
        o[d0] = __builtin_amdgcn_mfma_f32_32x32x16_bf16(pa1, (bf16x8){X##l1[0], X##l1[1], X##l1[2], X##l1[3], X##h1[0], X##h1[1], X##h1[2], X##h1[3]}, o[d0], 0, 0, 0);   \
        o[d0] = __builtin_amdgcn_mfma_f32_32x32x16_bf16(pa2, (bf16x8){X##l2[0], X##l2[1], X##l2[2], X##l2[3], X##h2[0], X##h2[1], X##h2[2], X##h2[3]}, o[d0], 0, 0, 0);   \
        o[d0] = __builtin_amdgcn_mfma_f32_32x32x16_bf16(pa3, (bf16x8){X##l3[0], X##l3[1], X##l3[2], X##l3[3], X##h3[0], X##h3[1], X##h3[2], X##h3[3]}, o[d0], 0, 0, 0); } while (0)
    s16x4 Al0, Al1, Al2, Al3, Ah0, Ah1, Ah2, Ah3, Bl0, Bl1, Bl2, Bl3, Bh0, Bh1, Bh2, Bh3;
    PV_RD(A, 0); PV_RD(B, 1);
    asm volatile("s_waitcnt lgkmcnt(8)" ::: "memory"); SBAR(); PV_MM(A, 0); SBAR(); PV_RD(A, 2);
    asm volatile("s_waitcnt lgkmcnt(8)" ::: "memory"); SBAR(); PV_MM(B, 1); SBAR(); PV_RD(B, 3);
    asm volatile("s_waitcnt lgkmcnt(8)" ::: "memory"); SBAR(); PV_MM(A, 2);
    asm volatile("s_waitcnt lgkmcnt(0)" ::: "memory"); SBAR(); PV_MM(B, 3);
#undef PV_RD
#undef PV_MM
#undef TRRD
}

struct Blk { const bf16* Q; const void* K; const void* V; const float* Kn; const float* Vn; const int* pt; void* O; int P0, t0, NT; float A; };
template <bool DEC> __device__ __forceinline__ const void* tile_ptr(const Blk& b, const void* base, const float* nw, int t) {
    const int gt = b.t0 + t;
    if constexpr (!DEC) { return (const bf16*)base + (size_t)gt * KVBLK * PITCH; }
    else { if (gt >= PAST / KVBLK) return nw; const int pg = ((const __attribute__((address_space(4))) int*)(unsigned long long)b.pt)[gt >> 1];   return (const float*)base + ((size_t)pg * PAGE + (gt & 1) * KVBLK) * PITCH; }
}
struct Seam { bf16x8 qr[4]; bf16x8 st_v0, st_v1, st_k0, st_k1; f32x4 sf0, sf1, sf2, sf3; };
#define VMW() asm volatile("s_waitcnt vmcnt(0)" ::: "memory")
#define VMWN(n) asm volatile("s_waitcnt vmcnt(%0)" :: "i"(n) : "memory")
#define ROWH(p, half) ((const bf16*)(p) + (half) * 32 * PITCH + toff)
#define ROWF(p, half) ((const float*)(p) + (half) * 32 * PITCH + toff)
#define SLOAD_H(Kp, Vp) do { S.st_v0 = *(const bf16x8*)ROWH(Vp, 0); S.st_v1 = *(const bf16x8*)ROWH(Vp, 1); S.st_k0 = *(const bf16x8*)ROWH(Kp, 0); S.st_k1 = *(const bf16x8*)ROWH(Kp, 1); } while (0)
#define SWRITE_HK(bf) do { *(bf16x8*)(K_lds + (bf) * SHM_K + kws) = S.st_k0; *(bf16x8*)(K_lds + (bf) * SHM_K + kws + 32 * 256) = S.st_k1; } while (0)
#define SWRITE_HV(bf) do { *(bf16x8*)(V_lds + (bf) * SHM_V + vst0) = S.st_v0; *(bf16x8*)(V_lds + (bf) * SHM_V + vst0 + 8192) = S.st_v1; } while (0)
#define SWRITE_H(bf) do { SWRITE_HV(bf); SWRITE_HK(bf); } while (0)
#define SLOAD_F(p) do { S.sf0 = *(const f32x4*)ROWF(p, 0); S.sf1 = *(const f32x4*)(ROWF(p, 0) + 4); S.sf2 = *(const f32x4*)ROWF(p, 1); S.sf3 = *(const f32x4*)(ROWF(p, 1) + 4); } while (0)
#define SWRITE_KF(bf) do { *(bf16x8*)(K_lds + (bf) * SHM_K + kws) = pack8(S.sf0, S.sf1); *(bf16x8*)(K_lds + (bf) * SHM_K + kws + 32 * 256) = pack8(S.sf2, S.sf3); } while (0)
#define SWRITE_VF(bf) do { *(bf16x8*)(V_lds + (bf) * SHM_V + vst0) = pack8(S.sf0, S.sf1); *(bf16x8*)(V_lds + (bf) * SHM_V + vst0 + 8192) = pack8(S.sf2, S.sf3); } while (0)
#define QLOAD(blk) do { const bf16* q_ = (blk).Q + (unsigned)((DEC ? (r32 & 3) : ((wid & 3) * QBLK + r32)) * PITCH + sub * 64 + hi * 8); \
        _Pragma("unroll") for (int d0 = 0; d0 < 4; ++d0) S.qr[d0] = *(const bf16x8*)(q_ + d0 * 16); } while (0)
template <bool DEC>
__device__ __forceinline__ void attn_prime(const Blk& cur, char* lds, Seam& S) {
    const int tid = threadIdx.x, wid = __builtin_amdgcn_readfirstlane(tid >> 6), lane = tid & 63, r32 = lane & 31, hi = lane >> 5, sub = wid >> 2;
    const int sr = tid >> 4, sc = (tid & 15) * 8, kws = KSWZ(sr, sc * 2); char* K_lds = lds + 2 * SHM_V;
    const unsigned toff = (unsigned)(sr * PITCH + sc);
    QLOAD(cur);
    const void* k0 = tile_ptr<DEC>(cur, cur.K, cur.Kn, 0); const void* v0 = tile_ptr<DEC>(cur, cur.V, cur.Vn, 0);
    if constexpr (DEC) { SLOAD_F(k0); VMW(); SWRITE_KF(0); SBAR(); SLOAD_F(v0); }
    else { SLOAD_H(k0, v0); VMW(); SWRITE_HK(0); }
    __syncthreads();
}
template <bool DEC>
__device__ __forceinline__ void attn_block(const Blk& cur, const Blk& nxt, float lam, const float* gain, char* lds, Seam& S) {
    constexpr bool F32 = DEC;
    const int tid = threadIdx.x, wid = __builtin_amdgcn_readfirstlane(tid >> 6), lane = tid & 63, r32 = lane & 31, hi = lane >> 5, sub = wid >> 2;
    const bool act = DEC ? ((wid & 3) == sub) : true;
    const int NT = cur.NT;
    const int qlo = cur.P0 + (DEC ? 0 : (wid & 3) * QBLK);
    char* V_lds = lds; char* K_lds = lds + 2 * SHM_V;
    float* ws = (float*)(lds + LDS_WSF) + wid * 128; float* li_l = ws, * al_l = ws + 32;
    float m_reg = -1e30f, l_reg = 0; f32x16 o[4] = {};
    const int sr = tid >> 4, sc = (tid & 15) * 8, vst0 = v_st(sr, sc), kws = KSWZ(sr, sc * 2);
    const unsigned toff = (unsigned)(sr * PITCH + sc);
    const int vb0 = (int)(uintptr_t)V_lds + v_rd_base(lane);
    const float A = cur.A;
    const float* cvec = ws + 64 + hi * 16;
    if (r32 < 16) ws[64 + lane - 16 * hi] = A * (float)crow(lane & 15, hi);
    asm volatile("s_waitcnt lgkmcnt(0)" ::: "memory");
#define RESC(a) do { if (__any((a) < 1.f)) { if (hi == 0) al_l[r32] = (a); asm volatile("s_waitcnt lgkmcnt(0)" ::: "memory");              \
                     _Pragma("unroll") for (int d_ = 0; d_ < 4; ++d_) _Pragma("unroll") for (int r = 0; r < 16; ++r) o[d_][r] *= al_l[crow(r, hi)]; } } while (0)
#define KBASE(t) ((cur.t0 + (t)) * KVBLK)
#define KP(t) tile_ptr<DEC>(cur, cur.K, cur.Kn, (t))
#define VP(t) tile_ptr<DEC>(cur, cur.V, cur.Vn, (t))
#define TOFF(t) (A * (float)(KBASE(t) - cur.P0))
#define MASKT(P0_, P1_, t) do { const int kb_ = KBASE(t); if (kb_ + KVBLK - 1 > qlo) { unsigned l_; asm volatile("v_mbcnt_lo_u32_b32 %0, -1, 0\n\tv_mbcnt_hi_u32_b32 %0, -1, %0" : "=v"(l_)); mask_tile(P0_, P1_, qlo + (int)(l_ & 31u) - 4 * (int)(l_ >> 5) - kb_); } } while (0)
#define PSM(P0_, P1_, mnX, alX, t) do { const float t0_ = TOFF(t); partialSM(P0_, P1_, m_reg, mnX, alX, t0_, t0_ + 32.f * A); } while (0)
    constexpr int NQL = 4;
#define SEAM_K0() do { VMWN(NQL); if constexpr (F32) { SWRITE_KF(0); SBAR(); SLOAD_F(nv0); } else { SWRITE_HK(0); } SBAR(); } while (0)
    const void* nk0 = tile_ptr<DEC>(nxt, nxt.K, nxt.Kn, 0); const void* nv0 = tile_ptr<DEC>(nxt, nxt.V, nxt.Vn, 0);
    f32x16 pA0, pA1, pB0, pB1; float mnA, mnB, alA = 1.f, alB = 1.f; bf16x8 pa0, pa1, pa2, pa3;
    if constexpr (F32) { VMW(); SWRITE_VF(0); SBAR(); } else { SWRITE_HV(0); SBAR(); }
    if (NT > 1) { if constexpr (F32) SLOAD_F(KP(1)); else SLOAD_H(KP(1), VP(1)); }
    SBAR(); if (act) qkt<0>(pA0, pA1, K_lds, r32, hi, sub, S.qr, cvec);
    if constexpr (F32) { if (NT > 1) { VMW(); SWRITE_KF(1); SBAR(); SLOAD_F(VP(1)); } }
    if (act) { MASKT(pA0, pA1, 0); PSM(pA0, pA1, mnA, alA, 0); }
    if (NT > 1) { VMW(); if constexpr (F32) { SWRITE_VF(1); SBAR(); if (NT > 2) SLOAD_F(KP(2)); } else SWRITE_H(1); }
    __syncthreads();
#define HALF_STEP(PX0, PX1, mnX, alX, PY0, PY1, alY, t, KB, VB, SB) do {                                                      \
        SBAR(); if (act) qkt<KB>(PX0, PX1, K_lds, r32, hi, sub, S.qr, cvec);                                                   \
        if (act) finishSM(PY0, PY1, alY, l_reg, pa0, pa1, pa2, pa3); SBAR();                                                   \
        if ((t) + 1 < NT) { if constexpr (F32) { VMW(); SWRITE_KF(SB); SBAR(); SLOAD_F(VP((t) + 1)); }                       \
                            else { SLOAD_H(KP((t) + 1), VP((t) + 1)); } SBAR(); }                                             \
        if (act) { pv_tile<VB>(o, vb0, pa0, pa1, pa2, pa3); MASKT(PX0, PX1, (t)); PSM(PX0, PX1, mnX, alX, (t)); }             \
        __syncthreads();                                                                                                      \
        if ((t) + 1 < NT) { VMW(); if constexpr (F32) { SWRITE_VF(SB); SBAR(); if ((t) + 2 < NT) SLOAD_F(KP((t) + 2)); }     \
                            else { SWRITE_H(SB); } }                                                                          \
        if (act) RESC(alX); __syncthreads(); } while (0)
    for (int t = 1; t + 1 < NT; t += 2) {
        HALF_STEP(pB0, pB1, mnB, alB, pA0, pA1, alA, t, 1, 0, 0);
        HALF_STEP(pA0, pA1, mnA, alA, pB0, pB1, alB, t + 1, 0, 1, 1);
    }
    const bool even = (NT & 1) == 0;
    if (even) { SBAR(); if (act) qkt<1>(pB0, pB1, K_lds, r32, hi, sub, S.qr, cvec); SBAR(); }
    if constexpr (F32) { SLOAD_F(nk0); SBAR(); } else { SLOAD_H(nk0, nv0); SBAR(); }
    QLOAD(nxt);
    SBAR();
    if (act) finishSM(pA0, pA1, alA, l_reg, pa0, pa1, pa2, pa3);
    SBAR();
    if (act) pv_tile<0>(o, vb0, pa0, pa1, pa2, pa3);
    if (even) { if (act) { MASKT(pB0, pB1, NT - 1); PSM(pB0, pB1, mnB, alB, NT - 1); } __syncthreads(); if (act) { RESC(alB);
        finishSM(pB0, pB1, alB, l_reg, pa0, pa1, pa2, pa3); SBAR(); pv_tile<1>(o, vb0, pa0, pa1, pa2, pa3); } }
    SBAR(); SEAM_K0();
    if (act && hi == 0) li_l[r32] = l_reg;
    asm volatile("s_waitcnt lgkmcnt(0)" ::: "memory");
    if constexpr (DEC) {
        if (act) {
            float* op = (float*)cur.O + (size_t)sub * 4 * OPW;
            if (hi == 0) {
#pragma unroll
                for (int r = 0; r < 4; ++r)
#pragma unroll
                    for (int d0 = 0; d0 < 4; ++d0) op[(unsigned)(r * OPW + d0 * 32 + r32)] = o[d0][r];
                if (r32 < 4) { op[(unsigned)(r32 * OPW + 128)] = m_reg; op[(unsigned)(r32 * OPW + 129)] = l_reg; }
            }
        }
        __syncthreads();
    } else {
        int lane_o = lane; asm volatile("" : "+v"(lane_o));
        float rli[16];
#pragma unroll
        for (int r = 0; r < 16; ++r) rli[r] = __builtin_amdgcn_rcpf(li_l[crow(r, hi)]);
        float* X = (float*)(lds + LDS_X) + (wid & 3) * 4096 + lane_o;
        if (sub == 1) {
#pragma unroll
            for (int d0 = 0; d0 < 4; ++d0)
#pragma unroll
                for (int r = 0; r < 16; ++r) X[(d0 * 16 + r) * 64] = lam * (o[d0][r] * rli[r]);
        }
        __syncthreads();
        if (sub == 0) {
            float ssr[16];
#pragma unroll
            for (int r = 0; r < 16; ++r) { float s = 0.f;
#pragma unroll
                for (int d0 = 0; d0 < 4; ++d0) { const float x = o[d0][r] * rli[r] - X[(d0 * 16 + r) * 64]; o[d0][r] = x; s += x * x; }
                ssr[r] = s; }
#pragma unroll
            for (int r = 0; r < 16; ++r) {
#pragma unroll
                for (int off = 1; off < 32; off <<= 1) ssr[r] += __shfl_xor(ssr[r], off); }
            float g[4];
#pragma unroll
            for (int d0 = 0; d0 < 4; ++d0) g[d0] = gain[d0 * 32 + (lane_o & 31)] * 0.8f;
            const int r32o = lane_o & 31, hio = lane_o >> 5;
            char* Ow = (char*)cur.O + (unsigned)((((wid & 3) * QBLK + 4 * hio) * DM + r32o) * 2);
#pragma unroll
            for (int r = 0; r < 16; ++r) { const int orow = (r & 3) + 8 * (r >> 2); const float rn = rsqrtf(ssr[r] * (1.f / D) + EPS);
#pragma unroll
                for (int d0 = 0; d0 < 4; ++d0) { const float v = o[d0][r] * rn * g[d0]; const float vn = __shfl_xor(v, 1);
                    if ((r32 & 1) == 0) *(unsigned*)(Ow + (orow * DM + d0 * 32) * 2) = cvtpk(v, vn); } }
        }
        __syncthreads();
    }
#undef RESC
#undef KBASE
#undef KP
#undef VP
#undef TOFF
#undef MASKT
#undef PSM
#undef SEAM_K0
#undef HALF_STEP
}
struct DmaOff { unsigned k0, k1, v0, v1; };
__device__ __forceinline__ DmaOff dma_off(int wid, int lane) {
    DmaOff d; unsigned ko[2], vo[2];
#pragma unroll
    for (int i = 0; i < 2; ++i) {
        const int row = (2 * wid + i) * 4 + (lane >> 4), colB = ((lane & 15) * 16) ^ ((row & 7) << 4);
        ko[i] = (unsigned)(row * PITCH + (colB >> 1));
        const int bk = (2 * wid + i) * 2 + (lane >> 5), kk = (bk >> 2) * 8 + ((lane & 31) >> 2), c = (bk & 3) * 32 + (lane & 3) * 8, k = (kk & ~0xC) | ((kk & 4) << 1) | ((kk & 8) >> 1);
        vo[i] = (unsigned)(k * PITCH + c); }
    d.k0 = ko[0]; d.k1 = ko[1]; d.v0 = vo[0]; d.v1 = vo[1]; return d;
}
#define DMA16(gp, lp) __builtin_amdgcn_global_load_lds((const unsigned*)(gp), (__attribute__((address_space(3))) unsigned*)(unsigned)(uintptr_t)(lp), 16, 0, 0)
#define DMA_K(Kp, bf) do { DMA16((const bf16*)(Kp) + dof.k0, K_lds + (bf) * SHM_K + wid * 2048); DMA16((const bf16*)(Kp) + dof.k1, K_lds + (bf) * SHM_K + wid * 2048 + 1024); } while (0)
#define DMA_V(Vp, bf) do { DMA16((const bf16*)(Vp) + dof.v0, V_lds + (bf) * SHM_V + wid * 2048); DMA16((const bf16*)(Vp) + dof.v1, V_lds + (bf) * SHM_V + wid * 2048 + 1024); } while (0)
__device__ __forceinline__ void attn_prime_p(const Blk& cur, char* lds, Seam& S) {
    constexpr bool DEC = false;
    const int tid = threadIdx.x, wid = __builtin_amdgcn_readfirstlane(tid >> 6), lane = tid & 63, r32 = lane & 31, hi = lane >> 5, sub = wid >> 2;
    char* V_lds = lds; char* K_lds = lds + 2 * SHM_V;
    const DmaOff dof = dma_off(wid, lane);
    QLOAD(cur);
    DMA_K(tile_ptr<false>(cur, cur.K, cur.Kn, 0), 0); DMA_V(tile_ptr<false>(cur, cur.V, cur.Vn, 0), 0);
}
__device__ __forceinline__ void attn_block_p(const Blk& cur, const Blk& nxt, float lam, const float* gain, char* lds, Seam& S) {
    constexpr bool DEC = false;
    const int tid = threadIdx.x, wid = __builtin_amdgcn_readfirstlane(tid >> 6), lane = tid & 63, r32 = lane & 31, hi = lane >> 5, sub = wid >> 2;
    constexpr bool act = true;
    const int NT = cur.NT;
    const int qlo = cur.P0 + (DEC ? 0 : (wid & 3) * QBLK);
    char* V_lds = lds; char* K_lds = lds + 2 * SHM_V;
    float* ws = (float*)(lds + LDS_WSF) + wid * 128; float* li_l = ws, * al_l = ws + 32;
    float m_reg = -1e30f, l_reg = 0; f32x16 o[4] = {};
    const DmaOff dof = dma_off(wid, lane);
    const int vb0 = (int)(uintptr_t)V_lds + v_rd_base(lane);
    const float A = cur.A;
    const float* cvec = ws + 64 + hi * 16;
    if (r32 < 16) ws[64 + lane - 16 * hi] = A * (float)crow(lane & 15, hi);
    asm volatile("s_waitcnt lgkmcnt(0)" ::: "memory");
#define RESC(a) do { if (__any((a) < 1.f)) { if (hi == 0) al_l[r32] = (a); asm volatile("s_waitcnt lgkmcnt(0)" ::: "memory");              \
                     _Pragma("unroll") for (int d_ = 0; d_ < 4; ++d_) _Pragma("unroll") for (int r = 0; r < 16; ++r) o[d_][r] *= al_l[crow(r, hi)]; } } while (0)
#define KBASE(t) ((cur.t0 + (t)) * KVBLK)
#define KP(t) tile_ptr<DEC>(cur, cur.K, cur.Kn, (t))
#define VP(t) tile_ptr<DEC>(cur, cur.V, cur.Vn, (t))
#define TOFF(t) (A * (float)(KBASE(t) - cur.P0))
#define MASKT(P0_, P1_, t) do { const int kb_ = KBASE(t); if (kb_ + KVBLK - 1 > qlo) { unsigned l_; asm volatile("v_mbcnt_lo_u32_b32 %0, -1, 0\n\tv_mbcnt_hi_u32_b32 %0, -1, %0" : "=v"(l_)); mask_tile(P0_, P1_, qlo + (int)(l_ & 31u) - 4 * (int)(l_ >> 5) - kb_); } } while (0)
#define PSM(P0_, P1_, mnX, alX, t) do { const float t0_ = TOFF(t); partialSM(P0_, P1_, m_reg, mnX, alX, t0_, t0_ + 32.f * A); } while (0)
    const void* nk0 = tile_ptr<DEC>(nxt, nxt.K, nxt.Kn, 0); const void* nv0 = tile_ptr<DEC>(nxt, nxt.V, nxt.Vn, 0);
    f32x16 pA0, pA1, pB0, pB1; float mnA, mnB, alA = 1.f, alB = 1.f; bf16x8 pa0, pa1, pa2, pa3;
    VMW(); __syncthreads();
    if (NT > 1) { DMA_K(KP(1), 1); DMA_V(VP(1), 1); }
    SBAR(); qkt<0>(pA0, pA1, K_lds, r32, hi, sub, S.qr, cvec);
    MASKT(pA0, pA1, 0); PSM(pA0, pA1, mnA, alA, 0);
    if (NT > 1) VMW();
    __syncthreads();
#define HALF_STEP(PX0, PX1, mnX, alX, PY0, PY1, alY, t, KB, VB, SB) do {                                                      \
        SBAR(); if ((t) + 1 < NT) { DMA_K(KP((t) + 1), SB); SBAR(); }                                                          \
        qkt<KB>(PX0, PX1, K_lds, r32, hi, sub, S.qr, cvec);                                                                    \
        finishSM(PY0, PY1, alY, l_reg, pa0, pa1, pa2, pa3); SBAR();                                                            \
        pv_tile2<VB>(o, vb0, pa0, pa1, pa2, pa3); MASKT(PX0, PX1, (t)); PSM(PX0, PX1, mnX, alX, (t));                           \
        __syncthreads();                                                                                                      \
        if ((t) + 1 < NT) { DMA_V(VP((t) + 1), SB); SBAR(); }                                                                  \
        RESC(alX);                                                                                                            \
        if ((t) + 1 < NT) VMWN(2); else VMW();                                                                                 \
        __syncthreads(); } while (0)
    for (int t = 1; t + 1 < NT; t += 2) {
        HALF_STEP(pB0, pB1, mnB, alB, pA0, pA1, alA, t, 1, 0, 0);
        HALF_STEP(pA0, pA1, mnA, alA, pB0, pB1, alB, t + 1, 0, 1, 1);
    }
    const bool even = (NT & 1) == 0;
    if (even) { SBAR(); qkt<1>(pB0, pB1, K_lds, r32, hi, sub, S.qr, cvec); SBAR(); }
    QLOAD(nxt);
    SBAR();
    finishSM(pA0, pA1, alA, l_reg, pa0, pa1, pa2, pa3);
    SBAR();
    pv_tile2<0>(o, vb0, pa0, pa1, pa2, pa3);
    if (even) { MASKT(pB0, pB1, NT - 1); PSM(pB0, pB1, mnB, alB, NT - 1); }
    VMW(); __syncthreads();
    DMA_K(nk0, 0); DMA_V(nv0, 0); SBAR();
    if (even) { RESC(alB); finishSM(pB0, pB1, alB, l_reg, pa0, pa1, pa2, pa3); SBAR(); pv_tile2<1>(o, vb0, pa0, pa1, pa2, pa3); }
    SBAR();
    if (hi == 0) li_l[r32] = l_reg;
    asm volatile("s_waitcnt lgkmcnt(0)" ::: "memory");
    if constexpr (DEC) {
        if (act) {
            float* op = (float*)cur.O + (size_t)sub * 4 * OPW;
            if (hi == 0) {
#pragma unroll
                for (int r = 0; r < 4; ++r)
#pragma unroll
                    for (int d0 = 0; d0 < 4; ++d0) op[(unsigned)(r * OPW + d0 * 32 + r32)] = o[d0][r];
                if (r32 < 4) { op[(unsigned)(r32 * OPW + 128)] = m_reg; op[(unsigned)(r32 * OPW + 129)] = l_reg; }
            }
        }
        __syncthreads();
    } else {
        int lane_o = lane; asm volatile("" : "+v"(lane_o));
        float rli[16];
#pragma unroll
        for (int r = 0; r < 16; ++r) rli[r] = __builtin_amdgcn_rcpf(li_l[crow(r, hi)]);
        float* X = (float*)(lds + LDS_X) + (wid & 3) * 4096 + lane_o;
        if (sub == 1) {
#pragma unroll
            for (int d0 = 0; d0 < 4; ++d0)
#pragma unroll
                for (int r = 0; r < 16; ++r) X[(d0 * 16 + r) * 64] = lam * (o[d0][r] * rli[r]);
        }
        __syncthreads();
        if (sub == 0) {
            float ssr[16];
#pragma unroll
            for (int r = 0; r < 16; ++r) { float s = 0.f;
#pragma unroll
                for (int d0 = 0; d0 < 4; ++d0) { const float x = o[d0][r] * rli[r] - X[(d0 * 16 + r) * 64]; o[d0][r] = x; s += x * x; }
                ssr[r] = s; }
#pragma unroll
            for (int r = 0; r < 16; ++r) {
#pragma unroll
                for (int off = 1; off < 32; off <<= 1) ssr[r] += __shfl_xor(ssr[r], off); }
            float g[4];
#pragma unroll
            for (int d0 = 0; d0 < 4; ++d0) g[d0] = gain[d0 * 32 + (lane_o & 31)] * 0.8f;
            const int r32o = lane_o & 31, hio = lane_o >> 5;
            char* Ow = (char*)cur.O + (unsigned)((((wid & 3) * QBLK + 4 * hio) * DM + r32o) * 2);
#pragma unroll
            for (int r = 0; r < 16; ++r) { const int orow = (r & 3) + 8 * (r >> 2); const float rn = rsqrtf(ssr[r] * (1.f / D) + EPS);
#pragma unroll
                for (int d0 = 0; d0 < 4; ++d0) { const float v = o[d0][r] * rn * g[d0]; const float vn = __shfl_xor(v, 1);
                    if ((r32 & 1) == 0) *(unsigned*)(Ow + (orow * DM + d0 * 32) * 2) = cvtpk(v, vn); } }
        }
        __syncthreads();
    }
#undef RESC
#undef KBASE
#undef KP
#undef VP
#undef TOFF
#undef MASKT
#undef PSM
#undef HALF_STEP
}
#undef DMA16
#undef DMA_K
#undef DMA_V

struct StageF { f32x4 k0, k1, k2, k3, v0, v1, v2, v3; };
#define DLOAD(R, Kp, Vp) do { const float* k_ = ROWF(Kp, 0); const float* k2_ = ROWF(Kp, 1); const float* v_ = ROWF(Vp, 0); const float* v2_ = ROWF(Vp, 1); \
        R.k0 = *(const f32x4*)k_; R.k1 = *(const f32x4*)(k_ + 4); R.k2 = *(const f32x4*)k2_; R.k3 = *(const f32x4*)(k2_ + 4); \
        R.v0 = *(const f32x4*)v_; R.v1 = *(const f32x4*)(v_ + 4); R.v2 = *(const f32x4*)v2_; R.v3 = *(const f32x4*)(v2_ + 4); } while (0)
#define DWRITE(R, bf) do { *(bf16x8*)(K_lds + (bf) * SHM_K + kws) = pack8(R.k0, R.k1); *(bf16x8*)(K_lds + (bf) * SHM_K + kws + 32 * 256) = pack8(R.k2, R.k3); \
        *(bf16x8*)(V_lds + (bf) * SHM_V + vst0) = pack8(R.v0, R.v1); *(bf16x8*)(V_lds + (bf) * SHM_V + vst1) = pack8(R.v2, R.v3); } while (0)
template <int KB>
__device__ __forceinline__ void qkt_half(f32x16& p, const char* K_lds, int r32, int hi, int sub, int half, const bf16x8* qr, const float* cvp_) {
    unsigned cvo = (unsigned)(uintptr_t)cvp_; asm volatile("" : "+v"(cvo));
    const __attribute__((address_space(3))) float* cvp = (const __attribute__((address_space(3))) float*)cvo;
    f32x16 cvec;
#pragma unroll
    for (int q4 = 0; q4 < 4; ++q4) { const f32x4 t = *(const __attribute__((address_space(3))) f32x4*)(cvp + 4 * q4); cvec[4 * q4] = t[0]; cvec[4 * q4 + 1] = t[1]; cvec[4 * q4 + 2] = t[2]; cvec[4 * q4 + 3] = t[3]; }
    const char* kb[4];
#pragma unroll
    for (int dd = 0; dd < 4; ++dd) kb[dd] = K_lds + KB * SHM_K + KSWZ(r32, (dd * 16 + hi * 8) * 2) + sub * 128 + half * (32 * 256);
#pragma unroll
    for (int dd = 0; dd < 4; ++dd) { bf16x8 b0 = *reinterpret_cast<const bf16x8*>(kb[dd]);
        if (dd == 0) p = __builtin_amdgcn_mfma_f32_32x32x16_bf16(b0, qr[0], cvec, 0, 0, 0); else p = __builtin_amdgcn_mfma_f32_32x32x16_bf16(b0, qr[dd], p, 0, 0, 0); }
}
__device__ __forceinline__ void softmax_half(f32x16& p, float& m_reg, float& alpha, float& l_reg, float T, bf16x8& pa0, bf16x8& pa1) {
    float pm = p[0];
#pragma unroll
    for (int r = 1; r < 16; ++r) pm = fmaxf(pm, p[r]);
    float pmax = pm + T;
    { auto rr = __builtin_amdgcn_permlane32_swap(__float_as_uint(pmax), __float_as_uint(pmax), false, false);
      pmax = fmaxf(__uint_as_float(rr[0]), __uint_as_float(rr[1])); }
    constexpr float C2 = 1.4426950408889634f * SCALE;
    float mn;
    if (__builtin_expect(__all((pmax - m_reg) * SCALE <= THR), 1)) { mn = m_reg; alpha = 1.f; }
    else { mn = fmaxf(m_reg, pmax); alpha = __builtin_amdgcn_exp2f((m_reg - mn) * C2); m_reg = mn; }
    const float L = (T - mn) * C2;
    float ps = 0.f;
#pragma unroll
    for (int r = 0; r < 16; ++r) { p[r] = __builtin_amdgcn_exp2f(fmaf(p[r], C2, L)); ps += p[r]; }
    { auto rr = __builtin_amdgcn_permlane32_swap(__float_as_uint(ps), __float_as_uint(ps), false, false);
      ps = __uint_as_float(rr[0]) + __uint_as_float(rr[1]); }
    l_reg = l_reg * alpha + ps;
#define PK4(P, B_, OUT) do { unsigned a0 = cvtpk(P[B_+0], P[B_+1]), a1 = cvtpk(P[B_+2], P[B_+3]);                          \
        unsigned b0 = cvtpk(P[B_+4], P[B_+5]), b1 = cvtpk(P[B_+6], P[B_+7]);                                             \
        auto r0 = __builtin_amdgcn_permlane32_swap(a0, b0, false, false); auto r1 = __builtin_amdgcn_permlane32_swap(a1, b1, false, false); \
        u32x4 w = {r0[0], r1[0], r0[1], r1[1]}; OUT = *reinterpret_cast<bf16x8*>(&w); } while (0)
    PK4(p, 0, pa0); PK4(p, 8, pa1);
#undef PK4
}
template <int VB>
__device__ __forceinline__ void pv_half(f32x16* o, int vbh  , bf16x8 pa0, bf16x8 pa1) {
#define TRRD(dst, off) asm volatile("ds_read_b64_tr_b16 %0, %1 offset:%2" : "=&v"(dst) : "v"(vbh), "i"(off) : "memory")
    s16x4 l0[4], h0[4], l1[4], h1[4];
#define PV_RD(d0) do { constexpr int b_ = VB * SHM_V + v_rd_off(d0, 0, 0); TRRD(l0[d0], b_); TRRD(h0[d0], b_ + 2048); TRRD(l1[d0], b_ + 4096); TRRD(h1[d0], b_ + 6144); } while (0)
#define PV_MM(d0, PA, L_, H_) o[d0] = __builtin_amdgcn_mfma_f32_32x32x16_bf16(PA, (bf16x8){L_[d0][0], L_[d0][1], L_[d0][2], L_[d0][3], H_[d0][0], H_[d0][1], H_[d0][2], H_[d0][3]}, o[d0], 0, 0, 0)
    PV_RD(0); PV_RD(1); PV_RD(2); PV_RD(3);
    asm volatile("s_waitcnt lgkmcnt(8)" ::: "memory"); SBAR();
    PV_MM(0, pa0, l0, h0); PV_MM(1, pa0, l0, h0); PV_MM(0, pa1, l1, h1); PV_MM(1, pa1, l1, h1);
    asm volatile("s_waitcnt lgkmcnt(0)" ::: "memory"); SBAR();
    PV_MM(2, pa0, l0, h0); PV_MM(3, pa0, l0, h0); PV_MM(2, pa1, l1, h1); PV_MM(3, pa1, l1, h1);
#undef PV_RD
#undef PV_MM
#undef TRRD
}
struct DecFin { unsigned* cnt; const float* pbase; bf16* dst; const float* gain; float lam; };
__device__ __forceinline__ void dec_unit(const Blk& cur, char* lds, const DecFin& fin) {
    constexpr bool DEC = true;
    const int tid = threadIdx.x, wid = __builtin_amdgcn_readfirstlane(tid >> 6), lane = tid & 63, r32 = lane & 31, hi = lane >> 5, sub = wid >> 2, half = wid & 1;
    const bool act = sub == 0 ? (wid & 3) < 2 : (wid & 3) >= 2;
    const int NT = cur.NT;
    const int qlo = cur.P0, qm = qlo + r32 - 4 * hi - 32 * half;
    char* V_lds = lds; char* K_lds = lds + 2 * SHM_V;
    float* ws = (float*)(lds + LDS_WSF) + wid * 128; float* al_l = ws + 32;
    float m_reg = -1e30f, l_reg = 0; f32x16 o[4] = {};
    const int sr = tid >> 4, sc = (tid & 15) * 8, vst0 = v_st(sr, sc), vst1 = v_st(32 + sr, sc), kws = KSWZ(sr, sc * 2);
    const unsigned toff = (unsigned)(sr * PITCH + sc);
    const int vbh = (int)(uintptr_t)V_lds + v_rd_base(lane) + half * 8192;
    const float A = cur.A;
    const float* cvec = ws + 64 + hi * 16;
    if (r32 < 16) ws[64 + lane - 16 * hi] = A * (float)crow(lane & 15, hi);
    asm volatile("s_waitcnt lgkmcnt(0)" ::: "memory");
    Seam S; QLOAD(cur);
    StageF RA, RB;
#define KP(t) tile_ptr<true>(cur, cur.K, cur.Kn, (t))
#define VP(t) tile_ptr<true>(cur, cur.V, cur.Vn, (t))
#define KBASE(t) ((cur.t0 + (t)) * KVBLK)
#define PGE(t) (((const __attribute__((address_space(4))) int*)(unsigned long long)cur.pt)[((cur.t0 + (t)) >> 1) < NPAGE ? ((cur.t0 + (t)) >> 1) : NPAGE - 1])
#define PGK(pg, t) ((cur.t0 + (t)) >= PAST / KVBLK ? cur.Kn : (const float*)cur.K + ((size_t)(pg) * PAGE + ((cur.t0 + (t)) & 1) * KVBLK) * PITCH)
#define PGV(pg, t) ((cur.t0 + (t)) >= PAST / KVBLK ? cur.Vn : (const float*)cur.V + ((size_t)(pg) * PAGE + ((cur.t0 + (t)) & 1) * KVBLK) * PITCH)
#define COMPUTE(BUF, t) do { f32x16 p; float al; bf16x8 pa0, pa1; \
        qkt_half<BUF>(p, K_lds, r32, hi, sub, half, S.qr, cvec); \
        const int kb_ = KBASE(t); \
        if (kb_ + KVBLK - 1 > qlo) { const float NEG = -__builtin_inff(); _Pragma("unroll") for (int r = 0; r < 16; ++r) { const int c = (r & 3) + 8 * (r >> 2); if (qm - kb_ - c < 0) p[r] = NEG; } } \
        softmax_half(p, m_reg, al, l_reg, A * (float)(kb_ + 32 * half - cur.P0), pa0, pa1); \
        if (__any(al < 1.f)) { if (hi == 0) al_l[r32] = al; asm volatile("s_waitcnt lgkmcnt(0)" ::: "memory"); \
            _Pragma("unroll") for (int d_ = 0; d_ < 4; ++d_) _Pragma("unroll") for (int r = 0; r < 16; ++r) o[d_][r] *= al_l[crow(r, hi)]; } \
        SBAR(); pv_half<BUF>(o, vbh, pa0, pa1); } while (0)
    DLOAD(RA, KP(0), VP(0)); if (NT > 1) DLOAD(RB, KP(1), VP(1));
    SBAR(); DWRITE(RA, 0); SBAR(); if (NT > 2) DLOAD(RA, KP(2), VP(2));
    __syncthreads();
    int t = 0;
#pragma unroll 1
    for (; t + 4 < NT; t += 2) {
        const int pg3 = PGE(t + 3), pg4 = PGE(t + 4); SBAR();
        if (act) COMPUTE(0, t);
        SBAR(); DWRITE(RB, 1); SBAR(); DLOAD(RB, PGK(pg3, t + 3), PGV(pg3, t + 3));
        __syncthreads();
        if (act) COMPUTE(1, t + 1);
        SBAR(); DWRITE(RA, 0); SBAR(); DLOAD(RA, PGK(pg4, t + 4), PGV(pg4, t + 4));
        __syncthreads();
    }
#pragma unroll 1
    for (; t < NT; t += 2) {
        if (act) COMPUTE(0, t);
        SBAR();
        if (t + 1 < NT) { DWRITE(RB, 1); SBAR(); if (t + 3 < NT) DLOAD(RB, KP(t + 3), VP(t + 3)); }
        __syncthreads();
        if (t + 1 < NT) {
            if (act) COMPUTE(1, t + 1);
            SBAR();
            if (t + 2 < NT) { DWRITE(RA, 0); SBAR(); if (t + 4 < NT) DLOAD(RA, KP(t + 4), VP(t + 4)); }
            __syncthreads();
        }
    }
    if (act && hi == 0) {
        float* op = (float*)cur.O + (size_t)(half * 2 + sub) * 4 * OPW;
#pragma unroll
        for (int r = 0; r < 4; ++r)
#pragma unroll
            for (int d0 = 0; d0 < 4; ++d0) __hip_atomic_store(op + (unsigned)(r * OPW + d0 * 32 + r32), o[d0][r], RLX_AGENT);
        if (r32 < 4) { __hip_atomic_store(op + (unsigned)(r32 * OPW + 128), m_reg, RLX_AGENT); __hip_atomic_store(op + (unsigned)(r32 * OPW + 129), l_reg, RLX_AGENT); }
    }
    asm volatile("s_waitcnt vmcnt(0)" ::: "memory");
    __syncthreads();
    volatile __attribute__((address_space(3))) unsigned* flag = (volatile __attribute__((address_space(3))) unsigned*)(unsigned)(uintptr_t)(lds + LDS_WSF + NW * 512);
    if (tid == 0) { const unsigned old = __hip_atomic_fetch_add(fin.cnt, 1u, RLX_AGENT); *flag = (old == (unsigned)(NSPLIT - 1)) ? 1u : 0u; }
    __syncthreads();
    if (*flag != 0u && wid < 4) {
        constexpr float C2 = 1.4426950408889634f * SCALE; constexpr int NS = 2 * NSPLIT, SET = 2 * 4 * OPW;
        const int q = wid; float res0 = 0.f, res1 = 0.f;
#pragma unroll
        for (int sb = 0; sb < 2; ++sb) {
            const float* op = fin.pbase + (size_t)(sb * 4 + q) * OPW;
            float mm[NS], ll[NS], x0[NS], x1[NS];
#pragma unroll
            for (int s = 0; s < NS; ++s) { mm[s] = __hip_atomic_load(op + (size_t)s * SET + 128, RLX_AGENT); ll[s] = __hip_atomic_load(op + (size_t)s * SET + 129, RLX_AGENT);
                x0[s] = __hip_atomic_load(op + (size_t)s * SET + lane, RLX_AGENT); x1[s] = __hip_atomic_load(op + (size_t)s * SET + 64 + lane, RLX_AGENT); }
            float M = -1e30f;
#pragma unroll
            for (int s = 0; s < NS; ++s) M = fmaxf(M, mm[s]);
            float L = 0.f, a0 = 0.f, a1 = 0.f;
#pragma unroll
            for (int s = 0; s < NS; ++s) { const float w = __builtin_amdgcn_exp2f((mm[s] - M) * C2); L += w * ll[s]; a0 += w * x0[s]; a1 += w * x1[s]; }
            const float il = 1.f / L;
            if (sb == 0) { res0 = a0 * il; res1 = a1 * il; } else { res0 -= fin.lam * a0 * il; res1 -= fin.lam * a1 * il; }
        }
        float ss = res0 * res0 + res1 * res1;
#pragma unroll
        for (int off = 1; off < 64; off <<= 1) ss += __shfl_xor(ss, off);
        const float rn = rsqrtf(ss * (1.f / D) + EPS) * 0.8f;
        bf16* dst = fin.dst + (size_t)q * DM;
        dst[lane] = (bf16)(cvtpk(res0 * rn * fin.gain[lane], 0.f) & 0xffffu); dst[64 + lane] = (bf16)(cvtpk(res1 * rn * fin.gain[64 + lane], 0.f) & 0xffffu);
    }
    __syncthreads();
#undef KP
#undef VP
#undef KBASE
#undef PGE
#undef PGK
#undef PGV
#undef COMPUTE
}
#undef DLOAD
#undef DWRITE
#undef VMW
#undef VMWN
#undef ROWH
#undef ROWF
#undef SLOAD_H
#undef SWRITE_HK
#undef SWRITE_HV
#undef SWRITE_H
#undef SLOAD_F
#undef SWRITE_KF
#undef SWRITE_VF
#undef QLOAD
#undef KSWZ
#undef SBAR
}

__device__ __forceinline__ dattn::Blk prompt_blk(Frame& F, int bh, int qb) {
    const int b = bh >> 3, h = bh & 7; dattn::Blk k;
    k.Q = WSP(bf16, WS_Q) + ((size_t)b * SEQ + (size_t)qb * dattn::QB) * 1024 + h * HD;
    k.K = WSP(bf16, WS_KB) + (size_t)b * SKP * 1024 + h * HD; k.V = WSP(bf16, WS_VB) + (size_t)b * SKP * 1024 + h * HD;
    k.Kn = nullptr; k.Vn = nullptr; k.pt = nullptr;
    k.O = WSP(bf16, WS_CAT) + ((size_t)b * SEQ + (size_t)qb * dattn::QB) * DM + AW + h * HD;
    k.P0 = NMETA + qb * dattn::QB; k.t0 = 0; k.NT = (k.P0 + dattn::QB - 1) / 64 + 1; k.A = 8.f * exp2f(-(float)(h + 1));
    return k;
}
__device__ __forceinline__ dattn::Blk decode_blk(Frame& F, int bh, int split) {
    const int b = bh >> 3, h = bh & 7; dattn::Blk k;
    k.Q = WSP(bf16, WS_QS) + (size_t)(b * 4) * 1024 + h * HD;
    k.K = inp(F, I_CK) + h * HD; k.V = inp(F, I_CV) + h * HD;
    k.Kn = WSP(float, WS_KS) + (size_t)b * 64 * 1024 + h * HD; k.Vn = WSP(float, WS_VS) + (size_t)b * 64 * 1024 + h * HD;
    k.pt = (const int*)inp(F, I_PT) + b * NPAGE;
    k.O = WSP(float, WS_OPART) + (size_t)(bh * dattn::NSPLIT + split) * 2 * (2 * 4 * dattn::OPW);
    k.P0 = PAST; k.t0 = split * (PAST / 64 / dattn::NSPLIT); k.NT = PAST / 64 / dattn::NSPLIT + (split == dattn::NSPLIT - 1 ? 1 : 0); k.A = 8.f * exp2f(-(float)(h + 1));
    return k;
}
template <bool DO_DEC, bool DO_PROMPT> __device__ __forceinline__ void attn_fast_phase(Frame& F) {
    const float lam = lam_get(F);
    const float* gain = inp(F, I_SUBLN);
    char* lds = (char*)F.lds;
    dattn::Seam S;
    const int rsel = F.vcu & 15;
    const int role = (int)((MK_ROLES >> (2 * rsel)) & 3u);
    const bool lfirst = ((MK_LFIRST >> rsel) & 1u) != 0;
#pragma unroll 1
    for (int slot = 0; slot < 3; ++slot) {
        const bool do_dec = slot == (role == 0 ? 0 : 1);
        if (do_dec) {
            if constexpr (DO_DEC) for (int u = F.vcu; u < DB * NH * dattn::NSPLIT; u += F.G) {
                const int bh = u / dattn::NSPLIT;
                const dattn::Blk cur = decode_blk(F, bh, u % dattn::NSPLIT);
                const dattn::DecFin fin{(unsigned*)(F.ws + WS_CTL) + CW_DCNT + 16 * bh, WSP(float, WS_OPART) + (size_t)(bh * dattn::NSPLIT * 2) * (2 * 4 * dattn::OPW),
                                        WSP(bf16, WS_CAT) + (size_t)(ROW_SAMP + (bh >> 3) * 4) * DM + AW + (bh & 7) * HD, gain, lam};
                dattn::dec_unit(cur, lds, fin);
            }
        } else {
            const int first = (role == 1 && slot == 2) ? 1 : 0;
            const int nblk = role == 1 ? 1 : ((role == 0 ? slot == 1 : slot == 0) ? 2 : 0);
            if constexpr (DO_PROMPT) if (nblk > 0) for (int it = F.vcu; it < NB * NH * 16; it += F.G) {
                const int bh = it >> 4, s = it & 15;
                const int qa = lfirst ? 31 - s : s, qb = lfirst ? s : 31 - s;
                dattn::Blk cur = prompt_blk(F, bh, first == 0 ? qa : qb);
                dattn::attn_prime_p(cur, lds, S);
#pragma unroll 1
                for (int bp = 0; bp < nblk; ++bp) {
                    const dattn::Blk nxt = prompt_blk(F, bh, qb);
                    dattn::attn_block_p(cur, nxt, lam, gain, lds, S);
                    cur = nxt;
                }
                asm volatile("s_waitcnt vmcnt(0)" ::: "memory"); __syncthreads();
            }
        }
    }
}
__device__ __forceinline__ void feat_pass(Frame& F) {
    const int gt = F.vcu * NWAVES * 64 + F.tid, NT = F.G * NWAVES * 64;
    bf16* cat = WSP(bf16, WS_CAT);
    for (int idx = gt; idx < (MAIN / 8) * 128; idx += NT) {
        const int cg = idx & 127, rc = idx >> 7, row0 = rc * 8, b = row0 >> 12, pos0 = 16 + (row0 & 4095), c0 = cg * 8, g = c0 >> 8, w = 2 << g;
        const bf16* base = WSP(bf16, WS_PB) + ((size_t)b * SP + pos0 - 15) * 1024 + c0;
        v4u x[23];
#pragma unroll
        for (int i = 0; i < 23; ++i) x[i] = *(const GAS v4u*)(base + (size_t)i * 1024);
        const float inv = 1.f / (float)w;
        float sum[8];
#pragma unroll
        for (int j = 0; j < 8; ++j) sum[j] = 0.f;
#pragma unroll
        for (int i = 0; i < 15; ++i) if (i >= 16 - w) {
            sum[0] += bflo(x[i].x); sum[1] += bfhi(x[i].x); sum[2] += bflo(x[i].y); sum[3] += bfhi(x[i].y); sum[4] += bflo(x[i].z); sum[5] += bfhi(x[i].z); sum[6] += bflo(x[i].w); sum[7] += bfhi(x[i].w); }
#pragma unroll
        for (int r = 0; r < 8; ++r) {
            const v4u xc = x[15 + r];
            const float cur[8] = {bflo(xc.x), bfhi(xc.x), bflo(xc.y), bfhi(xc.y), bflo(xc.z), bfhi(xc.z), bflo(xc.w), bfhi(xc.w)};
            float f[8];
#pragma unroll
            for (int j = 0; j < 8; ++j) { sum[j] += cur[j]; f[j] = sum[j] * inv - cur[j]; }
            v4u o; o.x = pk2(f[0], f[1]); o.y = pk2(f[2], f[3]); o.z = pk2(f[4], f[5]); o.w = pk2(f[6], f[7]);
            *(GAS v4u*)(cat + (size_t)(row0 + r) * DM + c0) = o;
            v4u y = x[r];
            if (w == 8) y = x[8 + r]; else if (w == 4) y = x[12 + r]; else if (w == 2) y = x[14 + r];
            sum[0] -= bflo(y.x); sum[1] -= bfhi(y.x); sum[2] -= bflo(y.y); sum[3] -= bfhi(y.y); sum[4] -= bflo(y.z); sum[5] -= bfhi(y.z); sum[6] -= bflo(y.w); sum[7] -= bfhi(y.w); }
    }
    for (int idx = gt; idx < 32 * 256; idx += NT) {
        const int cq = idx & 255, j = idx >> 8, b = j >> 2, t = j & 3, c0 = cq * 4, g = c0 >> 8, w = 2 << g;
        const float* sp = inp(F, I_SPOOL) + (size_t)b * 15 * 1024 + c0; const float* pn = WSP(float, WS_PSN) + (size_t)(b * 4) * 1024 + c0;
        f32x4 x[16];
#pragma unroll
        for (int i = 0; i < 16; ++i) { const int ri = t + i; x[i] = *(const GAS f32x4*)(ri < 15 ? sp + (size_t)ri * 1024 : pn + (size_t)(ri - 15) * 1024); }
        f32x4 sum = {0.f, 0.f, 0.f, 0.f};
#pragma unroll
        for (int i = 0; i < 16; ++i) if (i >= 16 - w) { sum.x += x[i].x; sum.y += x[i].y; sum.z += x[i].z; sum.w += x[i].w; }
        const float inv = 1.f / (float)w; const f32x4 a = x[15];
        v2u o; o.x = pk2(sum.x * inv - a.x, sum.y * inv - a.y); o.y = pk2(sum.z * inv - a.z, sum.w * inv - a.w);
        *(GAS v2u*)(cat + (size_t)(ROW_SAMP + j) * DM + c0) = o;
    }
}
__device__ __forceinline__ void attn_simple_task(Frame& F, int rt, int h, float lam, LAS float* wl) {
    const int lane = F.lane; const bool samp = rt >= MAIN;
    int b, pos; const bf16* qrow;
    if (!samp) { b = rt >> 12; pos = 16 + (rt & 4095); qrow = WSP(bf16, WS_Q) + (size_t)rt * 1024 + h * HD; }
    else { const int j = rt - MAIN; b = j >> 2; pos = PAST + (j & 3); qrow = WSP(bf16, WS_QS) + (size_t)j * 1024 + h * HD; }
    wl[lane] = bf2f(qrow[lane]); wl[64 + lane] = bf2f(qrow[64 + lane]);
    LDS_WAIT(); asm volatile("" ::: "memory");
    const float slope = exp2f(-(float)(h + 1));
    const int* pt = (const int*)inp(F, I_PT) + b * NPAGE;
    float res0 = 0.f, res1 = 0.f;
#pragma unroll 1
    for (int sub = 0; sub < 2; ++sub) {
        float m = -1e30f, l = 0.f, o0 = 0.f, o1 = 0.f;
        const LAS float* qs = wl + sub * 64;
#pragma unroll 1
        for (int kb = 0; kb <= pos; kb += 64) {
            const int key = kb + lane; const bool valid = key <= pos; const int kk = valid ? key : pos;
            float s = 0.f;
            if (!samp) {
                const bf16* kr = WSP(bf16, WS_KB) + ((size_t)b * SKP + kk) * 1024 + h * HD + sub * 64;
#pragma unroll
                for (int c = 0; c < 8; ++c) { const v4u x = *(const GAS v4u*)(kr + 8 * c);
                    s += qs[8 * c] * bflo(x.x) + qs[8 * c + 1] * bfhi(x.x) + qs[8 * c + 2] * bflo(x.y) + qs[8 * c + 3] * bfhi(x.y) + qs[8 * c + 4] * bflo(x.z) + qs[8 * c + 5] * bfhi(x.z) + qs[8 * c + 6] * bflo(x.w) + qs[8 * c + 7] * bfhi(x.w); }
            } else {
                const float* kr = kk < PAST ? inp(F, I_CK) + (((size_t)pt[kk >> 7] * PAGE + (kk & 127)) * NH + h) * HD + sub * 64 : WSP(float, WS_KS) + ((size_t)b * 64 + (kk - PAST)) * 1024 + h * HD + sub * 64;
#pragma unroll
                for (int c = 0; c < 16; ++c) { const f32x4 x = *(const GAS f32x4*)(kr + 4 * c); s += qs[4 * c] * x.x + qs[4 * c + 1] * x.y + qs[4 * c + 2] * x.z + qs[4 * c + 3] * x.w; }
            }
            s = valid ? s * 0.125f - slope * (float)(pos - key) : -1e30f;
            const float mn = fmaxf(m, wave_max(s)), a = __expf(m - mn), p = valid ? __expf(s - mn) : 0.f;
            l = l * a + wave_sum(p); m = mn; o0 *= a; o1 *= a;
            const int nk = (pos - kb + 1) < 64 ? (pos - kb + 1) : 64;
#pragma unroll 4
            for (int j = 0; j < nk; ++j) { const float pj = __shfl(p, j); const int kj = kb + j;
                if (!samp) { const bf16* vr = WSP(bf16, WS_VB) + ((size_t)b * SKP + kj) * 1024 + h * HD; o0 += pj * bf2f(vr[lane]); o1 += pj * bf2f(vr[64 + lane]); }
                else { const float* vr = kj < PAST ? inp(F, I_CV) + (((size_t)pt[kj >> 7] * PAGE + (kj & 127)) * NH + h) * HD : WSP(float, WS_VS) + ((size_t)b * 64 + (kj - PAST)) * 1024 + h * HD; o0 += pj * vr[lane]; o1 += pj * vr[64 + lane]; } }
        }
        const float il = 1.f / l;
        if (sub == 0) { res0 = o0 * il; res1 = o1 * il; } else { res0 -= lam * o0 * il; res1 -= lam * o1 * il; }
    }
    const float ss = wave_sum(res0 * res0 + res1 * res1), rn = rsqrtf(ss * (1.f / HD) + EPS) * 0.8f;
    const int row = samp ? ROW_SAMP + (rt - MAIN) : rt;
    bf16* dst = WSP(bf16, WS_CAT) + (size_t)row * DM + AW + h * HD;
    dst[lane] = (bf16)f2bf(res0 * rn * inp(F, I_SUBLN)[lane]); dst[64 + lane] = (bf16)f2bf(res1 * rn * inp(F, I_SUBLN)[64 + lane]);
    LDS_WAIT(); asm volatile("" ::: "memory");
}
__device__ __forceinline__ void attn_simple_phase(Frame& F, bool do_samp, bool do_prompt) {
    const float lam = lam_get(F);
    LAS float* wl = (LAS float*)(F.lds + RING_OFF) + F.wave * 128;
    const int gw = F.vcu * NWAVES + F.wave, NGW = F.G * NWAVES;
    for (int it = gw; it < (MAIN + 32) * NH; it += NGW) {
        int rt, h;
        if (it < 32 * NH) { rt = MAIN + (it >> 3); h = it & 7; }
        else { const int k = it - 32 * NH; h = k & 7; const int r = k >> 3; rt = (r & 1) * SEQ + (SEQ - 1 - (r >> 1)); }
        if (rt >= MAIN ? do_samp : do_prompt) attn_simple_task(F, rt, h, lam, wl);
    }
}
__device__ __forceinline__ void final_norm(Frame& F, int first) {
    const int gw = F.vcu * NWAVES + F.wave, NGW = F.G * NWAVES; const unsigned lane = lane_now();
    const float* ssq = ssq_ptr(F, 2);
    for (int m = first + gw; m < MAIN + 32; m += NGW) {
        const int row = m < MAIN ? m : ROW_SAMP + (m - MAIN);
        float* y = m < MAIN ? F.out + O_YP + (size_t)m * DM : F.out + O_YS + (size_t)(m - MAIN) * DM;
        const float rs = rsqrtf(ssq[row * SSQ_PAD] * (1.f / DM) + EPS);
        GAS f32x4* yr = (GAS f32x4*)y + lane;
#pragma unroll
        for (int j = 0; j < 8; ++j) { const f32x4 gv = ((const GAS f32x4*)inp(F, I_NFIN))[lane + 64 * j]; f32x4 v = yr[64 * j]; v.x *= rs * gv.x; v.y *= rs * gv.y; v.z *= rs * gv.z; v.w *= rs * gv.w; yr[64 * j] = v; }
    }
}

struct Args { const float* in[26]; float* out; unsigned char* ws; int ph_lo, ph_hi, li, pad; };
__global__ void __launch_bounds__(NWAVES * 64, 2) hymba_fwd(Args args) {
    extern __shared__ __attribute__((aligned(16))) unsigned char lds[];
    Frame F;
    F.lds = (LAS unsigned char*)lds;
    F.MISC = (volatile LAS unsigned*)(F.lds + MISC_OFF);
    F.tid = threadIdx.x; F.lane = F.tid & 63; F.wave = __builtin_amdgcn_readfirstlane(F.tid >> 6);
    F.G = gridDim.x; { const int bx = blockIdx.x; F.vcu = (F.G % 8 == 0) ? (bx % 8) * (F.G / 8) + bx / 8 : bx; }
    F.ws = args.ws; F.out = args.out; F.ctl = (gu32*)(args.ws + WS_CTL);
    for (int u = F.tid; u < (LDS_BYTES - LDSCTL_OFF) / 4; u += NWAVES * 64) ((LAS unsigned*)(F.lds + LDSCTL_OFF))[u] = 0u;
    __syncthreads();
    if (F.tid == 0) { volatile LAS unsigned* t = (volatile LAS unsigned*)(F.lds + LDSCTL_OFF);
#pragma unroll
        for (int i = 0; i < 26; ++i) { const unsigned long long p = (unsigned long long)args.in[i]; t[2 * i] = (unsigned)p; t[2 * i + 1] = (unsigned)(p >> 32); } }
    __syncthreads();
    if (F.wave == 0) { const float lam = lam_value(F); if (F.lane == 0) F.MISC[16] = __builtin_bit_cast(unsigned, lam); }
    __syncthreads();
    XcdBarrier bar; bar.bar = (unsigned*)(F.ctl + CW_BAR); bar.x = 0; bar.st = nullptr;
    if (N_LAUNCHES == 1) bar = xcd_barrier_post((unsigned*)(F.ctl + CW_BAR), F.MISC + 8);
#define GRID_BAR() do { if (N_LAUNCHES == 1) { xcd_barrier(bar); if constexpr (((MK_REPEAT >> 13) & 1) != 0) xcd_barrier(bar); } } while (0)
    const int lo = args.ph_lo, hi = args.ph_hi;
#define IN(k) (lo <= (k) && (k) < hi)
#define BOTH(k) (IN(k) && IN((k) + 1))

#ifndef MK_REPEAT
#define MK_REPEAT 0
#endif
    constexpr int TR_W1_END = TR_D1_END + 768, TR_W2_END = TR_OUT_END, TR_W3_END = TR_W2_END, TR_W4_END = TR_W3_END, TR_W6_END = TR_GU2_END;
    static_assert(TR_W1_END <= TR_IN_END && TR_W4_END <= TR_GU2_END && TR_W6_END <= TR_END, "conversion windows");
#define REP(k) (((MK_REPEAT >> (k)) & 1) ? 2 : 1)
    if (IN(0)) { _Pragma("unroll 1") for (int rep = 0; rep < REP(0); ++rep) { p0_prologue(F); if (rep + 1 < REP(0)) __syncthreads(); } if (BOTH(0)) GRID_BAR(); }
    if (IN(1)) { RSwiglu r{WSP(bf16, WS_ACT), nullptr}; run_gemm<RSwiglu, 1>(F, WSP(bf16, WS_XA), WSP(bf16, WS_WGU1), 2 * FF, DM, r, nullptr, F.G / 2); tr_window(F, TR_GU1_END, TR_W1_END, F.G / 2); if (BOTH(1)) GRID_BAR(); }
    if (IN(2)) { RResid r{&F, 0, 0.5f}; run_gemm<RResid, 2>(F, WSP(bf16, WS_ACT), WSP(bf16, WS_WD1), DM, FF, r, ssq_ptr(F, 0), 0); tr_window(F, TR_W1_END, TR_W2_END, 32); if (BOTH(2)) GRID_BAR(); }
    if (IN(3)) { RProj r{&F}; run_gemm<RProj, 3>(F, WSP(bf16, WS_XA), WSP(bf16, WS_WIN), NQKV, DM, r, nullptr, 0); tr_window(F, TR_W2_END, TR_W3_END, 64); if (BOTH(3)) GRID_BAR(); }
    if (IN(4)) { _Pragma("unroll 1") for (int rep = 0; rep < REP(4); ++rep) { feat_pass(F);
        if constexpr (MK_FAST_ATTN == 1) attn_fast_phase<true, true>(F);
        else if constexpr (MK_FAST_ATTN == 2) { attn_fast_phase<false, true>(F); attn_simple_phase(F, true, false); }
        else if constexpr (MK_FAST_ATTN == 3) { attn_fast_phase<true, false>(F); attn_simple_phase(F, false, true); }
        else attn_simple_phase(F, true, true); }
        tr_window(F, TR_W3_END, TR_W4_END, 0);
        if (BOTH(4)) GRID_BAR(); }
    if (IN(6)) { RResid r{&F, 1, 1.f}; run_gemm<RResid, 6>(F, WSP(bf16, WS_CAT), WSP(bf16, WS_WOUT), DM, DM, r, ssq_ptr(F, 1), 0); tr_window(F, TR_W4_END, TR_W6_END, 32); if (BOTH(6)) GRID_BAR(); }
    if (IN(7)) { RSwiglu r{WSP(bf16, WS_ACT), ssq_ptr(F, 1)}; run_gemm<RSwiglu, 7>(F, WSP(bf16, WS_XA), WSP(bf16, WS_WGU2), 2 * FF, DM, r, nullptr, F.G / 2); tr_window(F, TR_W6_END, TR_END, F.G / 2); if (BOTH(7)) GRID_BAR(); }
    const bool fuse_final = FAST_GEMM && F.G == 256 && ((MK_REPEAT >> 8) & 1) == 0;
    if (IN(8)) { RResid r{&F, 2, 0.5f};
        if (fuse_final) { run_gemm_final_main(F, WSP(bf16, WS_ACT), WSP(bf16, WS_WD2)); run_gemm<RResid, 8>(F, WSP(bf16, WS_ACT), WSP(bf16, WS_WD2), DM, FF, r, ssq_ptr(F, 2), 0, true, true); }
        else run_gemm<RResid, 8>(F, WSP(bf16, WS_ACT), WSP(bf16, WS_WD2), DM, FF, r, ssq_ptr(F, 2), 0);
        if (BOTH(8) && !fuse_final) GRID_BAR(); }
    if (IN(9) && !fuse_final) { final_norm(F, 0); }
#undef IN
#undef BOTH
}

extern "C" void kernel_launch(void* const* d_in, const int* in_sizes, int n_in, void* d_out, int out_size, void* d_ws, size_t ws_size, hipStream_t stream) {
    static int grid = 0;
    if (grid == 0) {
        if (n_in != 26 || (size_t)out_size != O_END || ws_size < WS_END) { fprintf(stderr, "kernel_launch: unexpected shapes (n_in %d, out %d, ws %zu); nothing launched\n", n_in, out_size, ws_size); grid = -1; return; }
        int dev = 0, cus = 0, per_cu = 0;
        if (hipGetDevice(&dev) != hipSuccess || hipDeviceGetAttribute(&cus, hipDeviceAttributeMultiprocessorCount, dev) != hipSuccess) { grid = -1; return; }
        if (hipFuncSetAttribute((const void*)hymba_fwd, hipFuncAttributeMaxDynamicSharedMemorySize, LDS_BYTES) != hipSuccess) { fprintf(stderr, "kernel_launch: hipFuncSetAttribute failed\n"); grid = -1; return; }
        if (hipOccupancyMaxActiveBlocksPerMultiprocessor(&per_cu, (const void*)hymba_fwd, NWAVES * 64, LDS_BYTES) != hipSuccess || per_cu < 1) { fprintf(stderr, "kernel_launch: occupancy query says %d blocks per CU\n", per_cu); }
        (void)hipGetLastError();
        grid = cus;
#if defined(MK_FORCE_GRID)
        grid = MK_FORCE_GRID;
#endif
    }
    if (grid < 0) return;
    if (hipMemsetAsync((char*)d_ws + WS_CTL, 0, CTL_ZERO_BYTES, stream) != hipSuccess) return;
    Args a{};
    for (int i = 0; i < 26; ++i) a.in[i] = (const float*)d_in[i];
    a.out = (float*)d_out; a.ws = (unsigned char*)d_ws;
    for (int li = 0; li < N_LAUNCHES; ++li) {
        a.ph_lo = (N_LAUNCHES == 1) ? 0 : li; a.ph_hi = (N_LAUNCHES == 1) ? NPH : li + 1; a.li = li; a.pad = 0;
        hipLaunchKernelGGL(hymba_fwd, dim3(grid), dim3(NWAVES * 64), LDS_BYTES, stream, a);
        if (hipPeekAtLastError() != hipSuccess) { fprintf(stderr, "kernel_launch: launch %d failed\n", li); break; }
#if defined(MK_DUP_PHASE)
        if (N_LAUNCHES == NPH && li == MK_DUP_PHASE) {
            if (li == 2) hipMemsetAsync((char*)d_ws + WS_SSQ, 0, (size_t)MROWS * SSQ_PAD * 4, stream);
            if (li == 8) { hipMemsetAsync((char*)d_ws + WS_SSQ + (size_t)2 * MROWS * SSQ_PAD * 4, 0, (size_t)MROWS * SSQ_PAD * 4, stream); hipMemsetAsync((char*)d_ws + WS_CTL + (size_t)CW_PCNT * 4, 0, 64 * 32 * 4, stream); }
            hipLaunchKernelGGL(hymba_fwd, dim3(grid), dim3(NWAVES * 64), LDS_BYTES, stream, a);
        }
#endif
    }
}
```

```cpp
#include <hip/hip_runtime.h>
#include <cstdio>
#include <cstdint>
#define MK_N_LAUNCHES 1
#define MK_FAST_GEMM 1
#define MK_FAST_ATTN 1
namespace pg8 {
#define PG8_LAS __attribute__((address_space(3)))
typedef unsigned short bf16_t;
typedef short bf16x8 __attribute__((ext_vector_type(8)));
typedef float f32x4 __attribute__((ext_vector_type(4)));
typedef unsigned u32x4 __attribute__((ext_vector_type(4)));
constexpr int BM = 256, BK = 64, HALF = 128, HTB = HALF * BK * 2  , STAGE_BYTES = 8 * HTB, NXCD = 8, WGM = 8;

__host__ __device__ __forceinline__ int lds_byte(int r, int c) { const int st = (r >> 4) * 2 + (c >> 5), rr = r & 15, cc = c & 31, ob = rr * 64 + cc * 2; return st * 1024 + (ob ^ (((ob >> 9) & 1) << 5)); }
__host__ __device__ __forceinline__ void stage_rc(int b, int& R, int& C) { const int st = b / 1024, sb = b % 1024, swz = sb ^ (((sb >> 9) & 1) << 5); R = (st >> 1) * 16 + swz / 64; C = (st & 1) * 32 + (swz % 64) / 2; }
__host__ __device__ __forceinline__ int perm32(int rho) { const int n = rho >> 4, i = rho & 15; return 8 * (i >> 2) + 4 * n + (i & 3); }

struct Unit { int pm, pn; };
struct Gemm { const bf16_t* A; const bf16_t* Bt; int M, N, K; };

struct StaticOrder {
    int nM, nN, nwg, G, c;
    __host__ __device__ void init(int M, int N, int G_, int c_) { nM = M / BM; nN = N / BM; nwg = nM * nN; G = G_; c = c_; }
    __host__ __device__ bool next(int i, Unit& u) const {
        const long L = (long)i * G + c; if (L >= nwg) return false;
        int wgid = (int)L; { const int q = nwg / NXCD, r = nwg % NXCD, xcd = wgid % NXCD, off = wgid / NXCD; wgid = (xcd < r ? xcd * (q + 1) : r * (q + 1) + (xcd - r) * q) + off; }
        const int nig = WGM * nN, gid = wgid / nig, fm = gid * WGM, gsz = (nM - fm) < WGM ? (nM - fm) : WGM;
        u.pm = fm + ((wgid % nig) % gsz); u.pn = (wgid % nig) / gsz; return true;
    }
    __device__ __forceinline__ void a_ready(const Unit&) const {}
    __device__ __forceinline__ void done(const Unit&) const {}
};
__device__ __forceinline__ unsigned cvt_pk_bf16(float lo, float hi) { unsigned r; asm volatile("v_cvt_pk_bf16_f32 %0, %1, %2" : "=v"(r) : "v"(lo), "v"(hi)); return r; }
template <class Epi, class Sched, bool ALIGN_EPI = false, bool SP2 = false>
__device__ __forceinline__ void gemm_phase(PG8_LAS unsigned char* lds, const Gemm g, const Sched& S, const Epi& E) {
    const int tid = threadIdx.x, wid = __builtin_amdgcn_readfirstlane(tid >> 6), lane = tid & 63, wr = wid >> 2, wc = wid & 3, fr = lane & 15, fq = lane >> 4;
    const int K = g.K, nt = K / BK;
    unsigned voffA[2], voffB[2];
#pragma unroll
    for (int i = 0; i < 2; ++i) { int R, C; stage_rc(tid * 16 + i * 8192, R, C); const int Rb = Epi::PERM ? ((R & ~31) + perm32(R & 31)) : R;
        voffA[i] = (unsigned)(R * K + C) * 2u; voffB[i] = (unsigned)(Rb * K + C) * 2u; }
    const size_t kstep = (size_t)(BK * 2);
    const size_t hstep = (size_t)HALF * K * 2;
    const size_t tstep = 2 * hstep;
    const unsigned ldsw = (unsigned)wid * 1024u;
    const int aoff = lds_byte(wr * 64 + fr, fq * 8), boff = lds_byte(wc * 32 + fr, fq * 8);
#define PG8_SA(b, h) (((b) * 2 + (h)) * HTB)
#define PG8_SB(b, h) ((4 + (b) * 2 + (h)) * HTB)
#define PG8_STAGE(bufoff, gbase, voff) do { _Pragma("unroll") for (int _i = 0; _i < 2; ++_i) \
        __builtin_amdgcn_global_load_lds((const unsigned*)((const char*)(gbase) + (voff)[_i]), (PG8_LAS unsigned*)(lds + (bufoff) + ldsw + _i * 8192), 16, 0, 0); } while (0)
#define PG8_LDA(dst, b, h) do { _Pragma("unroll") for (int m = 0; m < 4; ++m) _Pragma("unroll") for (int k = 0; k < 2; ++k) dst[m][k] = *(const PG8_LAS bf16x8*)(lds + PG8_SA(b, h) + aoff + m * 2048 + k * 1024); } while (0)
#define PG8_LDB(dst, b, h) do { _Pragma("unroll") for (int n = 0; n < 2; ++n) _Pragma("unroll") for (int k = 0; k < 2; ++k) dst[n][k] = *(const PG8_LAS bf16x8*)(lds + PG8_SB(b, h) + boff + n * 2048 + k * 1024); } while (0)
#define PG8_MMA(ai, bj, At, Bt) do { __builtin_amdgcn_s_setprio(1); _Pragma("unroll") for (int m = 0; m < 4; ++m) _Pragma("unroll") for (int n = 0; n < 2; ++n) _Pragma("unroll") for (int k = 0; k < 2; ++k) \
        acc[ai][bj][m][n] = __builtin_amdgcn_mfma_f32_16x16x32_bf16(Bt[n][k], At[m][k], acc[ai][bj][m][n], 0, 0, 0); __builtin_amdgcn_s_setprio(0); } while (0)
#define PG8_WAIT_V(n) asm volatile("s_waitcnt vmcnt(" #n ")" ::: "memory")
#define PG8_WAIT_L(n) asm volatile("s_waitcnt lgkmcnt(" #n ")" ::: "memory")
#define PG8_BAR __builtin_amdgcn_s_barrier()
#define PG8_SCHED __builtin_amdgcn_sched_barrier(0)
    Unit cur, nxt; int ui = 0;
    if (!S.next(0, cur)) return;
    f32x4 acc[2][2][4][2];
#pragma unroll
    for (int a = 0; a < 2; ++a)
#pragma unroll
        for (int b = 0; b < 2; ++b)
#pragma unroll
            for (int m = 0; m < 4; ++m)
#pragma unroll
                for (int n = 0; n < 2; ++n) acc[a][b][m][n] = (f32x4){0.f, 0.f, 0.f, 0.f};
    bf16x8 At[4][2], B0[2][2], B1[2][2];
    const char* cA = (const char*)g.A + (size_t)cur.pm * tstep; const char* cB = (const char*)g.Bt + (size_t)cur.pn * tstep;
    S.a_ready(cur);
    if constexpr (SP2) {
        PG8_STAGE(PG8_SB(0, 0), cB, voffB); PG8_STAGE(PG8_SB(0, 1), cB + hstep, voffB); PG8_STAGE(PG8_SA(0, 0), cA, voffA); PG8_STAGE(PG8_SA(0, 1), cA + hstep, voffA);
        if (wr == 1) PG8_BAR;
        PG8_WAIT_V(2); PG8_BAR;
        PG8_STAGE(PG8_SB(1, 0), cB + kstep, voffB); PG8_STAGE(PG8_SA(1, 0), cA + kstep, voffA); PG8_STAGE(PG8_SB(1, 1), cB + hstep + kstep, voffB);
        PG8_WAIT_V(6); PG8_BAR;
    } else {
        PG8_STAGE(PG8_SB(0, 0), cB, voffB); PG8_STAGE(PG8_SA(0, 0), cA, voffA); PG8_STAGE(PG8_SB(0, 1), cB + hstep, voffB); PG8_STAGE(PG8_SA(0, 1), cA + hstep, voffA);
        if (wr == 1) PG8_BAR;
        PG8_WAIT_V(4); PG8_BAR;
        PG8_STAGE(PG8_SB(1, 0), cB + kstep, voffB); PG8_STAGE(PG8_SA(1, 0), cA + kstep, voffA); PG8_STAGE(PG8_SB(1, 1), cB + hstep + kstep, voffB);
        PG8_WAIT_V(6); PG8_BAR;
    }
    for (;;) {
        const bool has_next = S.next(ui + 1, nxt);
        const char* nA = has_next ? (const char*)g.A + (size_t)nxt.pm * tstep : cA; const char* nB = has_next ? (const char*)g.Bt + (size_t)nxt.pn * tstep : cB;
        for (int t = 0; t < nt; t += 2) {
            const bool last = (t == nt - 2);
            const char* a1 = cA + (size_t)(t + 1) * kstep;
            const char* a2 = last ? nA : cA + (size_t)(t + 2) * kstep; const char* b2 = last ? nB : cB + (size_t)(t + 2) * kstep;
            const char* a3 = a2 + kstep; const char* b3 = b2 + kstep;
            if (last && has_next) S.a_ready(nxt);
            if constexpr (SP2) {
            PG8_LDB(B0, 0, 0); PG8_LDB(B1, 0, 1); PG8_SCHED; PG8_LDA(At, 0, 0); PG8_STAGE(PG8_SA(1, 1), a1 + hstep, voffA);
            PG8_WAIT_V(8); PG8_WAIT_L(0); PG8_BAR; PG8_MMA(0, 0, At, B0); PG8_MMA(0, 1, At, B1); PG8_BAR; PG8_SCHED;
            PG8_LDA(At, 0, 1); PG8_STAGE(PG8_SB(0, 0), b2, voffB); PG8_STAGE(PG8_SB(0, 1), b2 + hstep, voffB); PG8_STAGE(PG8_SA(0, 0), a2, voffA);
            PG8_WAIT_V(8); PG8_WAIT_L(0); PG8_BAR; PG8_MMA(1, 0, At, B0); PG8_MMA(1, 1, At, B1); PG8_BAR; PG8_SCHED;
            PG8_LDB(B0, 1, 0); PG8_LDB(B1, 1, 1); PG8_SCHED; PG8_LDA(At, 1, 0); PG8_STAGE(PG8_SA(0, 1), a2 + hstep, voffA);
            PG8_WAIT_V(8); PG8_WAIT_L(0); PG8_BAR; PG8_MMA(0, 0, At, B0); PG8_MMA(0, 1, At, B1); PG8_BAR; PG8_SCHED;
            PG8_LDA(At, 1, 1); PG8_STAGE(PG8_SB(1, 0), b3, voffB); PG8_STAGE(PG8_SB(1, 1), b3 + hstep, voffB); PG8_STAGE(PG8_SA(1, 0), a3, voffA);
            PG8_WAIT_V(8); PG8_WAIT_L(0); PG8_BAR; PG8_MMA(1, 0, At, B0); PG8_MMA(1, 1, At, B1); PG8_BAR; PG8_SCHED;
            } else {
            PG8_LDB(B0, 0, 0); PG8_SCHED; PG8_LDA(At, 0, 0); PG8_STAGE(PG8_SA(1, 1), a1 + hstep, voffA);
            PG8_WAIT_L(8); PG8_BAR; PG8_WAIT_L(0); PG8_MMA(0, 0, At, B0); PG8_BAR; PG8_SCHED;
            PG8_LDB(B1, 0, 1); PG8_STAGE(PG8_SB(0, 0), b2, voffB);
            PG8_BAR; PG8_WAIT_L(0); PG8_MMA(0, 1, At, B1); PG8_BAR;
            PG8_LDA(At, 0, 1); PG8_STAGE(PG8_SA(0, 0), a2, voffA);
            PG8_BAR; PG8_WAIT_L(0); PG8_MMA(1, 0, At, B0); PG8_BAR; PG8_SCHED;
            PG8_STAGE(PG8_SB(0, 1), b2 + hstep, voffB);
            PG8_WAIT_V(6); PG8_BAR; PG8_MMA(1, 1, At, B1); PG8_BAR;
            PG8_LDB(B0, 1, 0); PG8_SCHED; PG8_LDA(At, 1, 0); PG8_STAGE(PG8_SA(0, 1), a2 + hstep, voffA);
            PG8_WAIT_L(8); PG8_BAR; PG8_WAIT_L(0); PG8_MMA(0, 0, At, B0); PG8_BAR; PG8_SCHED;
            PG8_LDB(B1, 1, 1); PG8_STAGE(PG8_SB(1, 0), b3, voffB);
            PG8_BAR; PG8_WAIT_L(0); PG8_MMA(0, 1, At, B1); PG8_BAR;
            PG8_LDA(At, 1, 1); PG8_STAGE(PG8_SA(1, 0), a3, voffA);
            PG8_BAR; PG8_WAIT_L(0); PG8_MMA(1, 0, At, B0); PG8_BAR; PG8_SCHED;
            PG8_STAGE(PG8_SB(1, 1), b3 + hstep, voffB);
            PG8_WAIT_V(6); PG8_BAR; PG8_MMA(1, 1, At, B1); PG8_BAR;
            }
        }
        if constexpr (ALIGN_EPI) { if (wr == 0) PG8_BAR; }
        if constexpr (!Epi::AFTER_DRAIN) { E(acc, cur, wr, wc, fr, fq); S.done(cur); }
        if (!has_next) break;
#pragma unroll
        for (int a = 0; a < 2; ++a)
#pragma unroll
            for (int b = 0; b < 2; ++b)
#pragma unroll
                for (int m = 0; m < 4; ++m)
#pragma unroll
                    for (int n = 0; n < 2; ++n) acc[a][b][m][n] = (f32x4){0.f, 0.f, 0.f, 0.f};
        cur = nxt; cA = nA; cB = nB; ++ui;
        if constexpr (ALIGN_EPI) { if (wr == 1) PG8_BAR; }
    }
    PG8_WAIT_V(0);
    if constexpr (!ALIGN_EPI) { if (wr == 0) PG8_BAR; }
    PG8_BAR;
    if constexpr (Epi::AFTER_DRAIN) { E.fused(acc, cur, wr, wc, fr, fq, lds, wid, lane); S.done(cur); }
#undef PG8_SA
#undef PG8_SB
#undef PG8_STAGE
#undef PG8_LDA
#undef PG8_LDB
#undef PG8_MMA
#undef PG8_WAIT_V
#undef PG8_WAIT_L
#undef PG8_BAR
#undef PG8_SCHED
}
}
constexpr int DM = 2048, FF = 5632, NQKV = 4096, SEQ = 4096, NMETA = 16, SP = SEQ + NMETA  , SKP = 4160  , NB = 2;
constexpr int MAIN = NB * SEQ;
constexpr int ROW_META = MAIN, ROW_SAMP = MAIN + 16, MROWS = MAIN + 64;
constexpr int DB = 8, DS = 4, PAST = 16384, PAGE = 128, NPAGE = PAST / PAGE, NH = 8, HD = 128, AW = 1024, PW = 1024;
constexpr float EPS = 1e-6f;
constexpr int NWAVES = 8;
#ifndef MK_N_LAUNCHES
#define MK_N_LAUNCHES 1
#endif
constexpr int NPH = 10;
constexpr int N_LAUNCHES = MK_N_LAUNCHES;
#ifndef MK_FAST_GEMM
#define MK_FAST_GEMM 1
#endif
#ifndef MK_FAST_ATTN
#define MK_FAST_ATTN 1
#endif
constexpr bool FAST_GEMM = MK_FAST_GEMM;

constexpr size_t O_YP = 0, O_YS = O_YP + (size_t)MAIN * DM, O_KP = O_YS + (size_t)32 * DM, O_VP = O_KP + (size_t)NB * SP * 1024, O_PP = O_VP + (size_t)NB * SP * 1024,
                 O_KS = O_PP + (size_t)NB * 15 * 1024, O_VS = O_KS + (size_t)32 * 1024, O_PS = O_VS + (size_t)32 * 1024, O_END = O_PS + (size_t)DB * 15 * 1024;

constexpr size_t MiB = 1u << 20;
#ifndef MK_XSYNC
#define MK_XSYNC 0
#endif
#ifndef MK_REPEAT
#define MK_REPEAT 0
#endif
#ifndef MK_ROLES
#define MK_ROLES 0x55888888u
#define MK_LFIRST 0xFFFFu
#endif
constexpr size_t WS_CTL = 0, CTL_ZERO_BYTES = MK_XSYNC ? 256 * 1024 : 64 * 1024;
constexpr size_t WS_WGU1 = 2 * MiB, WS_WD1 = 46 * MiB, WS_WIN = 68 * MiB, WS_WOUT = 84 * MiB, WS_WGU2 = 92 * MiB, WS_WD2 = 136 * MiB;
constexpr size_t WS_XA = 158 * MiB, WS_ACT = 191 * MiB, WS_X1 = 280 * MiB, WS_Q = 345 * MiB, WS_QS = 361 * MiB, WS_KB = 362 * MiB, WS_VB = 379 * MiB, WS_PB = 396 * MiB;
constexpr size_t WS_KS = 413 * MiB, WS_VS = 415 * MiB, WS_PSN = 417 * MiB, WS_CAT = 418 * MiB, WS_OPART = 451 * MiB, WS_SSQ = 470 * MiB, WS_SLAB = 476 * MiB, WS_END = 486 * MiB;
static_assert(WS_WGU1 + (size_t)2 * FF * DM * 2 <= WS_WD1 && WS_WD1 + (size_t)DM * FF * 2 <= WS_WIN && WS_WIN + (size_t)NQKV * DM * 2 <= WS_WOUT && WS_WOUT + (size_t)DM * DM * 2 <= WS_WGU2, "ws map 1");
static_assert(WS_XA + (size_t)MROWS * DM * 2 <= WS_ACT && WS_ACT + (size_t)MROWS * FF * 2 <= WS_X1 && WS_X1 + (size_t)MROWS * DM * 4 <= WS_Q && WS_Q + (size_t)MAIN * 1024 * 2 <= WS_QS, "ws map 2");
static_assert(WS_KB + (size_t)NB * SKP * 1024 * 2 <= WS_VB && WS_VB + (size_t)NB * SKP * 1024 * 2 <= WS_PB && WS_PB + (size_t)NB * SP * 1024 * 2 <= WS_KS && WS_CAT + (size_t)MROWS * DM * 2 <= WS_OPART, "ws map 3");
constexpr int SSQ_PAD = 1;
constexpr size_t SSQ_BYTES = (size_t)4 * MROWS * SSQ_PAD * 4;
static_assert(WS_SSQ + SSQ_BYTES <= WS_SLAB, "ssq");
constexpr int CW_TMO = 0, CW_CODE = 1, CW_BAR = 4096, CW_SSQ = 16384, CW_DCNT = 14336;


constexpr int RING_OFF = 0, RING_BYTES = 131072;
constexpr int LDSCTL_OFF = RING_BYTES, MISC_OFF = LDSCTL_OFF + 320;
constexpr int LDS_BYTES = 147456;

#define GAS __attribute__((address_space(1)))
#define LAS __attribute__((address_space(3)))
typedef unsigned short bf16;
typedef unsigned v4u __attribute__((ext_vector_type(4)));
typedef unsigned v2u __attribute__((ext_vector_type(2)));
typedef float f32x4 __attribute__((ext_vector_type(4)));
typedef short bf16x8 __attribute__((ext_vector_type(8)));
typedef GAS unsigned gu32;
#define RLX_AGENT __ATOMIC_RELAXED, __HIP_MEMORY_SCOPE_AGENT
#define LDS_WAIT() asm volatile("s_waitcnt lgkmcnt(0)" ::: "memory")
#define VM_WAIT() asm volatile("s_waitcnt vmcnt(0)" ::: "memory")
__device__ __forceinline__ unsigned f2bf(float f) { unsigned u = __builtin_bit_cast(unsigned, f); return (u + 0x7fffu + ((u >> 16) & 1u)) >> 16; }
__device__ __forceinline__ unsigned pk2(float lo, float hi) { unsigned r; asm volatile("v_cvt_pk_bf16_f32 %0, %1, %2" : "=v"(r) : "v"(lo), "v"(hi)); return r; }
__device__ __forceinline__ float bf2f(unsigned short x) { return __builtin_bit_cast(float, (unsigned)x << 16); }
__device__ __forceinline__ float bflo(unsigned w) { return __builtin_bit_cast(float, w << 16); }
__device__ __forceinline__ float bfhi(unsigned w) { return __builtin_bit_cast(float, w & 0xffff0000u); }
__device__ __forceinline__ float wave_sum(float v) {
#pragma unroll
    for (int o = 1; o < 64; o <<= 1) v += __shfl_xor(v, o);
    return v;
}
__device__ __forceinline__ float wave_max(float v) {
#pragma unroll
    for (int o = 1; o < 64; o <<= 1) v = fmaxf(v, __shfl_xor(v, o));
    return v;
}
__device__ __forceinline__ unsigned lane_now() { unsigned l; asm volatile("v_mbcnt_lo_u32_b32 %0, -1, 0\n\tv_mbcnt_hi_u32_b32 %0, -1, %0" : "=v"(l)); return l; }
#define XB_TMO      128
#define XB_XCNT(j)  (256  + 64 * (j))
#define XB_XSUB(j)  (1280 + 64 * (j))
#define XB_XGEN(j)  (2304 + 64 * (j))
#define XB_TOP      3328
#define XB_TOPGEN   3392
#define XCD_BAR_WORDS 3456
#define XB_SPIN_CAP (1u << 18)

__device__ __forceinline__ unsigned xb_ld(unsigned* p)              { return __hip_atomic_load(p, __ATOMIC_RELAXED, __HIP_MEMORY_SCOPE_AGENT); }
__device__ __forceinline__ unsigned xb_add(unsigned* p, unsigned v) { return __hip_atomic_fetch_add(p, v, __ATOMIC_RELAXED, __HIP_MEMORY_SCOPE_AGENT); }
__device__ __forceinline__ unsigned xb_xcc_id() { return (unsigned)__builtin_amdgcn_s_getreg((3 << 11) | 20) & 0xFu; }
#define XB_SPIN(cond, bar) do { unsigned _sp = 0; while (cond) { __builtin_amdgcn_s_sleep(1); \
    if ((++_sp & 255u) == 0u) { if (xb_ld(&(bar)[XB_TMO])) break; if (_sp > XB_SPIN_CAP) { atomicAdd(&(bar)[XB_TMO], 1u); break; } } } } while (0)

struct XcdBarrier {
    unsigned* bar; unsigned x;
    volatile LAS unsigned* st;
};

__device__ __forceinline__ XcdBarrier xcd_barrier_post(unsigned* bar, volatile LAS unsigned* st) {
    XcdBarrier b; b.bar = bar; b.x = xb_xcc_id(); b.st = st;
    if (threadIdx.x == 0) (void)xb_add(&bar[XB_XCNT(b.x)], 1u);
    return b;
}
__device__ __forceinline__ void xcd_barrier_complete(unsigned* bar, unsigned x, unsigned& nloc, unsigned& nx) {
    const unsigned G = gridDim.x * gridDim.y * gridDim.z;
    unsigned sum, cnt, mine, sp = 0u;
    for (;;) {
        sum = 0u; cnt = 0u; mine = 0u;
#pragma unroll
        for (unsigned j = 0; j < 16; ++j) { const unsigned c = xb_ld(&bar[XB_XCNT(j)]); sum += c; cnt += (c > 0u) ? 1u : 0u; mine = (j == x) ? c : mine; }
        if (sum == G) break;
        __builtin_amdgcn_s_sleep(1);
        if ((++sp & 255u) == 0u) { if (xb_ld(&bar[XB_TMO])) break; if (sp > XB_SPIN_CAP) { atomicAdd(&bar[XB_TMO], 1u); break; } }
    }
    nloc = mine > 0u ? mine : 1u; nx = cnt > 0u ? cnt : 1u;
}

__device__ __forceinline__ void xcd_barrier(const XcdBarrier& b) {
    asm volatile("s_waitcnt vmcnt(0)" ::: "memory");
    __syncthreads();
    if (threadIdx.x == 0) {
        unsigned* bar = b.bar;
        __builtin_amdgcn_s_waitcnt(0);
        unsigned nloc = b.st[0], nx = b.st[1];
        if (nloc == 0u) { xcd_barrier_complete(bar, b.x, nloc, nx); b.st[0] = nloc; b.st[1] = nx; }
        const unsigned old = xb_add(&bar[XB_XSUB(b.x)], 1u);
        const unsigned gen = old / nloc;
        if (old + 1u == (gen + 1u) * nloc) {
            __builtin_amdgcn_fence(__ATOMIC_RELEASE, "agent");
            asm volatile("s_waitcnt vmcnt(0)" ::: "memory");
            const unsigned og = xb_add(&bar[XB_TOP], 1u);
            const unsigned tg = og / nx;
            if (og + 1u == (tg + 1u) * nx) xb_add(&bar[XB_TOPGEN], 1u);
            else XB_SPIN(xb_ld(&bar[XB_TOPGEN]) == tg, bar);
            __builtin_amdgcn_fence(__ATOMIC_ACQUIRE, "agent");
            xb_add(&bar[XB_XGEN(b.x)], 1u);
            asm volatile("s_waitcnt vmcnt(0)" ::: "memory");
        } else {
            XB_SPIN(xb_ld(&bar[XB_XGEN(b.x)]) == gen, bar);
            __builtin_amdgcn_fence(__ATOMIC_ACQUIRE, "agent");
            asm volatile("s_waitcnt vmcnt(0)" ::: "memory");
        }
    }
    __syncthreads();
}
struct Frame {
    LAS unsigned char* lds;
    volatile LAS unsigned* MISC;
    gu32* ctl;
    unsigned tid, lane; int wave, vcu, G;
    float* out; unsigned char* ws;
};
enum { I_XP = 0, I_XS, I_CK, I_CV, I_SPOOL, I_PT, I_META, I_NF1, I_WG1, I_WU1, I_WD1, I_NMIX, I_WIN, I_WPOOL, I_PSCALE, I_LQ1, I_LK1, I_LQ2, I_LK2, I_SUBLN, I_WOUT, I_NF2, I_WG2, I_WU2, I_WD2, I_NFIN };
#define WSP(T, off) ((T*)(F.ws + (off)))
__device__ __forceinline__ const float* inp(const Frame& F, int i) {
    volatile LAS unsigned* t = (volatile LAS unsigned*)(F.lds + LDSCTL_OFF);
    const unsigned lo = __builtin_amdgcn_readfirstlane(t[2 * i]), hi = __builtin_amdgcn_readfirstlane(t[2 * i + 1]);
    return (const float*)(const GAS float*)(((unsigned long long)hi << 32) | lo);
}
__device__ __forceinline__ float* ssq_ptr(const Frame& F, int k) { return (float*)(F.ws + WS_SSQ) + (size_t)k * MROWS * SSQ_PAD; }
__device__ __forceinline__ const float* x0_row(const Frame& F, int row) {
    if (row < MAIN) return inp(F, I_XP) + (size_t)row * DM;
    if (row < ROW_SAMP) return inp(F, I_META) + (size_t)(row - ROW_META) * DM;
    if (row < ROW_SAMP + 32) return inp(F, I_XS) + (size_t)(row - ROW_SAMP) * DM;
    return nullptr;
}
__device__ __forceinline__ float lam_get(const Frame& F) { return __builtin_bit_cast(float, (unsigned)F.MISC[16]); }
__device__ __forceinline__ float lam_value(const Frame& F) {
    const float a = wave_sum(inp(F, I_LQ1)[F.lane] * inp(F, I_LK1)[F.lane]), b = wave_sum(inp(F, I_LQ2)[F.lane] * inp(F, I_LK2)[F.lane]);
    return __expf(a) - __expf(b) + 0.2f;
}

struct TrItem { const float* W; bf16* WT; const float* gain; int N, ldk, koff, map, k0, n0; };
__device__ __forceinline__ int rowmap_rt(int map, int n) { return map == 0 ? n : (n >> 7) * 256 + (n & 127) + (map == 2 ? 128 : 0); }
__device__ __forceinline__ void tr_load(const TrItem& P, float (&wv)[32], unsigned lane) {
    const float* wp = P.W + (size_t)(P.k0 + (lane >> 5)) * P.N + P.n0 + (lane & 31);
#pragma unroll
    for (int i = 0; i < 32; ++i) wv[i] = __builtin_nontemporal_load(wp + (size_t)(2 * i) * P.N);
}
__device__ __forceinline__ void tr_store(const TrItem& P, const float (&wv)[32], LAS float* scr, unsigned lane) {
#pragma unroll
    for (int i = 0; i < 32; ++i) scr[(2 * i + (lane >> 5)) * 33 + (lane & 31)] = wv[i];
    LDS_WAIT(); asm volatile("" ::: "memory");
    const int c = lane & 7;
    f32x4 g0 = {1.f, 1.f, 1.f, 1.f}, g1 = g0;
    if (P.gain) { g0 = *(const GAS f32x4*)(P.gain + P.k0 + 8 * c); g1 = *(const GAS f32x4*)(P.gain + P.k0 + 8 * c + 4); }
#pragma unroll
    for (int j = 0; j < 4; ++j) { const int n = (lane >> 3) + 8 * j; const LAS float* s = scr + (8 * c) * 33 + n;
        v4u o; o.x = pk2(s[0 * 33] * g0.x, s[1 * 33] * g0.y); o.y = pk2(s[2 * 33] * g0.z, s[3 * 33] * g0.w); o.z = pk2(s[4 * 33] * g1.x, s[5 * 33] * g1.y); o.w = pk2(s[6 * 33] * g1.z, s[7 * 33] * g1.w);
        *(GAS v4u*)(P.WT + (size_t)rowmap_rt(P.map, P.n0 + n) * P.ldk + P.koff + P.k0 + 8 * c) = o; }
    LDS_WAIT(); asm volatile("" ::: "memory");
}
__device__ __forceinline__ void poolfold_tile(Frame& F, int tile) {
    const float* wp = inp(F, I_WPOOL); const float* ps = inp(F, I_PSCALE); const float* wout = inp(F, I_WOUT); bf16* WOUT = WSP(bf16, WS_WOUT);
    const int kb = tile >> 3, nb = tile & 7, k0 = kb * 32, g = k0 >> 8, i0 = k0 & 255, n0 = nb * 256;
    const unsigned tid = F.tid;
    LAS float* AT = (LAS float*)(F.lds + RING_OFF);
    LAS float* Bs = AT + 256 * 32;
    { const int i = tid >> 4, j0 = (tid & 15) * 16; const float* src = wp + ((size_t)(g * 256 + i0 + i)) * 256 + j0; const float* sc = ps + g * 256 + j0;
#pragma unroll
      for (int q = 0; q < 4; ++q) { const f32x4 a = *(const GAS f32x4*)(src + 4 * q), s4 = *(const GAS f32x4*)(sc + 4 * q);
          AT[(j0 + 4 * q + 0) * 32 + i] = a.x * s4.x; AT[(j0 + 4 * q + 1) * 32 + i] = a.y * s4.y; AT[(j0 + 4 * q + 2) * 32 + i] = a.z * s4.z; AT[(j0 + 4 * q + 3) * 32 + i] = a.w * s4.w; } }
    const float* bsrc = wout + (size_t)(g * 256) * DM + n0;
    f32x4 st[4];
#define PF_LOAD(c) do { _Pragma("unroll") for (int q = 0; q < 4; ++q) st[q] = *(const GAS f32x4*)(bsrc + (size_t)(32 * (c) + (tid >> 6) + 8 * q) * DM + (tid & 63) * 4); } while (0)
#define PF_WRITE(buf) do { _Pragma("unroll") for (int q = 0; q < 4; ++q) *(LAS f32x4*)(Bs + (buf) * 8192 + ((tid >> 6) + 8 * q) * 256 + (tid & 63) * 4) = st[q]; } while (0)
    PF_LOAD(0); PF_WRITE(0); PF_LOAD(1);
    __syncthreads();
    float acc[8][2];
#pragma unroll
    for (int r = 0; r < 8; ++r) { acc[r][0] = 0.f; acc[r][1] = 0.f; }
    const int ig = tid >> 7, np = tid & 127;
#pragma unroll 1
    for (int c = 0; c < 8; ++c) {
        const LAS float* Bc = Bs + (c & 1) * 8192 + np * 2; const LAS float* Ac = AT + (32 * c) * 32 + ig * 8;
#pragma unroll 8
        for (int j = 0; j < 32; ++j) { const f32x4 a0 = *(const LAS f32x4*)(Ac + j * 32), a1 = *(const LAS f32x4*)(Ac + j * 32 + 4); const float b0 = Bc[j * 256], b1 = Bc[j * 256 + 1];
            acc[0][0] += a0.x * b0; acc[0][1] += a0.x * b1; acc[1][0] += a0.y * b0; acc[1][1] += a0.y * b1; acc[2][0] += a0.z * b0; acc[2][1] += a0.z * b1; acc[3][0] += a0.w * b0; acc[3][1] += a0.w * b1;
            acc[4][0] += a1.x * b0; acc[4][1] += a1.x * b1; acc[5][0] += a1.y * b0; acc[5][1] += a1.y * b1; acc[6][0] += a1.z * b0; acc[6][1] += a1.z * b1; acc[7][0] += a1.w * b0; acc[7][1] += a1.w * b1; }
        if (c + 1 < 8) { PF_WRITE((c + 1) & 1); if (c + 2 < 8) PF_LOAD(c + 2); }
        __syncthreads();
    }
#undef PF_LOAD
#undef PF_WRITE
#pragma unroll
    for (int q = 0; q < 2; ++q) { v4u o; o.x = pk2(acc[0][q], acc[1][q]); o.y = pk2(acc[2][q], acc[3][q]); o.z = pk2(acc[4][q], acc[5][q]); o.w = pk2(acc[6][q], acc[7][q]);
        *(GAS v4u*)(WOUT + (size_t)(n0 + np * 2 + q) * DM + k0 + ig * 8) = o; }
}
__device__ __forceinline__ void rms_row_to_bf16(const float* xrow, const float* g, bf16* orow, int lane) {
    GAS unsigned long long* o8 = (GAS unsigned long long*)orow + lane;
    if (!xrow) {
#pragma unroll
        for (int j = 0; j < 8; ++j) o8[64 * j] = 0ull;
        return; }
    const GAS f32x4* xr = (const GAS f32x4*)xrow + lane;
    f32x4 v[8]; float s = 0.f;
#pragma unroll
    for (int j = 0; j < 8; ++j) { v[j] = xr[64 * j]; s += (v[j].x * v[j].x + v[j].y * v[j].y) + (v[j].z * v[j].z + v[j].w * v[j].w); }
    const float rs = rsqrtf(wave_sum(s) * (1.f / DM) + EPS);
#pragma unroll
    for (int j = 0; j < 8; ++j) { const f32x4 gv = ((const GAS f32x4*)g)[lane + 64 * j];
        o8[64 * j] = (unsigned long long)pk2(v[j].x * rs * gv.x, v[j].y * rs * gv.y) | ((unsigned long long)pk2(v[j].z * rs * gv.z, v[j].w * rs * gv.w) << 32); }
}
constexpr int TI_GU = (DM / 64) * (FF / 32), TI_DN = (FF / 64) * (DM / 32), TI_IN = (DM / 64) * (NQKV / 32), TI_OUT = (1024 / 64) * (DM / 32);
constexpr int TR_GU1_END = 2 * TI_GU, TR_D1_END = TR_GU1_END + TI_DN, TR_IN_END = TR_D1_END + TI_IN, TR_OUT_END = TR_IN_END + TI_OUT, TR_GU2_END = TR_OUT_END + 2 * TI_GU, TR_END = TR_GU2_END + TI_DN;
__device__ __forceinline__ TrItem tr_item(Frame& F, int it) {
    TrItem P; int r = it, nblk;
    if (r < TI_GU) { P = TrItem{inp(F, I_WG1), WSP(bf16, WS_WGU1), nullptr, FF, DM, 0, 1, 0, 0}; }
    else if ((r -= TI_GU) < TI_GU) { P = TrItem{inp(F, I_WU1), WSP(bf16, WS_WGU1), nullptr, FF, DM, 0, 2, 0, 0}; }
    else if ((r -= TI_GU) < TI_DN) { P = TrItem{inp(F, I_WD1), WSP(bf16, WS_WD1), nullptr, DM, FF, 0, 0, 0, 0}; }
    else if ((r -= TI_DN) < TI_IN) { P = TrItem{inp(F, I_WIN), WSP(bf16, WS_WIN), inp(F, I_NMIX), NQKV, DM, 0, 0, 0, 0}; }
    else if ((r -= TI_IN) < TI_OUT) { P = TrItem{inp(F, I_WOUT) + (size_t)1024 * DM, WSP(bf16, WS_WOUT), nullptr, DM, DM, 1024, 0, 0, 0}; }
    else if ((r -= TI_OUT) < TI_GU) { P = TrItem{inp(F, I_WG2), WSP(bf16, WS_WGU2), inp(F, I_NF2), FF, DM, 0, 1, 0, 0}; }
    else if ((r -= TI_GU) < TI_GU) { P = TrItem{inp(F, I_WU2), WSP(bf16, WS_WGU2), inp(F, I_NF2), FF, DM, 0, 2, 0, 0}; }
    else { r -= TI_GU; P = TrItem{inp(F, I_WD2), WSP(bf16, WS_WD2), nullptr, DM, FF, 0, 0, 0, 0}; }
    nblk = P.N / 32; P.k0 = 64 * (r / nblk); P.n0 = 32 * (r % nblk); return P;
}
__device__ __forceinline__ void tr_range(Frame& F, int first, int last, int part, int nparts) {
    LAS float* scr = (LAS float*)(F.lds + RING_OFF + F.wave * 16384);
    if (first + part < last) {
        float wv[32], wn[32];
        TrItem cur = tr_item(F, first + part); tr_load(cur, wv, F.lane);
#pragma unroll 1
        for (int it = first + part; it < last; it += nparts) {
            const bool more = it + nparts < last; TrItem nxt = cur;
            if (more) { nxt = tr_item(F, it + nparts); tr_load(nxt, wn, F.lane); }
            tr_store(cur, wv, scr, F.lane);
            if (more) { cur = nxt;
#pragma unroll
                for (int i = 0; i < 32; ++i) wv[i] = wn[i]; }
        }
    }
}
__device__ __forceinline__ void tr_window(Frame& F, int first, int last, int wg_first) {
    const int c = (int)blockIdx.x, wf = wg_first < F.G ? wg_first : 0;
    if (c >= wf) tr_range(F, first, last, (c - wf) * NWAVES + F.wave, (F.G - wf) * NWAVES);
}
__device__ __forceinline__ void p0_prologue(Frame& F) {
    const int gw = F.vcu * NWAVES + F.wave, NGW = F.G * NWAVES;
    for (int tile = F.vcu; tile < 256; tile += F.G) poolfold_tile(F, tile);
    tr_range(F, 0, TR_GU1_END, gw, NGW);
    { const int gt = F.vcu * NWAVES * 64 + F.tid, NT = F.G * NWAVES * 64; f32x4* z = (f32x4*)(F.ws + WS_SSQ);
      for (int i = gt; i < (int)(SSQ_BYTES / 16); i += NT) z[i] = (f32x4){0.f, 0.f, 0.f, 0.f}; }
    {
        const float* g = inp(F, I_NF1);
        f32x4 v[8], w[8]; const float* xr = gw < MROWS ? x0_row(F, gw) : nullptr;
        if (xr) {
#pragma unroll
            for (int j = 0; j < 8; ++j) v[j] = ((const GAS f32x4*)xr)[F.lane + 64 * j]; }
#pragma unroll 1
        for (int m = gw; m < MROWS; m += NGW) {
            const int mn = m + NGW; const float* xn = mn < MROWS ? x0_row(F, mn) : nullptr;
            if (xn) {
#pragma unroll
                for (int j = 0; j < 8; ++j) w[j] = ((const GAS f32x4*)xn)[F.lane + 64 * j]; }
            GAS unsigned long long* o8 = (GAS unsigned long long*)(WSP(bf16, WS_XA) + (size_t)m * DM) + F.lane;
            if (!xr) {
#pragma unroll
                for (int j = 0; j < 8; ++j) o8[64 * j] = 0ull;
            } else {
                float s = 0.f;
#pragma unroll
                for (int j = 0; j < 8; ++j) s += (v[j].x * v[j].x + v[j].y * v[j].y) + (v[j].z * v[j].z + v[j].w * v[j].w);
                const float rs = rsqrtf(wave_sum(s) * (1.f / DM) + EPS);
#pragma unroll
                for (int j = 0; j < 8; ++j) { const f32x4 gv = ((const GAS f32x4*)g)[F.lane + 64 * j];
                    o8[64 * j] = (unsigned long long)pk2(v[j].x * rs * gv.x, v[j].y * rs * gv.y) | ((unsigned long long)pk2(v[j].z * rs * gv.z, v[j].w * rs * gv.w) << 32); }
            }
            xr = xn;
#pragma unroll
            for (int j = 0; j < 8; ++j) v[j] = w[j];
        }
    }
    { const int gt = F.vcu * NWAVES * 64 + F.tid, NT = F.G * NWAVES * 64;
      for (int i = gt; i < DB * 11 * 256; i += NT) { const int c4 = i & 255, r = (i >> 8) % 11, b = i / (11 * 256);
          ((f32x4*)(F.out + O_PS + ((size_t)b * 15 + r) * 1024))[c4] = ((const f32x4*)(inp(F, I_SPOOL) + ((size_t)b * 15 + 4 + r) * 1024))[c4]; } }
}

struct RSwiglu {
    static constexpr bool HAS_SSQ = false;
    bf16* act; const float* ssq;
    struct Pre { float q; };
    __device__ __forceinline__ void pre(int row, int, Pre& p) const { p.q = ssq ? ssq[row * SSQ_PAD] : 0.f; }
    __device__ __forceinline__ float tile(int row, int colbase, const float (&v)[2][8], const Pre& p) const {
        const float rs = ssq ? rsqrtf(p.q * (1.f / DM) + EPS) : 1.f;
        const int ff = (colbase >> 8) * 128 + (colbase & 127);
        float a[8];
#pragma unroll
        for (int j = 0; j < 8; ++j) { const float g = v[0][j] * rs, u = v[1][j] * rs; a[j] = g * u * __builtin_amdgcn_rcpf(1.f + __builtin_amdgcn_exp2f(g * -1.4426950408889634f)); }
        v4u o; o.x = pk2(a[0], a[1]); o.y = pk2(a[2], a[3]); o.z = pk2(a[4], a[5]); o.w = pk2(a[6], a[7]);
        *(GAS v4u*)(act + (size_t)row * FF + ff) = o; return 0.f;
    }
};
struct RResid {
    static constexpr bool HAS_SSQ = true;
    const Frame* Fp; int mode;
    float alpha;
    struct Pre { f32x4 a0, a1, b0, b1; v4u w0, w1; };
    __device__ __forceinline__ float resid_inplace(float (&v)[2][8], const Pre& p) const {
        float s = 0.f;
#pragma unroll
        for (int h = 0; h < 2; ++h) { const v4u w = h ? p.w1 : p.w0; const float rr_[8] = {bflo(w.x), bfhi(w.x), bflo(w.y), bfhi(w.y), bflo(w.z), bfhi(w.z), bflo(w.w), bfhi(w.w)};
#pragma unroll
            for (int j = 0; j < 8; ++j) { v[h][j] = rr_[j] + alpha * v[h][j]; s += v[h][j] * v[h][j]; } }
        return s;
    }
    __device__ __forceinline__ void pre(int row, int colbase, Pre& p) const {
        const Frame& F = *Fp;
        if (mode == 0) { const float* res = x0_row(F, row); p.a0 = p.a1 = p.b0 = p.b1 = (f32x4){0.f, 0.f, 0.f, 0.f};
            if (res) { p.a0 = *(const GAS f32x4*)(res + colbase); p.a1 = *(const GAS f32x4*)(res + colbase + 4); p.b0 = *(const GAS f32x4*)(res + colbase + 128); p.b1 = *(const GAS f32x4*)(res + colbase + 132); } }
        else { const bf16* xa = WSP(bf16, WS_XA) + (size_t)row * DM + colbase; p.w0 = *(const GAS v4u*)xa; p.w1 = *(const GAS v4u*)(xa + 128); }
    }
    __device__ __forceinline__ float tile(int row, int colbase, const float (&v)[2][8], const Pre& p) const {
        const Frame& F = *Fp;
        bf16* xa = WSP(bf16, WS_XA) + (size_t)row * DM;
        float* dst = mode != 2 ? nullptr : (row < MAIN ? F.out + O_YP + (size_t)row * DM : (row >= ROW_SAMP && row < ROW_SAMP + 32) ? F.out + O_YS + (size_t)(row - ROW_SAMP) * DM : nullptr);
        float s = 0.f;
#pragma unroll
        for (int h = 0; h < 2; ++h) { const int col = colbase + 128 * h;
            f32x4 r0, r1;
            if (mode == 0) { r0 = h ? p.b0 : p.a0; r1 = h ? p.b1 : p.a1; }
            else { const v4u w = h ? p.w1 : p.w0; r0 = (f32x4){bflo(w.x), bfhi(w.x), bflo(w.y), bfhi(w.y)}; r1 = (f32x4){bflo(w.z), bfhi(w.z), bflo(w.w), bfhi(w.w)}; }
            f32x4 a = {r0.x + alpha * v[h][0], r0.y + alpha * v[h][1], r0.z + alpha * v[h][2], r0.w + alpha * v[h][3]};
            f32x4 b = {r1.x + alpha * v[h][4], r1.y + alpha * v[h][5], r1.z + alpha * v[h][6], r1.w + alpha * v[h][7]};
            s += (a.x * a.x + a.y * a.y) + (a.z * a.z + a.w * a.w) + (b.x * b.x + b.y * b.y) + (b.z * b.z + b.w * b.w);
            if (mode == 2) { if (dst) { *(GAS f32x4*)(dst + col) = a; *(GAS f32x4*)(dst + col + 4) = b; } }
            else { v4u o; o.x = pk2(a.x, a.y); o.y = pk2(a.z, a.w); o.z = pk2(b.x, b.y); o.w = pk2(b.z, b.w); *(GAS v4u*)(xa + col) = o; } }
        return s;
    }
};
struct RProj {
    static constexpr bool HAS_SSQ = false;
    const Frame* Fp;
    __device__ __forceinline__ void put(int row, int col, const float (&x)[8]) const {
        const Frame& F = *Fp;
        const int t = col >> 10, c = col & 1023;
        v4u o; o.x = pk2(x[0], x[1]); o.y = pk2(x[2], x[3]); o.z = pk2(x[4], x[5]); o.w = pk2(x[6], x[7]);
        const f32x4 fa = {x[0], x[1], x[2], x[3]}, fb = {x[4], x[5], x[6], x[7]};
        if (row < MAIN) {
            const int b = row >> 12, tt = row & 4095;
            if (t == 0) { *(GAS v4u*)(WSP(bf16, WS_PB) + ((size_t)b * SP + 16 + tt) * 1024 + c) = o;
                if (tt >= SEQ - 15) { float* d = F.out + O_PP + ((size_t)b * 15 + (tt - (SEQ - 15))) * 1024 + c; *(GAS f32x4*)d = fa; *(GAS f32x4*)(d + 4) = fb; } }
            else if (t == 1) { *(GAS v4u*)(WSP(bf16, WS_Q) + (size_t)row * 1024 + c) = o; }
            else { *(GAS v4u*)(WSP(bf16, t == 2 ? WS_KB : WS_VB) + ((size_t)b * SKP + 16 + tt) * 1024 + c) = o;
                float* d = F.out + (t == 2 ? O_KP : O_VP) + ((size_t)b * SP + 16 + tt) * 1024 + c; *(GAS f32x4*)d = fa; *(GAS f32x4*)(d + 4) = fb; }
        } else if (row < ROW_SAMP) {
            const int i = row - ROW_META;
#pragma unroll
            for (int b = 0; b < NB; ++b) {
                if (t == 0) { *(GAS v4u*)(WSP(bf16, WS_PB) + ((size_t)b * SP + i) * 1024 + c) = o; }
                else if (t >= 2) { *(GAS v4u*)(WSP(bf16, t == 2 ? WS_KB : WS_VB) + ((size_t)b * SKP + i) * 1024 + c) = o;
                    float* d = F.out + (t == 2 ? O_KP : O_VP) + ((size_t)b * SP + i) * 1024 + c; *(GAS f32x4*)d = fa; *(GAS f32x4*)(d + 4) = fb; } }
        } else if (row < ROW_SAMP + 32) {
            const int j = row - ROW_SAMP, b = j >> 2, tt = j & 3;
            if (t == 0) { float* d = WSP(float, WS_PSN) + (size_t)j * 1024 + c; *(GAS f32x4*)d = fa; *(GAS f32x4*)(d + 4) = fb;
                float* e = F.out + O_PS + ((size_t)b * 15 + 11 + tt) * 1024 + c; *(GAS f32x4*)e = fa; *(GAS f32x4*)(e + 4) = fb; }
            else if (t == 1) { *(GAS v4u*)(WSP(bf16, WS_QS) + (size_t)j * 1024 + c) = o; }
            else { float* d = WSP(float, t == 2 ? WS_KS : WS_VS) + ((size_t)b * 64 + tt) * 1024 + c; *(GAS f32x4*)d = fa; *(GAS f32x4*)(d + 4) = fb;
                float* e = F.out + (t == 2 ? O_KS : O_VS) + (size_t)j * 1024 + c; *(GAS f32x4*)e = fa; *(GAS f32x4*)(e + 4) = fb; }
        }
    }
    struct Pre { float q; };
    __device__ __forceinline__ void pre(int row, int, Pre& p) const { p.q = ssq_ptr(*Fp, 0)[row * SSQ_PAD]; }
    __device__ __forceinline__ float tile(int row, int colbase, const float (&v)[2][8], const Pre& p) const {
        const float rs = rsqrtf(p.q * (1.f / DM) + EPS);
        float x[8];
#pragma unroll
        for (int h = 0; h < 2; ++h) {
#pragma unroll
            for (int j = 0; j < 8; ++j) x[j] = v[h][j] * rs;
            put(row, colbase + 128 * h, x); }
        return 0.f;
    }
};
struct SyncOrder {
    pg8::StaticOrder S; unsigned* cnt; unsigned nloc, xcc; int full_rounds; mutable int ui;
    __device__ bool next(int i, pg8::Unit& u) const { return S.next(i, u); }
    __device__ __forceinline__ void a_ready(const pg8::Unit&) const {
        const int i = ui++;
        if (i >= 1 && i < full_rounds) {
            if (threadIdx.x == 0) { unsigned* c = cnt + 64 * (xcc * 8 + i); __hip_atomic_fetch_add(c, 1u, RLX_AGENT); unsigned sp = 0;
                while (__hip_atomic_load(c, RLX_AGENT) < nloc) { __builtin_amdgcn_s_sleep(1); if (++sp > (1u << 16)) break; } }
            __builtin_amdgcn_s_barrier();
        }
    }
    __device__ __forceinline__ void done(const pg8::Unit&) const {}
};
struct RepOrder {
    pg8::StaticOrder S;
    int sh;
    __device__ bool next(int i, pg8::Unit& u) const { return S.next(i >> sh, u); }
    __device__ __forceinline__ void a_ready(const pg8::Unit&) const {}
    __device__ __forceinline__ void done(const pg8::Unit&) const {}
};
template <class R, int SKIP1 = 0> struct EpiFast {
    static constexpr bool PERM = true, AFTER_DRAIN = false;
    R r; float* ssq_dst; mutable int cnt; float* ssq_dummy;
    __device__ __forceinline__ void operator()(const pg8::f32x4 (&acc)[2][2][4][2], const pg8::Unit& u, int wr, int wc, int fr, int fq) const {
        float* sdst = ssq_dst;
        if constexpr (SKIP1 == 1) { const int msk = ((MK_REPEAT >> 15) & 1) ? 3 : 1; if (((cnt++) & msk) != msk) return; }
        if constexpr (SKIP1 == 2) { if (((cnt++) & 1) == 0) sdst = ssq_dummy; }
        const int colbase = u.pn * 256 + wc * 32 + 8 * fq, rowb = u.pm * 256 + wr * 64 + fr;
        typename R::Pre pp[2];
        r.pre(rowb, colbase, pp[0]);
#pragma unroll
        for (int i = 0; i < 8; ++i) {
            const int ai = i >> 2, m = i & 3, row = rowb + ai * 128 + m * 16;
            if (i + 1 < 8) r.pre(rowb + ((i + 1) >> 2) * 128 + ((i + 1) & 3) * 16, colbase, pp[(i + 1) & 1]);
            float v[2][8];
#pragma unroll
            for (int bj = 0; bj < 2; ++bj)
#pragma unroll
                for (int n = 0; n < 2; ++n)
#pragma unroll
                    for (int j = 0; j < 4; ++j) v[bj][4 * n + j] = acc[ai][bj][m][n][j];
            float s = r.tile(row, colbase, v, pp[i & 1]);
            if constexpr (R::HAS_SSQ) { s += __shfl_xor(s, 16); s += __shfl_xor(s, 32); if (fq == 0) __hip_atomic_fetch_add(sdst + row * SSQ_PAD, s, RLX_AGENT); }
        }
    }
};
template <class R> struct EpiDrain {
    static constexpr bool PERM = true, AFTER_DRAIN = true;
    R r; float* ssq_dst;
    __device__ __forceinline__ void operator()(const pg8::f32x4 (&)[2][2][4][2], const pg8::Unit&, int, int, int, int) const {}
    __device__ __forceinline__ void fused(const pg8::f32x4 (&acc)[2][2][4][2], const pg8::Unit& u, int wr, int wc, int fr, int fq, LAS unsigned char* lds, int wid, int lane) const {
        const int colbase = u.pn * 256 + wc * 32 + 8 * fq, rowb = u.pm * 256 + wr * 64 + fr;
        LAS float* tmp = (LAS float*)lds;
        typename R::Pre pp[2];
        r.pre(rowb, colbase, pp[0]);
#pragma unroll
        for (int i = 0; i < 8; ++i) {
            const int ai = i >> 2, m = i & 3, row = rowb + ai * 128 + m * 16;
            if (i + 1 < 8) r.pre(rowb + ((i + 1) >> 2) * 128 + ((i + 1) & 3) * 16, colbase, pp[(i + 1) & 1]);
            float v[2][8];
#pragma unroll
            for (int bj = 0; bj < 2; ++bj)
#pragma unroll
                for (int n = 0; n < 2; ++n)
#pragma unroll
                    for (int j = 0; j < 4; ++j) v[bj][4 * n + j] = acc[ai][bj][m][n][j];
            float s = r.tile(row, colbase, v, pp[i & 1]);
            s += __shfl_xor(s, 16); s += __shfl_xor(s, 32);
            if (fq == 0) tmp[wc * 256 + ai * 128 + wr * 64 + m * 16 + fr] = s;
        }
        __syncthreads();
        if (threadIdx.x < 256) { const int t = threadIdx.x; __hip_atomic_fetch_add(ssq_dst + (u.pm * 256 + t) * SSQ_PAD, (tmp[t] + tmp[256 + t]) + (tmp[512 + t] + tmp[768 + t]), RLX_AGENT); }
        __syncthreads();
    }
};
struct EpiFinal {
    static constexpr bool PERM = true, AFTER_DRAIN = true;
    const Frame* Fp; float* ssq; unsigned* cnt; const float* nf;
    __device__ __forceinline__ void operator()(const pg8::f32x4 (&)[2][2][4][2], const pg8::Unit&, int, int, int, int) const {}
    __device__ __forceinline__ void fused(const pg8::f32x4 (&acc_)[2][2][4][2], const pg8::Unit& u, int wr, int wc, int fr, int fq, LAS unsigned char* lds, int wid, int lane) const {
        const Frame& F = *Fp;
        auto& acc = const_cast<pg8::f32x4 (&)[2][2][4][2]>(acc_);
        const int colbase = u.pn * 256 + wc * 32 + 8 * fq, rowb = u.pm * 256 + wr * 64 + fr;
        v4u rw[2][2];
        { const bf16* res = WSP(bf16, WS_XA) + (size_t)rowb * DM + colbase; rw[0][0] = *(const GAS v4u*)res; rw[0][1] = *(const GAS v4u*)(res + 128); }
#pragma unroll
        for (int i = 0; i < 8; ++i) {
            const int ai = i >> 2, m = i & 3, row = rowb + ai * 128 + m * 16;
            if (i + 1 < 8) { const bf16* res = WSP(bf16, WS_XA) + (size_t)(rowb + ((i + 1) >> 2) * 128 + ((i + 1) & 3) * 16) * DM + colbase; rw[(i + 1) & 1][0] = *(const GAS v4u*)res; rw[(i + 1) & 1][1] = *(const GAS v4u*)(res + 128); }
            float s = 0.f;
#pragma unroll
            for (int bj = 0; bj < 2; ++bj) { const v4u w = rw[i & 1][bj];
#pragma unroll
                for (int n = 0; n < 2; ++n) { const f32x4 r4 = n == 0 ? (f32x4){bflo(w.x), bfhi(w.x), bflo(w.y), bfhi(w.y)} : (f32x4){bflo(w.z), bfhi(w.z), bflo(w.w), bfhi(w.w)}; f32x4 x = acc[ai][bj][m][n];
                    x.x = r4.x + 0.5f * x.x; x.y = r4.y + 0.5f * x.y; x.z = r4.z + 0.5f * x.z; x.w = r4.w + 0.5f * x.w; acc[ai][bj][m][n] = x;
                    s += (x.x * x.x + x.y * x.y) + (x.z * x.z + x.w * x.w); } }
            s += __shfl_xor(s, 16); s += __shfl_xor(s, 32);
            if (fq == 0) ((LAS float*)lds)[wc * 256 + ai * 128 + wr * 64 + m * 16 + fr] = s;
        }
        __syncthreads();
        if (threadIdx.x < 256) { const int t = threadIdx.x; const LAS float* tmp = (const LAS float*)lds; __hip_atomic_fetch_add(ssq + (u.pm * 256 + t) * SSQ_PAD, (tmp[t] + tmp[256 + t]) + (tmp[512 + t] + tmp[768 + t]), RLX_AGENT); }
        asm volatile("s_waitcnt vmcnt(0)" ::: "memory");
        __syncthreads();
        if (threadIdx.x == 0) {
            unsigned* c = cnt + 64 * u.pm;
            __hip_atomic_fetch_add(c, 1u, RLX_AGENT);
            unsigned sp = 0;
            while (__hip_atomic_load(c, RLX_AGENT) < (unsigned)(DM / 256)) { __builtin_amdgcn_s_sleep(1); if (++sp > (1u << 22)) break; }
        }
        __syncthreads();
        f32x4 g[2][2];
#pragma unroll
        for (int bj = 0; bj < 2; ++bj)
#pragma unroll
            for (int n = 0; n < 2; ++n) g[bj][n] = *(const GAS f32x4*)(nf + colbase + 128 * bj + 4 * n);
        float sq[8];
#pragma unroll
        for (int i = 0; i < 8; ++i) sq[i] = __hip_atomic_load(ssq + (rowb + (i >> 2) * 128 + (i & 3) * 16) * SSQ_PAD, RLX_AGENT);
#pragma unroll
        for (int i = 0; i < 8; ++i) {
            const int ai = i >> 2, m = i & 3, row = rowb + ai * 128 + m * 16;
            const float rs = rsqrtf(sq[i] * (1.f / DM) + EPS);
            float* y = F.out + O_YP + (size_t)row * DM + colbase;
#pragma unroll
            for (int bj = 0; bj < 2; ++bj)
#pragma unroll
                for (int n = 0; n < 2; ++n) { const f32x4 x = acc[ai][bj][m][n], gg = g[bj][n]; f32x4 o = {x.x * rs * gg.x, x.y * rs * gg.y, x.z * rs * gg.z, x.w * rs * gg.w};
                    *(GAS f32x4*)(y + 128 * bj + 4 * n) = o; }
        }
    }
};
constexpr int CW_TCNT = 12288;
static_assert((CW_TCNT + 64 * 16 + 16) * 4 <= (int)CTL_ZERO_BYTES && WS_SLAB + (size_t)64 * 8 * 4096 * 4 <= WS_END, "tail slabs");
template <class R>
__device__ __forceinline__ void gemm_simple_unit(Frame& F, const bf16* A, const bf16* Bt, int K, int N, int row0, int pn, int wc, int slice, int nsl, const R& r, float* ssq_dst, bool final_tail = false) {
    const int lane = F.lane, wid = F.wave, fr = lane & 15, fq = lane >> 4;
    const int nks = K / 32 / nsl, ks0 = slice * nks;
    f32x4 acc[4][2][2];
#pragma unroll
    for (int m = 0; m < 4; ++m)
#pragma unroll
        for (int bj = 0; bj < 2; ++bj)
#pragma unroll
            for (int n = 0; n < 2; ++n) acc[m][bj][n] = (f32x4){0.f, 0.f, 0.f, 0.f};
    const bf16* ap = A + (size_t)(row0 + fr) * K + ks0 * 32 + fq * 8;
    const bf16* bp = Bt + (size_t)(pn * 256 + wc * 32 + 8 * (fr >> 2) + (fr & 3)) * K + ks0 * 32 + fq * 8;
    bf16x8 a0[4], b0[2][2], a1[4], b1[2][2];
#define GS_LOAD(a_, b_, j_) do { _Pragma("unroll") for (int m = 0; m < 4; ++m) a_[m] = *(const GAS bf16x8*)(ap + (size_t)(16 * m) * K + (j_) * 32); \
        _Pragma("unroll") for (int bj = 0; bj < 2; ++bj) _Pragma("unroll") for (int n = 0; n < 2; ++n) b_[bj][n] = *(const GAS bf16x8*)(bp + (size_t)(bj * 128 + 4 * n) * K + (j_) * 32); } while (0)
#define GS_MMA(a_, b_) do { _Pragma("unroll") for (int m = 0; m < 4; ++m) _Pragma("unroll") for (int bj = 0; bj < 2; ++bj) _Pragma("unroll") for (int n = 0; n < 2; ++n) \
        acc[m][bj][n] = __builtin_amdgcn_mfma_f32_16x16x32_bf16(b_[bj][n], a_[m], acc[m][bj][n], 0, 0, 0); } while (0)
    if (wid < nks) GS_LOAD(a0, b0, wid);
    for (int j = wid; j < nks; j += 16) {
        if (j + 8 < nks) GS_LOAD(a1, b1, j + 8);
        GS_MMA(a0, b0);
        if (j + 16 < nks) GS_LOAD(a0, b0, j + 16);
        if (j + 8 < nks) GS_MMA(a1, b1);
    }
#undef GS_LOAD
#undef GS_MMA
    LAS float* part = (LAS float*)(F.lds + RING_OFF);
#pragma unroll
    for (int m = 0; m < 4; ++m)
#pragma unroll
        for (int bj = 0; bj < 2; ++bj)
#pragma unroll
            for (int n = 0; n < 2; ++n) *(LAS f32x4*)(part + ((wid * 64 + 16 * m + fr) * 64 + bj * 32 + 8 * fq + 4 * n)) = acc[m][bj][n];
    __syncthreads();
    const int rr = F.tid >> 2, sub = F.tid & 3, colbase = pn * 256 + wc * 32 + 8 * sub;
    float v[2][8];
    if (F.tid < 256) {
#pragma unroll
        for (int bj = 0; bj < 2; ++bj)
#pragma unroll
            for (int j = 0; j < 8; ++j) v[bj][j] = 0.f;
#pragma unroll
        for (int w = 0; w < 8; ++w)
#pragma unroll
            for (int bj = 0; bj < 2; ++bj) { const f32x4 p0 = *(LAS f32x4*)(part + ((w * 64 + rr) * 64 + bj * 32 + 8 * sub)), p1 = *(LAS f32x4*)(part + ((w * 64 + rr) * 64 + bj * 32 + 8 * sub + 4));
                v[bj][0] += p0.x; v[bj][1] += p0.y; v[bj][2] += p0.z; v[bj][3] += p0.w; v[bj][4] += p1.x; v[bj][5] += p1.y; v[bj][6] += p1.z; v[bj][7] += p1.w; }
    }
    if (nsl == 1) {
        if (F.tid < 256) { typename R::Pre p_; r.pre(row0 + rr, colbase, p_); float s = r.tile(row0 + rr, colbase, v, p_); if constexpr (R::HAS_SSQ) { s += __shfl_xor(s, 1); s += __shfl_xor(s, 2); if (sub == 0) __hip_atomic_fetch_add(ssq_dst + (row0 + rr) * SSQ_PAD, s, RLX_AGENT); } }
    } else {
        const int cu = pn * 4 + wc;
        const __amdgpu_buffer_rsrc_t srs = __builtin_amdgcn_make_buffer_rsrc((void*)(F.ws + WS_SLAB), 0, 64 * 8 * 16384, 0x00020000);
        const int sbase = __builtin_amdgcn_readfirstlane(cu * 8 * 16384), tq = (int)(F.tid & 255) * 16;
        unsigned* cnt = (unsigned*)(F.ws + WS_CTL) + CW_TCNT + 16 * cu;
        if (F.tid < 256) {
#pragma unroll
            for (int q = 0; q < 4; ++q) { const f32x4 d = {v[q >> 1][(q & 1) * 4 + 0], v[q >> 1][(q & 1) * 4 + 1], v[q >> 1][(q & 1) * 4 + 2], v[q >> 1][(q & 1) * 4 + 3]};
                __builtin_amdgcn_raw_buffer_store_b128(__builtin_bit_cast(v4u, d), srs, q * 4096 + tq, sbase + slice * 16384, 16); }
        }
        asm volatile("s_waitcnt vmcnt(0)" ::: "memory");
        __syncthreads();
        if (F.tid == 0) { const unsigned old = __hip_atomic_fetch_add(cnt, 1u, RLX_AGENT); F.MISC[20] = (old == (unsigned)(nsl - 1)) ? 1u : 0u; }
        __syncthreads();
        if (F.MISC[20] != 0u) {
            if (F.tid < 256) {
#pragma unroll
                for (int bj = 0; bj < 2; ++bj)
#pragma unroll
                    for (int j = 0; j < 8; ++j) v[bj][j] = 0.f;
#pragma unroll
                for (int s4 = 0; s4 < 8; s4 += 4) {
                    v4u t_[4][4];
                    if (s4 < nsl) {
#pragma unroll
                        for (int q = 0; q < 4; ++q)
#pragma unroll
                            for (int e = 0; e < 4; ++e) t_[q][e] = __builtin_amdgcn_raw_buffer_load_b128(srs, e * 4096 + tq, sbase + (s4 + q) * 16384, 16);
#pragma unroll
                        for (int q = 0; q < 4; ++q)
#pragma unroll
                            for (int e = 0; e < 4; ++e) { const f32x4 d = __builtin_bit_cast(f32x4, t_[q][e]); v[e >> 1][(e & 1) * 4 + 0] += d.x; v[e >> 1][(e & 1) * 4 + 1] += d.y; v[e >> 1][(e & 1) * 4 + 2] += d.z; v[e >> 1][(e & 1) * 4 + 3] += d.w; }
                    }
                }
                if (final_tail) {
                    if constexpr (R::HAS_SSQ) { typename R::Pre p_; r.pre(row0 + rr, colbase, p_); float s = r.resid_inplace(v, p_); s += __shfl_xor(s, 1); s += __shfl_xor(s, 2); if (sub == 0) __hip_atomic_fetch_add(ssq_dst + (row0 + rr) * SSQ_PAD, s, RLX_AGENT); }
                } else {
                typename R::Pre p_; r.pre(row0 + rr, colbase, p_); float s = r.tile(row0 + rr, colbase, v, p_); if constexpr (R::HAS_SSQ) { s += __shfl_xor(s, 1); s += __shfl_xor(s, 2); if (sub == 0) __hip_atomic_fetch_add(ssq_dst + (row0 + rr) * SSQ_PAD, s, RLX_AGENT); }
                }
            }
            if (F.tid == 0) __hip_atomic_store(cnt, 0u, RLX_AGENT);
            if (final_tail) {
                asm volatile("s_waitcnt vmcnt(0)" ::: "memory");
                __syncthreads();
                unsigned* fc = (unsigned*)(F.ws + WS_CTL) + CW_TCNT + 64 * 16;
                if (F.tid == 0) { __hip_atomic_fetch_add(fc, 1u, RLX_AGENT); unsigned sp = 0;
                    while (__hip_atomic_load(fc, RLX_AGENT) < (unsigned)((N / 256) * 4)) { __builtin_amdgcn_s_sleep(1); if (++sp > (1u << 22)) break; } }
                __syncthreads();
                const int row = row0 + rr;
                if (F.tid < 256 && row >= ROW_SAMP && row < ROW_SAMP + 32) {
                    const float rs = rsqrtf(__hip_atomic_load(ssq_dst + row * SSQ_PAD, RLX_AGENT) * (1.f / DM) + EPS);
                    const float* nf = inp(F, I_NFIN) + colbase; float* y = F.out + O_YS + (size_t)(row - ROW_SAMP) * DM + colbase;
#pragma unroll
                    for (int h = 0; h < 2; ++h) { const f32x4 g0 = *(const GAS f32x4*)(nf + 128 * h), g1 = *(const GAS f32x4*)(nf + 128 * h + 4);
                        *(GAS f32x4*)(y + 128 * h) = (f32x4){v[h][0] * rs * g0.x, v[h][1] * rs * g0.y, v[h][2] * rs * g0.z, v[h][3] * rs * g0.w};
                        *(GAS f32x4*)(y + 128 * h + 4) = (f32x4){v[h][4] * rs * g1.x, v[h][5] * rs * g1.y, v[h][6] * rs * g1.z, v[h][7] * rs * g1.w}; }
                }
            }
        }
    }
    __syncthreads();
}
#ifndef MK_REPEAT
#define MK_REPEAT 0
#endif
#ifndef MK_XSYNC
#define MK_XSYNC 0
#endif
constexpr int CW_XS = 32768;
constexpr int CW_PCNT = 8192;
static_assert((CW_PCNT + 64 * 32) * 4 <= (int)CTL_ZERO_BYTES, "ctl counters");
__device__ __forceinline__ void run_gemm_final_main(Frame& F, const bf16* A, const bf16* Bt) {
    pg8::Gemm g{A, Bt, MAIN, DM, FF}; pg8::StaticOrder S; S.init(MAIN, DM, F.G, (int)blockIdx.x);
    EpiFinal E{&F, ssq_ptr(F, 2), (unsigned*)(F.ws + WS_CTL) + CW_PCNT, inp(F, I_NFIN)};
    pg8::gemm_phase<EpiFinal, pg8::StaticOrder, false, true>(F.lds + RING_OFF, g, S, E);
}
template <class R, int PH>
__device__ __forceinline__ void run_gemm(Frame& F, const bf16* A, const bf16* Bt, int N, int K, const R& r, float* ssq_dst, int tail_off, bool skip_main = false, bool final_tail = false) {
    const bool one_unit = (MAIN / 256) * (N / 256) <= F.G;
    if constexpr (FAST_GEMM) if (!skip_main) {
        pg8::Gemm g{A, Bt, MAIN, N, K}; pg8::StaticOrder S; S.init(MAIN, N, F.G, (int)blockIdx.x);
        float* sdum = ssq_ptr(F, 3);
        if constexpr (((MK_REPEAT >> PH) & 1) != 0) { RepOrder RS{S, ((MK_REPEAT >> 15) & 1) ? 2 : 1}; EpiFast<R, 1> E{r, ssq_dst, 0, sdum}; pg8::gemm_phase<EpiFast<R, 1>, RepOrder, true, true>(F.lds + RING_OFF, g, RS, E); }
        else if constexpr (((MK_REPEAT >> (PH + 16)) & 1) != 0) { RepOrder RS{S, 1}; EpiFast<R, 2> E{r, ssq_dst, 0, sdum}; pg8::gemm_phase<EpiFast<R, 2>, RepOrder, true, true>(F.lds + RING_OFF, g, RS, E); }
        else if constexpr (MK_XSYNC != 0 && (PH == 1 || PH == 7 || PH == 3)) {
            const unsigned nloc = F.MISC[8];
            SyncOrder SS{S, (unsigned*)(F.ws + WS_CTL) + CW_XS + (PH == 1 ? 0 : PH == 3 ? 8192 : 16384), nloc ? nloc : 1u, xb_xcc_id(), (MAIN / 256) * (N / 256) / F.G, 0};
            EpiFast<R> E{r, ssq_dst, 0, sdum}; pg8::gemm_phase<EpiFast<R>, SyncOrder, true, true>(F.lds + RING_OFF, g, SS, E); }
        else if constexpr (R::HAS_SSQ) { if (one_unit) { EpiDrain<R> E{r, ssq_dst}; pg8::gemm_phase<EpiDrain<R>, pg8::StaticOrder, false, true>(F.lds + RING_OFF, g, S, E); } }
        else { EpiFast<R> E{r, ssq_dst, 0, sdum}; pg8::gemm_phase<EpiFast<R>, pg8::StaticOrder, true, true>(F.lds + RING_OFF, g, S, E); }
    }
    const int rb0 = (FAST_GEMM && (skip_main || !R::HAS_SSQ || one_unit)) ? MAIN / 64 : 0, nrb = MROWS / 64 - rb0, ncu = (N / 256) * 4, nun = nrb * ncu;
    const int nsl = (FAST_GEMM && tail_off == 0 && rb0 != 0) ? (256 / ncu > 8 ? 8 : 256 / ncu) : 1;
    const int tfirst = tail_off < F.G ? tail_off : 0;
    _Pragma("unroll 1") for (int rep_ = 0; rep_ < ((((MK_REPEAT >> 14) & 1) != 0 && PH != 6) ? 2 : 1); ++rep_)
    if ((int)blockIdx.x >= tfirst) for (int u = (int)blockIdx.x - tfirst; u < nun * nsl; u += F.G - tfirst) {
        const int uu = u / nsl, slice = u % nsl, rb = rb0 + uu / ncu, cu = uu % ncu;
        gemm_simple_unit<R>(F, A, Bt, K, N, rb * 64, cu >> 2, cu & 3, slice, nsl, r, (((MK_REPEAT >> 14) & 1) != 0 && PH != 6 && rep_ == 0) ? ssq_ptr(F, 3) : ssq_dst, final_tail && nsl > 1);
    }
}
namespace dattn {
typedef short bf16x8 __attribute__((ext_vector_type(8)));
typedef short s16x4 __attribute__((ext_vector_type(4)));
typedef float f32x16 __attribute__((ext_vector_type(16)));
typedef float f32x4 __attribute__((ext_vector_type(4)));
typedef unsigned u32x4 __attribute__((ext_vector_type(4)));
constexpr int NW = 8, QBLK = 32, KVBLK = 64, QB = 128, D = 128, PITCH = 1024;
constexpr int SHM_V = KVBLK * D * 2, SHM_K = KVBLK * D * 2;
constexpr int LDS_X = 2 * SHM_V + 2 * SHM_K;
constexpr int LDS_WSF = MISC_OFF + 256;
static_assert(LDS_X + 65536 <= RING_BYTES && LDS_WSF + NW * 512 + 16 <= LDS_BYTES, "attention LDS map");
constexpr float SCALE = 0.125f, THR = 8.f;
constexpr int NSPLIT = 4, OPW = 132;

#define KSWZ(row, colB) ((row) * 256 + ((colB) ^ (((row) & 7) << 4)))
#define SBAR() __builtin_amdgcn_sched_barrier(0)
__device__ __forceinline__ int v_st(int k, int c) { const int kk = (k & ~0xC) | ((k & 4) << 1) | ((k & 8) >> 1); return ((kk >> 3) * 4 + (c >> 5)) * 512 + ((kk & 7) * 32 + (c & 31)) * 2; }
__device__ __forceinline__ int v_rd_base(int lane) { return ((lane & 3) << 3) | (((lane >> 2) & 3) << 6) | (((lane >> 4) & 1) << 5) | (((lane >> 5) & 1) << 8); }
constexpr int v_rd_off(int d0, int ks, int half) { return d0 * 512 + ks * 4096 + half * 2048; }
__device__ __forceinline__ int crow(int r, int hi) { return (r & 3) + 8 * (r >> 2) + 4 * hi; }
__device__ __forceinline__ unsigned cvtpk(float lo, float hi) { unsigned r; asm volatile("v_cvt_pk_bf16_f32 %0, %1, %2" : "=v"(r) : "v"(lo), "v"(hi)); return r; }
__device__ __forceinline__ bf16x8 pack8(f32x4 a, f32x4 b) { u32x4 w = {cvtpk(a[0], a[1]), cvtpk(a[2], a[3]), cvtpk(b[0], b[1]), cvtpk(b[2], b[3])}; return *reinterpret_cast<bf16x8*>(&w); }
__device__ __forceinline__ void mask_tile(f32x16& p0, f32x16& p1, int dq) {
    const float NEG = -__builtin_inff();
#pragma unroll
    for (int r = 0; r < 16; ++r) { const int c = (r & 3) + 8 * (r >> 2); if (dq - c < 0) p0[r] = NEG; if (dq - c - 32 < 0) p1[r] = NEG; }
}
__device__ __forceinline__ void partialSM(f32x16& p0, f32x16& p1, float& m_reg, float& mn, float& alpha, float T0, float T1) {
    float pm0 = p0[0], pm1 = p1[0];
#pragma unroll
    for (int r = 1; r < 16; ++r) { pm0 = fmaxf(pm0, p0[r]); pm1 = fmaxf(pm1, p1[r]); }
    float pmax = fmaxf(pm0 + T0, pm1 + T1);
    { auto rr = __builtin_amdgcn_permlane32_swap(__float_as_uint(pmax), __float_as_uint(pmax), false, false);
      pmax = fmaxf(__uint_as_float(rr[0]), __uint_as_float(rr[1])); }
    constexpr float C2 = 1.4426950408889634f * SCALE;
    if (__builtin_expect(__all((pmax - m_reg) * SCALE <= THR), 1)) { mn = m_reg; alpha = 1.f; }
    else { mn = fmaxf(m_reg, pmax); alpha = __builtin_amdgcn_exp2f((m_reg - mn) * C2); m_reg = mn; }
    const float L0 = (T0 - mn) * C2, L1 = (T1 - mn) * C2;
#pragma unroll
    for (int r = 0; r < 16; ++r) p0[r] = fmaf(p0[r], C2, L0);
#pragma unroll
    for (int r = 0; r < 16; ++r) p1[r] = fmaf(p1[r], C2, L1);
#pragma unroll
    for (int r = 0; r < 16; ++r) p0[r] = __builtin_amdgcn_exp2f(p0[r]);
}
__device__ __forceinline__ void finishSM(f32x16& p0, f32x16& p1, float alpha, float& l_reg, bf16x8& pa0, bf16x8& pa1, bf16x8& pa2, bf16x8& pa3) {
#pragma unroll
    for (int r = 0; r < 16; ++r) p1[r] = __builtin_amdgcn_exp2f(p1[r]);
    float ps = 0;
#pragma unroll
    for (int r = 0; r < 16; ++r) ps += p0[r];
#pragma unroll
    for (int r = 0; r < 16; ++r) ps += p1[r];
    { auto rr = __builtin_amdgcn_permlane32_swap(__float_as_uint(ps), __float_as_uint(ps), false, false);
      ps = __uint_as_float(rr[0]) + __uint_as_float(rr[1]); }
    l_reg = l_reg * alpha + ps;
#define PK4(P, B_, OUT) do { unsigned a0 = cvtpk(P[B_+0], P[B_+1]), a1 = cvtpk(P[B_+2], P[B_+3]);                          \
        unsigned b0 = cvtpk(P[B_+4], P[B_+5]), b1 = cvtpk(P[B_+6], P[B_+7]);                                             \
        auto r0 = __builtin_amdgcn_permlane32_swap(a0, b0, false, false); auto r1 = __builtin_amdgcn_permlane32_swap(a1, b1, false, false); \
        u32x4 w = {r0[0], r1[0], r0[1], r1[1]}; OUT = *reinterpret_cast<bf16x8*>(&w); } while (0)
    PK4(p0, 0, pa0); PK4(p0, 8, pa1); PK4(p1, 0, pa2); PK4(p1, 8, pa3);
#undef PK4
}
template <int KB>
__device__ __forceinline__ void qkt(f32x16& p0, f32x16& p1, const char* K_lds, int r32, int hi, int sub, const bf16x8* qr, const float* cvp_) {
    unsigned cvo = (unsigned)(uintptr_t)cvp_; asm volatile("" : "+v"(cvo));
    const __attribute__((address_space(3))) float* cvp = (const __attribute__((address_space(3))) float*)cvo;
    f32x16 cvec;
#pragma unroll
    for (int q4 = 0; q4 < 4; ++q4) { const f32x4 t = *(const __attribute__((address_space(3))) f32x4*)(cvp + 4 * q4); cvec[4 * q4] = t[0]; cvec[4 * q4 + 1] = t[1]; cvec[4 * q4 + 2] = t[2]; cvec[4 * q4 + 3] = t[3]; }
    const char* kb[4];
#pragma unroll
    for (int dd = 0; dd < 4; ++dd) kb[dd] = K_lds + KB * SHM_K + KSWZ(r32, (dd * 16 + hi * 8) * 2) + sub * 128;
#pragma unroll
    for (int dd = 0; dd < 4; ++dd) {
        bf16x8 b0 = *reinterpret_cast<const bf16x8*>(kb[dd]);
        bf16x8 b1 = *reinterpret_cast<const bf16x8*>(kb[dd] + 32 * 256);
        if (dd == 0) { p0 = __builtin_amdgcn_mfma_f32_32x32x16_bf16(b0, qr[0], cvec, 0, 0, 0); p1 = __builtin_amdgcn_mfma_f32_32x32x16_bf16(b1, qr[0], cvec, 0, 0, 0); }
        else { p0 = __builtin_amdgcn_mfma_f32_32x32x16_bf16(b0, qr[dd], p0, 0, 0, 0); p1 = __builtin_amdgcn_mfma_f32_32x32x16_bf16(b1, qr[dd], p1, 0, 0, 0); } }
}
template <int VB>
__device__ __forceinline__ void pv_tile(f32x16* o, int vb0, bf16x8 pa0, bf16x8 pa1, bf16x8 pa2, bf16x8 pa3) {
#define TRRD(dst, off) asm volatile("ds_read_b64_tr_b16 %0, %1 offset:%2" : "=&v"(dst) : "v"(vb0), "i"(off) : "memory")
#define PV_D0(d0) do { s16x4 l0, l1, l2, l3, h0, h1, h2, h3; constexpr int b_ = VB * SHM_V + v_rd_off(d0, 0, 0); \
        TRRD(l0, b_); TRRD(h0, b_ + 2048); TRRD(l1, b_ + 4096); TRRD(h1, b_ + 6144); TRRD(l2, b_ + 8192); TRRD(h2, b_ + 10240); TRRD(l3, b_ + 12288); TRRD(h3, b_ + 14336); \
        asm volatile("s_waitcnt lgkmcnt(0)" ::: "memory"); SBAR();   \
        o[d0] = __builtin_amdgcn_mfma_f32_32x32x16_bf16(pa0, (bf16x8){l0[0], l0[1], l0[2], l0[3], h0[0], h0[1], h0[2], h0[3]}, o[d0], 0, 0, 0);   \
        o[d0] = __builtin_amdgcn_mfma_f32_32x32x16_bf16(pa1, (bf16x8){l1[0], l1[1], l1[2], l1[3], h1[0], h1[1], h1[2], h1[3]}, o[d0], 0, 0, 0);   \
        o[d0] = __builtin_amdgcn_mfma_f32_32x32x16_bf16(pa2, (bf16x8){l2[0], l2[1], l2[2], l2[3], h2[0], h2[1], h2[2], h2[3]}, o[d0], 0, 0, 0);   \
        o[d0] = __builtin_amdgcn_mfma_f32_32x32x16_bf16(pa3, (bf16x8){l3[0], l3[1], l3[2], l3[3], h3[0], h3[1], h3[2], h3[3]}, o[d0], 0, 0, 0); } while (0)
    PV_D0(0); PV_D0(1); PV_D0(2); PV_D0(3);
#undef PV_D0
#undef TRRD
}

struct Blk { const bf16* Q; const void* K; const void* V; const float* Kn; const float* Vn; const int* pt; void* O; int P0, t0, NT; float A; };
template <bool DEC> __device__ __forceinline__ const void* tile_ptr(const Blk& b, const void* base, const float* nw, int t) {
    const int gt = b.t0 + t;
    if constexpr (!DEC) { return (const bf16*)base + (size_t)gt * KVBLK * PITCH; }
    else { if (gt >= PAST / KVBLK) return nw; const int pg = ((const __attribute__((address_space(4))) int*)(unsigned long long)b.pt)[gt >> 1];   return (const float*)base + ((size_t)pg * PAGE + (gt & 1) * KVBLK) * PITCH; }
}
struct Seam { bf16x8 qr[4]; bf16x8 st_v0, st_v1, st_k0, st_k1; f32x4 sf0, sf1, sf2, sf3; };
#define VMW() asm volatile("s_waitcnt vmcnt(0)" ::: "memory")
#define VMWN(n) asm volatile("s_waitcnt vmcnt(%0)" :: "i"(n) : "memory")
#define ROWH(p, half) ((const bf16*)(p) + (half) * 32 * PITCH + toff)
#define ROWF(p, half) ((const float*)(p) + (half) * 32 * PITCH + toff)
#define SLOAD_H(Kp, Vp) do { S.st_v0 = *(const bf16x8*)ROWH(Vp, 0); S.st_v1 = *(const bf16x8*)ROWH(Vp, 1); S.st_k0 = *(const bf16x8*)ROWH(Kp, 0); S.st_k1 = *(const bf16x8*)ROWH(Kp, 1); } while (0)
#define SWRITE_HK(bf) do { *(bf16x8*)(K_lds + (bf) * SHM_K + kws) = S.st_k0; *(bf16x8*)(K_lds + (bf) * SHM_K + kws + 32 * 256) = S.st_k1; } while (0)
#define SWRITE_HV(bf) do { *(bf16x8*)(V_lds + (bf) * SHM_V + vst0) = S.st_v0; *(bf16x8*)(V_lds + (bf) * SHM_V + vst0 + 8192) = S.st_v1; } while (0)
#define SWRITE_H(bf) do { SWRITE_HV(bf); SWRITE_HK(bf); } while (0)
#define SLOAD_F(p) do { S.sf0 = *(const f32x4*)ROWF(p, 0); S.sf1 = *(const f32x4*)(ROWF(p, 0) + 4); S.sf2 = *(const f32x4*)ROWF(p, 1); S.sf3 = *(const f32x4*)(ROWF(p, 1) + 4); } while (0)
#define SWRITE_KF(bf) do { *(bf16x8*)(K_lds + (bf) * SHM_K + kws) = pack8(S.sf0, S.sf1); *(bf16x8*)(K_lds + (bf) * SHM_K + kws + 32 * 256) = pack8(S.sf2, S.sf3); } while (0)
#define SWRITE_VF(bf) do { *(bf16x8*)(V_lds + (bf) * SHM_V + vst0) = pack8(S.sf0, S.sf1); *(bf16x8*)(V_lds + (bf) * SHM_V + vst0 + 8192) = pack8(S.sf2, S.sf3); } while (0)
#define QLOAD(blk) do { const bf16* q_ = (blk).Q + (unsigned)((DEC ? (r32 & 3) : ((wid & 3) * QBLK + r32)) * PITCH + sub * 64 + hi * 8); \
        _Pragma("unroll") for (int d0 = 0; d0 < 4; ++d0) S.qr[d0] = *(const bf16x8*)(q_ + d0 * 16); } while (0)
template <bool DEC>
__device__ __forceinline__ void attn_prime(const Blk& cur, char* lds, Seam& S) {
    const int tid = threadIdx.x, wid = __builtin_amdgcn_readfirstlane(tid >> 6), lane = tid & 63, r32 = lane & 31, hi = lane >> 5, sub = wid >> 2;
    const int sr = tid >> 4, sc = (tid & 15) * 8, kws = KSWZ(sr, sc * 2); char* K_lds = lds + 2 * SHM_V;
    const unsigned toff = (unsigned)(sr * PITCH + sc);
    QLOAD(cur);
    const void* k0 = tile_ptr<DEC>(cur, cur.K, cur.Kn, 0); const void* v0 = tile_ptr<DEC>(cur, cur.V, cur.Vn, 0);
    if constexpr (DEC) { SLOAD_F(k0); VMW(); SWRITE_KF(0); SBAR(); SLOAD_F(v0); }
    else { SLOAD_H(k0, v0); VMW(); SWRITE_HK(0); }
    __syncthreads();
}
template <bool DEC>
__device__ __forceinline__ void attn_block(const Blk& cur, const Blk& nxt, float lam, const float* gain, char* lds, Seam& S) {
    constexpr bool F32 = DEC;
    const int tid = threadIdx.x, wid = __builtin_amdgcn_readfirstlane(tid >> 6), lane = tid & 63, r32 = lane & 31, hi = lane >> 5, sub = wid >> 2;
    const bool act = DEC ? ((wid & 3) == sub) : true;
    const int NT = cur.NT;
    const int qlo = cur.P0 + (DEC ? 0 : (wid & 3) * QBLK);
    char* V_lds = lds; char* K_lds = lds + 2 * SHM_V;
    float* ws = (float*)(lds + LDS_WSF) + wid * 128; float* li_l = ws, * al_l = ws + 32;
    float m_reg = -1e30f, l_reg = 0; f32x16 o[4] = {};
    const int sr = tid >> 4, sc = (tid & 15) * 8, vst0 = v_st(sr, sc), kws = KSWZ(sr, sc * 2);
    const unsigned toff = (unsigned)(sr * PITCH + sc);
    const int vb0 = (int)(uintptr_t)V_lds + v_rd_base(lane);
    const float A = cur.A;
    const float* cvec = ws + 64 + hi * 16;
    if (r32 < 16) ws[64 + lane - 16 * hi] = A * (float)crow(lane & 15, hi);
    asm volatile("s_waitcnt lgkmcnt(0)" ::: "memory");
#define RESC(a) do { if (__any((a) < 1.f)) { if (hi == 0) al_l[r32] = (a); asm volatile("s_waitcnt lgkmcnt(0)" ::: "memory");              \
                     _Pragma("unroll") for (int d_ = 0; d_ < 4; ++d_) _Pragma("unroll") for (int r = 0; r < 16; ++r) o[d_][r] *= al_l[crow(r, hi)]; } } while (0)
#define KBASE(t) ((cur.t0 + (t)) * KVBLK)
#define KP(t) tile_ptr<DEC>(cur, cur.K, cur.Kn, (t))
#define VP(t) tile_ptr<DEC>(cur, cur.V, cur.Vn, (t))
#define TOFF(t) (A * (float)(KBASE(t) - cur.P0))
#define MASKT(P0_, P1_, t) do { const int kb_ = KBASE(t); if (kb_ + KVBLK - 1 > qlo) { unsigned l_; asm volatile("v_mbcnt_lo_u32_b32 %0, -1, 0\n\tv_mbcnt_hi_u32_b32 %0, -1, %0" : "=v"(l_)); mask_tile(P0_, P1_, qlo + (int)(l_ & 31u) - 4 * (int)(l_ >> 5) - kb_); } } while (0)
#define PSM(P0_, P1_, mnX, alX, t) do { const float t0_ = TOFF(t); partialSM(P0_, P1_, m_reg, mnX, alX, t0_, t0_ + 32.f * A); } while (0)
    constexpr int NQL = 4;
#define SEAM_K0() do { VMWN(NQL); if constexpr (F32) { SWRITE_KF(0); SBAR(); SLOAD_F(nv0); } else { SWRITE_HK(0); } SBAR(); } while (0)
    const void* nk0 = tile_ptr<DEC>(nxt, nxt.K, nxt.Kn, 0); const void* nv0 = tile_ptr<DEC>(nxt, nxt.V, nxt.Vn, 0);
    f32x16 pA0, pA1, pB0, pB1; float mnA, mnB, alA = 1.f, alB = 1.f; bf16x8 pa0, pa1, pa2, pa3;
    if constexpr (F32) { VMW(); SWRITE_VF(0); SBAR(); } else { SWRITE_HV(0); SBAR(); }
    if (NT > 1) { if constexpr (F32) SLOAD_F(KP(1)); else SLOAD_H(KP(1), VP(1)); }
    SBAR(); if (act) qkt<0>(pA0, pA1, K_lds, r32, hi, sub, S.qr, cvec);
    if constexpr (F32) { if (NT > 1) { VMW(); SWRITE_KF(1); SBAR(); SLOAD_F(VP(1)); } }
    if (act) { MASKT(pA0, pA1, 0); PSM(pA0, pA1, mnA, alA, 0); }
    if (NT > 1) { VMW(); if constexpr (F32) { SWRITE_VF(1); SBAR(); if (NT > 2) SLOAD_F(KP(2)); } else SWRITE_H(1); }
    __syncthreads();
#define HALF_STEP(PX0, PX1, mnX, alX, PY0, PY1, alY, t, KB, VB, SB) do {                                                      \
        SBAR(); if (act) qkt<KB>(PX0, PX1, K_lds, r32, hi, sub, S.qr, cvec);                                                   \
        if (act) finishSM(PY0, PY1, alY, l_reg, pa0, pa1, pa2, pa3); SBAR();                                                   \
        if ((t) + 1 < NT) { if constexpr (F32) { VMW(); SWRITE_KF(SB); SBAR(); SLOAD_F(VP((t) + 1)); }                       \
                            else { SLOAD_H(KP((t) + 1), VP((t) + 1)); } SBAR(); }                                             \
        if (act) { pv_tile<VB>(o, vb0, pa0, pa1, pa2, pa3); MASKT(PX0, PX1, (t)); PSM(PX0, PX1, mnX, alX, (t)); }             \
        __syncthreads();                                                                                                      \
        if ((t) + 1 < NT) { VMW(); if constexpr (F32) { SWRITE_VF(SB); SBAR(); if ((t) + 2 < NT) SLOAD_F(KP((t) + 2)); }     \
                            else { SWRITE_H(SB); } }                                                                          \
        if (act) RESC(alX); __syncthreads(); } while (0)
    for (int t = 1; t + 1 < NT; t += 2) {
        HALF_STEP(pB0, pB1, mnB, alB, pA0, pA1, alA, t, 1, 0, 0);
        HALF_STEP(pA0, pA1, mnA, alA, pB0, pB1, alB, t + 1, 0, 1, 1);
    }
    const bool even = (NT & 1) == 0;
    if (even) { SBAR(); if (act) qkt<1>(pB0, pB1, K_lds, r32, hi, sub, S.qr, cvec); SBAR(); }
    if constexpr (F32) { SLOAD_F(nk0); SBAR(); } else { SLOAD_H(nk0, nv0); SBAR(); }
    QLOAD(nxt);
    SBAR();
    if (act) finishSM(pA0, pA1, alA, l_reg, pa0, pa1, pa2, pa3);
    SBAR();
    if (act) pv_tile<0>(o, vb0, pa0, pa1, pa2, pa3);
    if (even) { if (act) { MASKT(pB0, pB1, NT - 1); PSM(pB0, pB1, mnB, alB, NT - 1); } __syncthreads(); if (act) { RESC(alB);
        finishSM(pB0, pB1, alB, l_reg, pa0, pa1, pa2, pa3); SBAR(); pv_tile<1>(o, vb0, pa0, pa1, pa2, pa3); } }
    SBAR(); SEAM_K0();
    if (act && hi == 0) li_l[r32] = l_reg;
    asm volatile("s_waitcnt lgkmcnt(0)" ::: "memory");
    if constexpr (DEC) {
        if (act) {
            float* op = (float*)cur.O + (size_t)sub * 4 * OPW;
            if (hi == 0) {
#pragma unroll
                for (int r = 0; r < 4; ++r)
#pragma unroll
                    for (int d0 = 0; d0 < 4; ++d0) op[(unsigned)(r * OPW + d0 * 32 + r32)] = o[d0][r];
                if (r32 < 4) { op[(unsigned)(r32 * OPW + 128)] = m_reg; op[(unsigned)(r32 * OPW + 129)] = l_reg; }
            }
        }
        __syncthreads();
    } else {
        int lane_o = lane; asm volatile("" : "+v"(lane_o));
        float rli[16];
#pragma unroll
        for (int r = 0; r < 16; ++r) rli[r] = __builtin_amdgcn_rcpf(li_l[crow(r, hi)]);
        float* X = (float*)(lds + LDS_X) + (wid & 3) * 4096 + lane_o;
        if (sub == 1) {
#pragma unroll
            for (int d0 = 0; d0 < 4; ++d0)
#pragma unroll
                for (int r = 0; r < 16; ++r) X[(d0 * 16 + r) * 64] = lam * (o[d0][r] * rli[r]);
        }
        __syncthreads();
        if (sub == 0) {
            float ssr[16];
#pragma unroll
            for (int r = 0; r < 16; ++r) { float s = 0.f;
#pragma unroll
                for (int d0 = 0; d0 < 4; ++d0) { const float x = o[d0][r] * rli[r] - X[(d0 * 16 + r) * 64]; o[d0][r] = x; s += x * x; }
                ssr[r] = s; }
#pragma unroll
            for (int r = 0; r < 16; ++r) {
#pragma unroll
                for (int off = 1; off < 32; off <<= 1) ssr[r] += __shfl_xor(ssr[r], off); }
            float g[4];
#pragma unroll
            for (int d0 = 0; d0 < 4; ++d0) g[d0] = gain[d0 * 32 + (lane_o & 31)] * 0.8f;
            const int r32o = lane_o & 31, hio = lane_o >> 5;
            char* Ow = (char*)cur.O + (unsigned)((((wid & 3) * QBLK + 4 * hio) * DM + r32o) * 2);
#pragma unroll
            for (int r = 0; r < 16; ++r) { const int orow = (r & 3) + 8 * (r >> 2); const float rn = rsqrtf(ssr[r] * (1.f / D) + EPS);
#pragma unroll
                for (int d0 = 0; d0 < 4; ++d0) { const float v = o[d0][r] * rn * g[d0]; const float vn = __shfl_xor(v, 1);
                    if ((r32 & 1) == 0) *(unsigned*)(Ow + (orow * DM + d0 * 32) * 2) = cvtpk(v, vn); } }
        }
        __syncthreads();
    }
#undef RESC
#undef KBASE
#undef KP
#undef VP
#undef TOFF
#undef MASKT
#undef PSM
#undef SEAM_K0
#undef HALF_STEP
}
struct StageF { f32x4 k0, k1, k2, k3, v0, v1, v2, v3; };
#define DLOAD(R, Kp, Vp) do { const float* k_ = ROWF(Kp, 0); const float* k2_ = ROWF(Kp, 1); const float* v_ = ROWF(Vp, 0); const float* v2_ = ROWF(Vp, 1); \
        R.k0 = *(const f32x4*)k_; R.k1 = *(const f32x4*)(k_ + 4); R.k2 = *(const f32x4*)k2_; R.k3 = *(const f32x4*)(k2_ + 4); \
        R.v0 = *(const f32x4*)v_; R.v1 = *(const f32x4*)(v_ + 4); R.v2 = *(const f32x4*)v2_; R.v3 = *(const f32x4*)(v2_ + 4); } while (0)
#define DWRITE(R, bf) do { *(bf16x8*)(K_lds + (bf) * SHM_K + kws) = pack8(R.k0, R.k1); *(bf16x8*)(K_lds + (bf) * SHM_K + kws + 32 * 256) = pack8(R.k2, R.k3); \
        *(bf16x8*)(V_lds + (bf) * SHM_V + vst0) = pack8(R.v0, R.v1); *(bf16x8*)(V_lds + (bf) * SHM_V + vst1) = pack8(R.v2, R.v3); } while (0)
template <int KB>
__device__ __forceinline__ void qkt_half(f32x16& p, const char* K_lds, int r32, int hi, int sub, int half, const bf16x8* qr, const float* cvp_) {
    unsigned cvo = (unsigned)(uintptr_t)cvp_; asm volatile("" : "+v"(cvo));
    const __attribute__((address_space(3))) float* cvp = (const __attribute__((address_space(3))) float*)cvo;
    f32x16 cvec;
#pragma unroll
    for (int q4 = 0; q4 < 4; ++q4) { const f32x4 t = *(const __attribute__((address_space(3))) f32x4*)(cvp + 4 * q4); cvec[4 * q4] = t[0]; cvec[4 * q4 + 1] = t[1]; cvec[4 * q4 + 2] = t[2]; cvec[4 * q4 + 3] = t[3]; }
    const char* kb[4];
#pragma unroll
    for (int dd = 0; dd < 4; ++dd) kb[dd] = K_lds + KB * SHM_K + KSWZ(r32, (dd * 16 + hi * 8) * 2) + sub * 128 + half * (32 * 256);
#pragma unroll
    for (int dd = 0; dd < 4; ++dd) { bf16x8 b0 = *reinterpret_cast<const bf16x8*>(kb[dd]);
        if (dd == 0) p = __builtin_amdgcn_mfma_f32_32x32x16_bf16(b0, qr[0], cvec, 0, 0, 0); else p = __builtin_amdgcn_mfma_f32_32x32x16_bf16(b0, qr[dd], p, 0, 0, 0); }
}
__device__ __forceinline__ void softmax_half(f32x16& p, float& m_reg, float& alpha, float& l_reg, float T, bf16x8& pa0, bf16x8& pa1) {
    float pm = p[0];
#pragma unroll
    for (int r = 1; r < 16; ++r) pm = fmaxf(pm, p[r]);
    float pmax = pm + T;
    { auto rr = __builtin_amdgcn_permlane32_swap(__float_as_uint(pmax), __float_as_uint(pmax), false, false);
      pmax = fmaxf(__uint_as_float(rr[0]), __uint_as_float(rr[1])); }
    constexpr float C2 = 1.4426950408889634f * SCALE;
    float mn;
    if (__builtin_expect(__all((pmax - m_reg) * SCALE <= THR), 1)) { mn = m_reg; alpha = 1.f; }
    else { mn = fmaxf(m_reg, pmax); alpha = __builtin_amdgcn_exp2f((m_reg - mn) * C2); m_reg = mn; }
    const float L = (T - mn) * C2;
    float ps = 0.f;
#pragma unroll
    for (int r = 0; r < 16; ++r) { p[r] = __builtin_amdgcn_exp2f(fmaf(p[r], C2, L)); ps += p[r]; }
    { auto rr = __builtin_amdgcn_permlane32_swap(__float_as_uint(ps), __float_as_uint(ps), false, false);
      ps = __uint_as_float(rr[0]) + __uint_as_float(rr[1]); }
    l_reg = l_reg * alpha + ps;
#define PK4(P, B_, OUT) do { unsigned a0 = cvtpk(P[B_+0], P[B_+1]), a1 = cvtpk(P[B_+2], P[B_+3]);                          \
        unsigned b0 = cvtpk(P[B_+4], P[B_+5]), b1 = cvtpk(P[B_+6], P[B_+7]);                                             \
        auto r0 = __builtin_amdgcn_permlane32_swap(a0, b0, false, false); auto r1 = __builtin_amdgcn_permlane32_swap(a1, b1, false, false); \
        u32x4 w = {r0[0], r1[0], r0[1], r1[1]}; OUT = *reinterpret_cast<bf16x8*>(&w); } while (0)
    PK4(p, 0, pa0); PK4(p, 8, pa1);
#undef PK4
}
template <int VB>
__device__ __forceinline__ void pv_half(f32x16* o, int vbh  , bf16x8 pa0, bf16x8 pa1) {
#define TRRD(dst, off) asm volatile("ds_read_b64_tr_b16 %0, %1 offset:%2" : "=&v"(dst) : "v"(vbh), "i"(off) : "memory")
    s16x4 l0[4], h0[4], l1[4], h1[4];
#define PV_RD(d0) do { constexpr int b_ = VB * SHM_V + v_rd_off(d0, 0, 0); TRRD(l0[d0], b_); TRRD(h0[d0], b_ + 2048); TRRD(l1[d0], b_ + 4096); TRRD(h1[d0], b_ + 6144); } while (0)
#define PV_MM(d0, PA, L_, H_) o[d0] = __builtin_amdgcn_mfma_f32_32x32x16_bf16(PA, (bf16x8){L_[d0][0], L_[d0][1], L_[d0][2], L_[d0][3], H_[d0][0], H_[d0][1], H_[d0][2], H_[d0][3]}, o[d0], 0, 0, 0)
    PV_RD(0); PV_RD(1); PV_RD(2); PV_RD(3);
    asm volatile("s_waitcnt lgkmcnt(8)" ::: "memory"); SBAR();
    PV_MM(0, pa0, l0, h0); PV_MM(1, pa0, l0, h0); PV_MM(0, pa1, l1, h1); PV_MM(1, pa1, l1, h1);
    asm volatile("s_waitcnt lgkmcnt(0)" ::: "memory"); SBAR();
    PV_MM(2, pa0, l0, h0); PV_MM(3, pa0, l0, h0); PV_MM(2, pa1, l1, h1); PV_MM(3, pa1, l1, h1);
#undef PV_RD
#undef PV_MM
#undef TRRD
}
struct DecFin { unsigned* cnt; const float* pbase; bf16* dst; const float* gain; float lam; };
__device__ __forceinline__ void dec_unit(const Blk& cur, char* lds, const DecFin& fin) {
    constexpr bool DEC = true;
    const int tid = threadIdx.x, wid = __builtin_amdgcn_readfirstlane(tid >> 6), lane = tid & 63, r32 = lane & 31, hi = lane >> 5, sub = wid >> 2, half = wid & 1;
    const bool act = sub == 0 ? (wid & 3) < 2 : (wid & 3) >= 2;
    const int NT = cur.NT;
    const int qlo = cur.P0, qm = qlo + r32 - 4 * hi - 32 * half;
    char* V_lds = lds; char* K_lds = lds + 2 * SHM_V;
    float* ws = (float*)(lds + LDS_WSF) + wid * 128; float* al_l = ws + 32;
    float m_reg = -1e30f, l_reg = 0; f32x16 o[4] = {};
    const int sr = tid >> 4, sc = (tid & 15) * 8, vst0 = v_st(sr, sc), vst1 = v_st(32 + sr, sc), kws = KSWZ(sr, sc * 2);
    const unsigned toff = (unsigned)(sr * PITCH + sc);
    const int vbh = (int)(uintptr_t)V_lds + v_rd_base(lane) + half * 8192;
    const float A = cur.A;
    const float* cvec = ws + 64 + hi * 16;
    if (r32 < 16) ws[64 + lane - 16 * hi] = A * (float)crow(lane & 15, hi);
    asm volatile("s_waitcnt lgkmcnt(0)" ::: "memory");
    Seam S; QLOAD(cur);
    StageF RA, RB;
#define KP(t) tile_ptr<true>(cur, cur.K, cur.Kn, (t))
#define VP(t) tile_ptr<true>(cur, cur.V, cur.Vn, (t))
#define KBASE(t) ((cur.t0 + (t)) * KVBLK)
#define PGE(t) (((const __attribute__((address_space(4))) int*)(unsigned long long)cur.pt)[((cur.t0 + (t)) >> 1) < NPAGE ? ((cur.t0 + (t)) >> 1) : NPAGE - 1])
#define PGK(pg, t) ((cur.t0 + (t)) >= PAST / KVBLK ? cur.Kn : (const float*)cur.K + ((size_t)(pg) * PAGE + ((cur.t0 + (t)) & 1) * KVBLK) * PITCH)
#define PGV(pg, t) ((cur.t0 + (t)) >= PAST / KVBLK ? cur.Vn : (const float*)cur.V + ((size_t)(pg) * PAGE + ((cur.t0 + (t)) & 1) * KVBLK) * PITCH)
#define COMPUTE(BUF, t) do { f32x16 p; float al; bf16x8 pa0, pa1; \
        qkt_half<BUF>(p, K_lds, r32, hi, sub, half, S.qr, cvec); \
        const int kb_ = KBASE(t); \
        if (kb_ + KVBLK - 1 > qlo) { const float NEG = -__builtin_inff(); _Pragma("unroll") for (int r = 0; r < 16; ++r) { const int c = (r & 3) + 8 * (r >> 2); if (qm - kb_ - c < 0) p[r] = NEG; } } \
        softmax_half(p, m_reg, al, l_reg, A * (float)(kb_ + 32 * half - cur.P0), pa0, pa1); \
        if (__any(al < 1.f)) { if (hi == 0) al_l[r32] = al; asm volatile("s_waitcnt lgkmcnt(0)" ::: "memory"); \
            _Pragma("unroll") for (int d_ = 0; d_ < 4; ++d_) _Pragma("unroll") for (int r = 0; r < 16; ++r) o[d_][r] *= al_l[crow(r, hi)]; } \
        SBAR(); pv_half<BUF>(o, vbh, pa0, pa1); } while (0)
    DLOAD(RA, KP(0), VP(0)); if (NT > 1) DLOAD(RB, KP(1), VP(1));
    SBAR(); DWRITE(RA, 0); SBAR(); if (NT > 2) DLOAD(RA, KP(2), VP(2));
    __syncthreads();
    int t = 0;
#pragma unroll 1
    for (; t + 4 < NT; t += 2) {
        const int pg3 = PGE(t + 3), pg4 = PGE(t + 4); SBAR();
        if (act) COMPUTE(0, t);
        SBAR(); DWRITE(RB, 1); SBAR(); DLOAD(RB, PGK(pg3, t + 3), PGV(pg3, t + 3));
        __syncthreads();
        if (act) COMPUTE(1, t + 1);
        SBAR(); DWRITE(RA, 0); SBAR(); DLOAD(RA, PGK(pg4, t + 4), PGV(pg4, t + 4));
        __syncthreads();
    }
#pragma unroll 1
    for (; t < NT; t += 2) {
        if (act) COMPUTE(0, t);
        SBAR();
        if (t + 1 < NT) { DWRITE(RB, 1); SBAR(); if (t + 3 < NT) DLOAD(RB, KP(t + 3), VP(t + 3)); }
        __syncthreads();
        if (t + 1 < NT) {
            if (act) COMPUTE(1, t + 1);
            SBAR();
            if (t + 2 < NT) { DWRITE(RA, 0); SBAR(); if (t + 4 < NT) DLOAD(RA, KP(t + 4), VP(t + 4)); }
            __syncthreads();
        }
    }
    if (act && hi == 0) {
        float* op = (float*)cur.O + (size_t)(half * 2 + sub) * 4 * OPW;
#pragma unroll
        for (int r = 0; r < 4; ++r)
#pragma unroll
            for (int d0 = 0; d0 < 4; ++d0) __hip_atomic_store(op + (unsigned)(r * OPW + d0 * 32 + r32), o[d0][r], RLX_AGENT);
        if (r32 < 4) { __hip_atomic_store(op + (unsigned)(r32 * OPW + 128), m_reg, RLX_AGENT); __hip_atomic_store(op + (unsigned)(r32 * OPW + 129), l_reg, RLX_AGENT); }
    }
    asm volatile("s_waitcnt vmcnt(0)" ::: "memory");
    __syncthreads();
    volatile __attribute__((address_space(3))) unsigned* flag = (volatile __attribute__((address_space(3))) unsigned*)(unsigned)(uintptr_t)(lds + LDS_WSF + NW * 512);
    if (tid == 0) { const unsigned old = __hip_atomic_fetch_add(fin.cnt, 1u, RLX_AGENT); *flag = (old == (unsigned)(NSPLIT - 1)) ? 1u : 0u; }
    __syncthreads();
    if (*flag != 0u && wid < 4) {
        constexpr float C2 = 1.4426950408889634f * SCALE; constexpr int NS = 2 * NSPLIT, SET = 2 * 4 * OPW;
        const int q = wid; float res0 = 0.f, res1 = 0.f;
#pragma unroll
        for (int sb = 0; sb < 2; ++sb) {
            const float* op = fin.pbase + (size_t)(sb * 4 + q) * OPW;
            float mm[NS], ll[NS], x0[NS], x1[NS];
#pragma unroll
            for (int s = 0; s < NS; ++s) { mm[s] = __hip_atomic_load(op + (size_t)s * SET + 128, RLX_AGENT); ll[s] = __hip_atomic_load(op + (size_t)s * SET + 129, RLX_AGENT);
                x0[s] = __hip_atomic_load(op + (size_t)s * SET + lane, RLX_AGENT); x1[s] = __hip_atomic_load(op + (size_t)s * SET + 64 + lane, RLX_AGENT); }
            float M = -1e30f;
#pragma unroll
            for (int s = 0; s < NS; ++s) M = fmaxf(M, mm[s]);
            float L = 0.f, a0 = 0.f, a1 = 0.f;
#pragma unroll
            for (int s = 0; s < NS; ++s) { const float w = __builtin_amdgcn_exp2f((mm[s] - M) * C2); L += w * ll[s]; a0 += w * x0[s]; a1 += w * x1[s]; }
            const float il = 1.f / L;
            if (sb == 0) { res0 = a0 * il; res1 = a1 * il; } else { res0 -= fin.lam * a0 * il; res1 -= fin.lam * a1 * il; }
        }
        float ss = res0 * res0 + res1 * res1;
#pragma unroll
        for (int off = 1; off < 64; off <<= 1) ss += __shfl_xor(ss, off);
        const float rn = rsqrtf(ss * (1.f / D) + EPS) * 0.8f;
        bf16* dst = fin.dst + (size_t)q * DM;
        dst[lane] = (bf16)(cvtpk(res0 * rn * fin.gain[lane], 0.f) & 0xffffu); dst[64 + lane] = (bf16)(cvtpk(res1 * rn * fin.gain[64 + lane], 0.f) & 0xffffu);
    }
    __syncthreads();
#undef KP
#undef VP
#undef KBASE
#undef PGE
#undef PGK
#undef PGV
#undef COMPUTE
}
#undef DLOAD
#undef DWRITE
#undef VMW
#undef VMWN
#undef ROWH
#undef ROWF
#undef SLOAD_H
#undef SWRITE_HK
#undef SWRITE_HV
#undef SWRITE_H
#undef SLOAD_F
#undef SWRITE_KF
#undef SWRITE_VF
#undef QLOAD
#undef KSWZ
#undef SBAR
}

__device__ __forceinline__ dattn::Blk prompt_blk(Frame& F, int bh, int qb) {
    const int b = bh >> 3, h = bh & 7; dattn::Blk k;
    k.Q = WSP(bf16, WS_Q) + ((size_t)b * SEQ + (size_t)qb * dattn::QB) * 1024 + h * HD;
    k.K = WSP(bf16, WS_KB) + (size_t)b * SKP * 1024 + h * HD; k.V = WSP(bf16, WS_VB) + (size_t)b * SKP * 1024 + h * HD;
    k.Kn = nullptr; k.Vn = nullptr; k.pt = nullptr;
    k.O = WSP(bf16, WS_CAT) + ((size_t)b * SEQ + (size_t)qb * dattn::QB) * DM + AW + h * HD;
    k.P0 = NMETA + qb * dattn::QB; k.t0 = 0; k.NT = (k.P0 + dattn::QB - 1) / 64 + 1; k.A = 8.f * exp2f(-(float)(h + 1));
    return k;
}
__device__ __forceinline__ dattn::Blk decode_blk(Frame& F, int bh, int split) {
    const int b = bh >> 3, h = bh & 7; dattn::Blk k;
    k.Q = WSP(bf16, WS_QS) + (size_t)(b * 4) * 1024 + h * HD;
    k.K = inp(F, I_CK) + h * HD; k.V = inp(F, I_CV) + h * HD;
    k.Kn = WSP(float, WS_KS) + (size_t)b * 64 * 1024 + h * HD; k.Vn = WSP(float, WS_VS) + (size_t)b * 64 * 1024 + h * HD;
    k.pt = (const int*)inp(F, I_PT) + b * NPAGE;
    k.O = WSP(float, WS_OPART) + (size_t)(bh * dattn::NSPLIT + split) * 2 * (2 * 4 * dattn::OPW);
    k.P0 = PAST; k.t0 = split * (PAST / 64 / dattn::NSPLIT); k.NT = PAST / 64 / dattn::NSPLIT + (split == dattn::NSPLIT - 1 ? 1 : 0); k.A = 8.f * exp2f(-(float)(h + 1));
    return k;
}
template <bool DO_DEC, bool DO_PROMPT> __device__ __forceinline__ void attn_fast_phase(Frame& F) {
    const float lam = lam_get(F);
    const float* gain = inp(F, I_SUBLN);
    char* lds = (char*)F.lds;
    dattn::Seam S;
    const int rsel = F.vcu & 15;
    const int role = (int)((MK_ROLES >> (2 * rsel)) & 3u);
    const bool lfirst = ((MK_LFIRST >> rsel) & 1u) != 0;
#pragma unroll 1
    for (int slot = 0; slot < 3; ++slot) {
        const bool do_dec = slot == (role == 0 ? 0 : 1);
        if (do_dec) {
            if constexpr (DO_DEC) for (int u = F.vcu; u < DB * NH * dattn::NSPLIT; u += F.G) {
                const int bh = u / dattn::NSPLIT;
                const dattn::Blk cur = decode_blk(F, bh, u % dattn::NSPLIT);
                const dattn::DecFin fin{(unsigned*)(F.ws + WS_CTL) + CW_DCNT + 16 * bh, WSP(float, WS_OPART) + (size_t)(bh * dattn::NSPLIT * 2) * (2 * 4 * dattn::OPW),
                                        WSP(bf16, WS_CAT) + (size_t)(ROW_SAMP + (bh >> 3) * 4) * DM + AW + (bh & 7) * HD, gain, lam};
                dattn::dec_unit(cur, lds, fin);
            }
        } else {
            const int first = (role == 1 && slot == 2) ? 1 : 0;
            const int nblk = role == 1 ? 1 : ((role == 0 ? slot == 1 : slot == 0) ? 2 : 0);
            if constexpr (DO_PROMPT) if (nblk > 0) for (int it = F.vcu; it < NB * NH * 16; it += F.G) {
                const int bh = it >> 4, s = it & 15;
                const int qa = lfirst ? 31 - s : s, qb = lfirst ? s : 31 - s;
                dattn::Blk cur = prompt_blk(F, bh, first == 0 ? qa : qb);
                dattn::attn_prime<false>(cur, lds, S);
#pragma unroll 1
                for (int bp = 0; bp < nblk; ++bp) {
                    const dattn::Blk nxt = prompt_blk(F, bh, qb);
                    dattn::attn_block<false>(cur, nxt, lam, gain, lds, S);
                    cur = nxt;
                }
            }
        }
    }
}
__device__ __forceinline__ void feat_pass(Frame& F) {
    const int gt = F.vcu * NWAVES * 64 + F.tid, NT = F.G * NWAVES * 64;
    bf16* cat = WSP(bf16, WS_CAT);
    for (int idx = gt; idx < (MAIN / 8) * 128; idx += NT) {
        const int cg = idx & 127, rc = idx >> 7, row0 = rc * 8, b = row0 >> 12, pos0 = 16 + (row0 & 4095), c0 = cg * 8, g = c0 >> 8, w = 2 << g;
        const bf16* base = WSP(bf16, WS_PB) + ((size_t)b * SP + pos0 - 15) * 1024 + c0;
        v4u x[23];
#pragma unroll
        for (int i = 0; i < 23; ++i) x[i] = *(const GAS v4u*)(base + (size_t)i * 1024);
        const float inv = 1.f / (float)w;
        float sum[8];
#pragma unroll
        for (int j = 0; j < 8; ++j) sum[j] = 0.f;
#pragma unroll
        for (int i = 0; i < 15; ++i) if (i >= 16 - w) {
            sum[0] += bflo(x[i].x); sum[1] += bfhi(x[i].x); sum[2] += bflo(x[i].y); sum[3] += bfhi(x[i].y); sum[4] += bflo(x[i].z); sum[5] += bfhi(x[i].z); sum[6] += bflo(x[i].w); sum[7] += bfhi(x[i].w); }
#pragma unroll
        for (int r = 0; r < 8; ++r) {
            const v4u xc = x[15 + r];
            const float cur[8] = {bflo(xc.x), bfhi(xc.x), bflo(xc.y), bfhi(xc.y), bflo(xc.z), bfhi(xc.z), bflo(xc.w), bfhi(xc.w)};
            float f[8];
#pragma unroll
            for (int j = 0; j < 8; ++j) { sum[j] += cur[j]; f[j] = sum[j] * inv - cur[j]; }
            v4u o; o.x = pk2(f[0], f[1]); o.y = pk2(f[2], f[3]); o.z = pk2(f[4], f[5]); o.w = pk2(f[6], f[7]);
            *(GAS v4u*)(cat + (size_t)(row0 + r) * DM + c0) = o;
            v4u y = x[r];
            if (w == 8) y = x[8 + r]; else if (w == 4) y = x[12 + r]; else if (w == 2) y = x[14 + r];
            sum[0] -= bflo(y.x); sum[1] -= bfhi(y.x); sum[2] -= bflo(y.y); sum[3] -= bfhi(y.y); sum[4] -= bflo(y.z); sum[5] -= bfhi(y.z); sum[6] -= bflo(y.w); sum[7] -= bfhi(y.w); }
    }
    for (int idx = gt; idx < 32 * 256; idx += NT) {
        const int cq = idx & 255, j = idx >> 8, b = j >> 2, t = j & 3, c0 = cq * 4, g = c0 >> 8, w = 2 << g;
        const float* sp = inp(F, I_SPOOL) + (size_t)b * 15 * 1024 + c0; const float* pn = WSP(float, WS_PSN) + (size_t)(b * 4) * 1024 + c0;
        f32x4 x[16];
#pragma unroll
        for (int i = 0; i < 16; ++i) { const int ri = t + i; x[i] = *(const GAS f32x4*)(ri < 15 ? sp + (size_t)ri * 1024 : pn + (size_t)(ri - 15) * 1024); }
        f32x4 sum = {0.f, 0.f, 0.f, 0.f};
#pragma unroll
        for (int i = 0; i < 16; ++i) if (i >= 16 - w) { sum.x += x[i].x; sum.y += x[i].y; sum.z += x[i].z; sum.w += x[i].w; }
        const float inv = 1.f / (float)w; const f32x4 a = x[15];
        v2u o; o.x = pk2(sum.x * inv - a.x, sum.y * inv - a.y); o.y = pk2(sum.z * inv - a.z, sum.w * inv - a.w);
        *(GAS v2u*)(cat + (size_t)(ROW_SAMP + j) * DM + c0) = o;
    }
}
__device__ __forceinline__ void attn_simple_task(Frame& F, int rt, int h, float lam, LAS float* wl) {
    const int lane = F.lane; const bool samp = rt >= MAIN;
    int b, pos; const bf16* qrow;
    if (!samp) { b = rt >> 12; pos = 16 + (rt & 4095); qrow = WSP(bf16, WS_Q) + (size_t)rt * 1024 + h * HD; }
    else { const int j = rt - MAIN; b = j >> 2; pos = PAST + (j & 3); qrow = WSP(bf16, WS_QS) + (size_t)j * 1024 + h * HD; }
    wl[lane] = bf2f(qrow[lane]); wl[64 + lane] = bf2f(qrow[64 + lane]);
    LDS_WAIT(); asm volatile("" ::: "memory");
    const float slope = exp2f(-(float)(h + 1));
    const int* pt = (const int*)inp(F, I_PT) + b * NPAGE;
    float res0 = 0.f, res1 = 0.f;
#pragma unroll 1
    for (int sub = 0; sub < 2; ++sub) {
        float m = -1e30f, l = 0.f, o0 = 0.f, o1 = 0.f;
        const LAS float* qs = wl + sub * 64;
#pragma unroll 1
        for (int kb = 0; kb <= pos; kb += 64) {
            const int key = kb + lane; const bool valid = key <= pos; const int kk = valid ? key : pos;
            float s = 0.f;
            if (!samp) {
                const bf16* kr = WSP(bf16, WS_KB) + ((size_t)b * SKP + kk) * 1024 + h * HD + sub * 64;
#pragma unroll
                for (int c = 0; c < 8; ++c) { const v4u x = *(const GAS v4u*)(kr + 8 * c);
                    s += qs[8 * c] * bflo(x.x) + qs[8 * c + 1] * bfhi(x.x) + qs[8 * c + 2] * bflo(x.y) + qs[8 * c + 3] * bfhi(x.y) + qs[8 * c + 4] * bflo(x.z) + qs[8 * c + 5] * bfhi(x.z) + qs[8 * c + 6] * bflo(x.w) + qs[8 * c + 7] * bfhi(x.w); }
            } else {
                const float* kr = kk < PAST ? inp(F, I_CK) + (((size_t)pt[kk >> 7] * PAGE + (kk & 127)) * NH + h) * HD + sub * 64 : WSP(float, WS_KS) + ((size_t)b * 64 + (kk - PAST)) * 1024 + h * HD + sub * 64;
#pragma unroll
                for (int c = 0; c < 16; ++c) { const f32x4 x = *(const GAS f32x4*)(kr + 4 * c); s += qs[4 * c] * x.x + qs[4 * c + 1] * x.y + qs[4 * c + 2] * x.z + qs[4 * c + 3] * x.w; }
            }
            s = valid ? s * 0.125f - slope * (float)(pos - key) : -1e30f;
            const float mn = fmaxf(m, wave_max(s)), a = __expf(m - mn), p = valid ? __expf(s - mn) : 0.f;
            l = l * a + wave_sum(p); m = mn; o0 *= a; o1 *= a;
            const int nk = (pos - kb + 1) < 64 ? (pos - kb + 1) : 64;
#pragma unroll 4
            for (int j = 0; j < nk; ++j) { const float pj = __shfl(p, j); const int kj = kb + j;
                if (!samp) { const bf16* vr = WSP(bf16, WS_VB) + ((size_t)b * SKP + kj) * 1024 + h * HD; o0 += pj * bf2f(vr[lane]); o1 += pj * bf2f(vr[64 + lane]); }
                else { const float* vr = kj < PAST ? inp(F, I_CV) + (((size_t)pt[kj >> 7] * PAGE + (kj & 127)) * NH + h) * HD : WSP(float, WS_VS) + ((size_t)b * 64 + (kj - PAST)) * 1024 + h * HD; o0 += pj * vr[lane]; o1 += pj * vr[64 + lane]; } }
        }
        const float il = 1.f / l;
        if (sub == 0) { res0 = o0 * il; res1 = o1 * il; } else { res0 -= lam * o0 * il; res1 -= lam * o1 * il; }
    }
    const float ss = wave_sum(res0 * res0 + res1 * res1), rn = rsqrtf(ss * (1.f / HD) + EPS) * 0.8f;
    const int row = samp ? ROW_SAMP + (rt - MAIN) : rt;
    bf16* dst = WSP(bf16, WS_CAT) + (size_t)row * DM + AW + h * HD;
    dst[lane] = (bf16)f2bf(res0 * rn * inp(F, I_SUBLN)[lane]); dst[64 + lane] = (bf16)f2bf(res1 * rn * inp(F, I_SUBLN)[64 + lane]);
    LDS_WAIT(); asm volatile("" ::: "memory");
}
__device__ __forceinline__ void attn_simple_phase(Frame& F, bool do_samp, bool do_prompt) {
    const float lam = lam_get(F);
    LAS float* wl = (LAS float*)(F.lds + RING_OFF) + F.wave * 128;
    const int gw = F.vcu * NWAVES + F.wave, NGW = F.G * NWAVES;
    for (int it = gw; it < (MAIN + 32) * NH; it += NGW) {
        int rt, h;
        if (it < 32 * NH) { rt = MAIN + (it >> 3); h = it & 7; }
        else { const int k = it - 32 * NH; h = k & 7; const int r = k >> 3; rt = (r & 1) * SEQ + (SEQ - 1 - (r >> 1)); }
        if (rt >= MAIN ? do_samp : do_prompt) attn_simple_task(F, rt, h, lam, wl);
    }
}
__device__ __forceinline__ void final_norm(Frame& F, int first) {
    const int gw = F.vcu * NWAVES + F.wave, NGW = F.G * NWAVES; const unsigned lane = lane_now();
    const float* ssq = ssq_ptr(F, 2);
    for (int m = first + gw; m < MAIN + 32; m += NGW) {
        const int row = m < MAIN ? m : ROW_SAMP + (m - MAIN);
        float* y = m < MAIN ? F.out + O_YP + (size_t)m * DM : F.out + O_YS + (size_t)(m - MAIN) * DM;
        const float rs = rsqrtf(ssq[row * SSQ_PAD] * (1.f / DM) + EPS);
        GAS f32x4* yr = (GAS f32x4*)y + lane;
#pragma unroll
        for (int j = 0; j < 8; ++j) { const f32x4 gv = ((const GAS f32x4*)inp(F, I_NFIN))[lane + 64 * j]; f32x4 v = yr[64 * j]; v.x *= rs * gv.x; v.y *= rs * gv.y; v.z *= rs * gv.z; v.w *= rs * gv.w; yr[64 * j] = v; }
    }
}

struct Args { const float* in[26]; float* out; unsigned char* ws; int ph_lo, ph_hi, li, pad; };
__global__ void __launch_bounds__(NWAVES * 64, 2) hymba_fwd(Args args) {
    extern __shared__ __attribute__((aligned(16))) unsigned char lds[];
    Frame F;
    F.lds = (LAS unsigned char*)lds;
    F.MISC = (volatile LAS unsigned*)(F.lds + MISC_OFF);
    F.tid = threadIdx.x; F.lane = F.tid & 63; F.wave = __builtin_amdgcn_readfirstlane(F.tid >> 6);
    F.G = gridDim.x; { const int bx = blockIdx.x; F.vcu = (F.G % 8 == 0) ? (bx % 8) * (F.G / 8) + bx / 8 : bx; }
    F.ws = args.ws; F.out = args.out; F.ctl = (gu32*)(args.ws + WS_CTL);
    for (int u = F.tid; u < (LDS_BYTES - LDSCTL_OFF) / 4; u += NWAVES * 64) ((LAS unsigned*)(F.lds + LDSCTL_OFF))[u] = 0u;
    __syncthreads();
    if (F.tid == 0) { volatile LAS unsigned* t = (volatile LAS unsigned*)(F.lds + LDSCTL_OFF);
#pragma unroll
        for (int i = 0; i < 26; ++i) { const unsigned long long p = (unsigned long long)args.in[i]; t[2 * i] = (unsigned)p; t[2 * i + 1] = (unsigned)(p >> 32); } }
    __syncthreads();
    if (F.wave == 0) { const float lam = lam_value(F); if (F.lane == 0) F.MISC[16] = __builtin_bit_cast(unsigned, lam); }
    __syncthreads();
    XcdBarrier bar; bar.bar = (unsigned*)(F.ctl + CW_BAR); bar.x = 0; bar.st = nullptr;
    if (N_LAUNCHES == 1) bar = xcd_barrier_post((unsigned*)(F.ctl + CW_BAR), F.MISC + 8);
#define GRID_BAR() do { if (N_LAUNCHES == 1) { xcd_barrier(bar); if constexpr (((MK_REPEAT >> 13) & 1) != 0) xcd_barrier(bar); } } while (0)
    const int lo = args.ph_lo, hi = args.ph_hi;
#define IN(k) (lo <= (k) && (k) < hi)
#define BOTH(k) (IN(k) && IN((k) + 1))

#ifndef MK_REPEAT
#define MK_REPEAT 0
#endif
    constexpr int TR_W1_END = TR_D1_END + 768, TR_W2_END = TR_OUT_END, TR_W3_END = TR_W2_END, TR_W4_END = TR_W3_END, TR_W6_END = TR_GU2_END;
    static_assert(TR_W1_END <= TR_IN_END && TR_W4_END <= TR_GU2_END && TR_W6_END <= TR_END, "conversion windows");
#define REP(k) (((MK_REPEAT >> (k)) & 1) ? 2 : 1)
    if (IN(0)) { _Pragma("unroll 1") for (int rep = 0; rep < REP(0); ++rep) { p0_prologue(F); if (rep + 1 < REP(0)) __syncthreads(); } if (BOTH(0)) GRID_BAR(); }
    if (IN(1)) { RSwiglu r{WSP(bf16, WS_ACT), nullptr}; run_gemm<RSwiglu, 1>(F, WSP(bf16, WS_XA), WSP(bf16, WS_WGU1), 2 * FF, DM, r, nullptr, F.G / 2); tr_window(F, TR_GU1_END, TR_W1_END, F.G / 2); if (BOTH(1)) GRID_BAR(); }
    if (IN(2)) { RResid r{&F, 0, 0.5f}; run_gemm<RResid, 2>(F, WSP(bf16, WS_ACT), WSP(bf16, WS_WD1), DM, FF, r, ssq_ptr(F, 0), 0); tr_window(F, TR_W1_END, TR_W2_END, 32); if (BOTH(2)) GRID_BAR(); }
    if (IN(3)) { RProj r{&F}; run_gemm<RProj, 3>(F, WSP(bf16, WS_XA), WSP(bf16, WS_WIN), NQKV, DM, r, nullptr, 0); tr_window(F, TR_W2_END, TR_W3_END, 64); if (BOTH(3)) GRID_BAR(); }
    if (IN(4)) { _Pragma("unroll 1") for (int rep = 0; rep < REP(4); ++rep) { feat_pass(F);
        if constexpr (MK_FAST_ATTN == 1) attn_fast_phase<true, true>(F);
        else if constexpr (MK_FAST_ATTN == 2) { attn_fast_phase<false, true>(F); attn_simple_phase(F, true, false); }
        else if constexpr (MK_FAST_ATTN == 3) { attn_fast_phase<true, false>(F); attn_simple_phase(F, false, true); }
        else attn_simple_phase(F, true, true); }
        tr_window(F, TR_W3_END, TR_W4_END, 0);
        if (BOTH(4)) GRID_BAR(); }
    if (IN(6)) { RResid r{&F, 1, 1.f}; run_gemm<RResid, 6>(F, WSP(bf16, WS_CAT), WSP(bf16, WS_WOUT), DM, DM, r, ssq_ptr(F, 1), 0); tr_window(F, TR_W4_END, TR_W6_END, 32); if (BOTH(6)) GRID_BAR(); }
    if (IN(7)) { RSwiglu r{WSP(bf16, WS_ACT), ssq_ptr(F, 1)}; run_gemm<RSwiglu, 7>(F, WSP(bf16, WS_XA), WSP(bf16, WS_WGU2), 2 * FF, DM, r, nullptr, F.G / 2); tr_window(F, TR_W6_END, TR_END, F.G / 2); if (BOTH(7)) GRID_BAR(); }
    const bool fuse_final = FAST_GEMM && F.G == 256 && ((MK_REPEAT >> 8) & 1) == 0;
    if (IN(8)) { RResid r{&F, 2, 0.5f};
        if (fuse_final) { run_gemm_final_main(F, WSP(bf16, WS_ACT), WSP(bf16, WS_WD2)); run_gemm<RResid, 8>(F, WSP(bf16, WS_ACT), WSP(bf16, WS_WD2), DM, FF, r, ssq_ptr(F, 2), 0, true, true); }
        else run_gemm<RResid, 8>(F, WSP(bf16, WS_ACT), WSP(bf16, WS_WD2), DM, FF, r, ssq_ptr(F, 2), 0);
        if (BOTH(8) && !fuse_final) GRID_BAR(); }
    if (IN(9) && !fuse_final) { final_norm(F, 0); }
#undef IN
#undef BOTH
}

extern "C" void kernel_launch(void* const* d_in, const int* in_sizes, int n_in, void* d_out, int out_size, void* d_ws, size_t ws_size, hipStream_t stream) {
    static int grid = 0;
    if (grid == 0) {
        if (n_in != 26 || (size_t)out_size != O_END || ws_size < WS_END) { fprintf(stderr, "kernel_launch: unexpected shapes (n_in %d, out %d, ws %zu); nothing launched\n", n_in, out_size, ws_size); grid = -1; return; }
        int dev = 0, cus = 0, per_cu = 0;
        if (hipGetDevice(&dev) != hipSuccess || hipDeviceGetAttribute(&cus, hipDeviceAttributeMultiprocessorCount, dev) != hipSuccess) { grid = -1; return; }
        if (hipFuncSetAttribute((const void*)hymba_fwd, hipFuncAttributeMaxDynamicSharedMemorySize, LDS_BYTES) != hipSuccess) { fprintf(stderr, "kernel_launch: hipFuncSetAttribute failed\n"); grid = -1; return; }
        if (hipOccupancyMaxActiveBlocksPerMultiprocessor(&per_cu, (const void*)hymba_fwd, NWAVES * 64, LDS_BYTES) != hipSuccess || per_cu < 1) { fprintf(stderr, "kernel_launch: occupancy query says %d blocks per CU\n", per_cu); }
        (void)hipGetLastError();
        grid = cus;
#if defined(MK_FORCE_GRID)
        grid = MK_FORCE_GRID;
#endif
    }
    if (grid < 0) return;
    if (hipMemsetAsync((char*)d_ws + WS_CTL, 0, CTL_ZERO_BYTES, stream) != hipSuccess) return;
    Args a{};
    for (int i = 0; i < 26; ++i) a.in[i] = (const float*)d_in[i];
    a.out = (float*)d_out; a.ws = (unsigned char*)d_ws;
    for (int li = 0; li < N_LAUNCHES; ++li) {
        a.ph_lo = (N_LAUNCHES == 1) ? 0 : li; a.ph_hi = (N_LAUNCHES == 1) ? NPH : li + 1; a.li = li; a.pad = 0;
        hipLaunchKernelGGL(hymba_fwd, dim3(grid), dim3(NWAVES * 64), LDS_BYTES, stream, a);
        if (hipPeekAtLastError() != hipSuccess) { fprintf(stderr, "kernel_launch: launch %d failed\n", li); break; }
#if defined(MK_DUP_PHASE)
        if (N_LAUNCHES == NPH && li == MK_DUP_PHASE) {
            if (li == 2) hipMemsetAsync((char*)d_ws + WS_SSQ, 0, (size_t)MROWS * SSQ_PAD * 4, stream);
            if (li == 8) { hipMemsetAsync((char*)d_ws + WS_SSQ + (size_t)2 * MROWS * SSQ_PAD * 4, 0, (size_t)MROWS * SSQ_PAD * 4, stream); hipMemsetAsync((char*)d_ws + WS_CTL + (size_t)CW_PCNT * 4, 0, 64 * 32 * 4, stream); }
            hipLaunchKernelGGL(hymba_fwd, dim3(grid), dim3(NWAVES * 64), LDS_BYTES, stream, a);
        }
#endif
    }
}
```

```cpp
#include <hip/hip_runtime.h>
#include <cstdio>
#include <cstdint>
#define MK_N_LAUNCHES 1
#define MK_FAST_GEMM 1
#define MK_FAST_ATTN 1
namespace pg8 {
#define PG8_LAS __attribute__((address_space(3)))
typedef unsigned short bf16_t;
typedef short bf16x8 __attribute__((ext_vector_type(8)));
typedef float f32x4 __attribute__((ext_vector_type(4)));
typedef unsigned u32x4 __attribute__((ext_vector_type(4)));
constexpr int BM = 256, BK = 64, HALF = 128, HTB = HALF * BK * 2  , STAGE_BYTES = 8 * HTB, NXCD = 8, WGM = 8;

__host__ __device__ __forceinline__ int lds_byte(int r, int c) { const int st = (r >> 4) * 2 + (c >> 5), rr = r & 15, cc = c & 31, ob = rr * 64 + cc * 2; return st * 1024 + (ob ^ (((ob >> 9) & 1) << 5)); }
__host__ __device__ __forceinline__ void stage_rc(int b, int& R, int& C) { const int st = b / 1024, sb = b % 1024, swz = sb ^ (((sb >> 9) & 1) << 5); R = (st >> 1) * 16 + swz / 64; C = (st & 1) * 32 + (swz % 64) / 2; }
__host__ __device__ __forceinline__ int perm32(int rho) { const int n = rho >> 4, i = rho & 15; return 8 * (i >> 2) + 4 * n + (i & 3); }

struct Unit { int pm, pn; };
struct Gemm { const bf16_t* A; const bf16_t* Bt; int M, N, K; };

struct StaticOrder {
    int nM, nN, nwg, G, c;
    __host__ __device__ void init(int M, int N, int G_, int c_) { nM = M / BM; nN = N / BM; nwg = nM * nN; G = G_; c = c_; }
    __host__ __device__ bool next(int i, Unit& u) const {
        const long L = (long)i * G + c; if (L >= nwg) return false;
        int wgid = (int)L; { const int q = nwg / NXCD, r = nwg % NXCD, xcd = wgid % NXCD, off = wgid / NXCD; wgid = (xcd < r ? xcd * (q + 1) : r * (q + 1) + (xcd - r) * q) + off; }
        const int nig = WGM * nN, gid = wgid / nig, fm = gid * WGM, gsz = (nM - fm) < WGM ? (nM - fm) : WGM;
        u.pm = fm + ((wgid % nig) % gsz); u.pn = (wgid % nig) / gsz; return true;
    }
    __device__ __forceinline__ void a_ready(const Unit&) const {}
    __device__ __forceinline__ void done(const Unit&) const {}
};
__device__ __forceinline__ unsigned cvt_pk_bf16(float lo, float hi) { unsigned r; asm volatile("v_cvt_pk_bf16_f32 %0, %1, %2" : "=v"(r) : "v"(lo), "v"(hi)); return r; }
template <class Epi, class Sched, bool ALIGN_EPI = false, bool SP2 = false>
__device__ __forceinline__ void gemm_phase(PG8_LAS unsigned char* lds, const Gemm g, const Sched& S, const Epi& E) {
    const int tid = threadIdx.x, wid = __builtin_amdgcn_readfirstlane(tid >> 6), lane = tid & 63, wr = wid >> 2, wc = wid & 3, fr = lane & 15, fq = lane >> 4;
    const int K = g.K, nt = K / BK;
    unsigned voffA[2], voffB[2];
#pragma unroll
    for (int i = 0; i < 2; ++i) { int R, C; stage_rc(tid * 16 + i * 8192, R, C); const int Rb = Epi::PERM ? ((R & ~31) + perm32(R & 31)) : R;
        voffA[i] = (unsigned)(R * K + C) * 2u; voffB[i] = (unsigned)(Rb * K + C) * 2u; }
    const size_t kstep = (size_t)(BK * 2);
    const size_t hstep = (size_t)HALF * K * 2;
    const size_t tstep = 2 * hstep;
    const unsigned ldsw = (unsigned)wid * 1024u;
    const int aoff = lds_byte(wr * 64 + fr, fq * 8), boff = lds_byte(wc * 32 + fr, fq * 8);
#define PG8_SA(b, h) (((b) * 2 + (h)) * HTB)
#define PG8_SB(b, h) ((4 + (b) * 2 + (h)) * HTB)
#define PG8_STAGE(bufoff, gbase, voff) do { _Pragma("unroll") for (int _i = 0; _i < 2; ++_i) \
        __builtin_amdgcn_global_load_lds((const unsigned*)((const char*)(gbase) + (voff)[_i]), (PG8_LAS unsigned*)(lds + (bufoff) + ldsw + _i * 8192), 16, 0, 0); } while (0)
#define PG8_LDA(dst, b, h) do { _Pragma("unroll") for (int m = 0; m < 4; ++m) _Pragma("unroll") for (int k = 0; k < 2; ++k) dst[m][k] = *(const PG8_LAS bf16x8*)(lds + PG8_SA(b, h) + aoff + m * 2048 + k * 1024); } while (0)
#define PG8_LDB(dst, b, h) do { _Pragma("unroll") for (int n = 0; n < 2; ++n) _Pragma("unroll") for (int k = 0; k < 2; ++k) dst[n][k] = *(const PG8_LAS bf16x8*)(lds + PG8_SB(b, h) + boff + n * 2048 + k * 1024); } while (0)
#define PG8_MMA(ai, bj, At, Bt) do { __builtin_amdgcn_s_setprio(1); _Pragma("unroll") for (int m = 0; m < 4; ++m) _Pragma("unroll") for (int n = 0; n < 2; ++n) _Pragma("unroll") for (int k = 0; k < 2; ++k) \
        acc[ai][bj][m][n] = __builtin_amdgcn_mfma_f32_16x16x32_bf16(Bt[n][k], At[m][k], acc[ai][bj][m][n], 0, 0, 0); __builtin_amdgcn_s_setprio(0); } while (0)
#define PG8_WAIT_V(n) asm volatile("s_waitcnt vmcnt(" #n ")" ::: "memory")
#define PG8_WAIT_L(n) asm volatile("s_waitcnt lgkmcnt(" #n ")" ::: "memory")
#define PG8_BAR __builtin_amdgcn_s_barrier()
#define PG8_SCHED __builtin_amdgcn_sched_barrier(0)
    Unit cur, nxt; int ui = 0;
    if (!S.next(0, cur)) return;
    f32x4 acc[2][2][4][2];
#pragma unroll
    for (int a = 0; a < 2; ++a)
#pragma unroll
        for (int b = 0; b < 2; ++b)
#pragma unroll
            for (int m = 0; m < 4; ++m)
#pragma unroll
                for (int n = 0; n < 2; ++n) acc[a][b][m][n] = (f32x4){0.f, 0.f, 0.f, 0.f};
    bf16x8 At[4][2], B0[2][2], B1[2][2];
    const char* cA = (const char*)g.A + (size_t)cur.pm * tstep; const char* cB = (const char*)g.Bt + (size_t)cur.pn * tstep;
    S.a_ready(cur);
    if constexpr (SP2) {
        PG8_STAGE(PG8_SB(0, 0), cB, voffB); PG8_STAGE(PG8_SB(0, 1), cB + hstep, voffB); PG8_STAGE(PG8_SA(0, 0), cA, voffA); PG8_STAGE(PG8_SA(0, 1), cA + hstep, voffA);
        if (wr == 1) PG8_BAR;
        PG8_WAIT_V(2); PG8_BAR;
        PG8_STAGE(PG8_SB(1, 0), cB + kstep, voffB); PG8_STAGE(PG8_SA(1, 0), cA + kstep, voffA); PG8_STAGE(PG8_SB(1, 1), cB + hstep + kstep, voffB);
        PG8_WAIT_V(6); PG8_BAR;
    } else {
        PG8_STAGE(PG8_SB(0, 0), cB, voffB); PG8_STAGE(PG8_SA(0, 0), cA, voffA); PG8_STAGE(PG8_SB(0, 1), cB + hstep, voffB); PG8_STAGE(PG8_SA(0, 1), cA + hstep, voffA);
        if (wr == 1) PG8_BAR;
        PG8_WAIT_V(4); PG8_BAR;
        PG8_STAGE(PG8_SB(1, 0), cB + kstep, voffB); PG8_STAGE(PG8_SA(1, 0), cA + kstep, voffA); PG8_STAGE(PG8_SB(1, 1), cB + hstep + kstep, voffB);
        PG8_WAIT_V(6); PG8_BAR;
    }
    for (;;) {
        const bool has_next = S.next(ui + 1, nxt);
        const char* nA = has_next ? (const char*)g.A + (size_t)nxt.pm * tstep : cA; const char* nB = has_next ? (const char*)g.Bt + (size_t)nxt.pn * tstep : cB;
        for (int t = 0; t < nt; t += 2) {
            const bool last = (t == nt - 2);
            const char* a1 = cA + (size_t)(t + 1) * kstep;
            const char* a2 = last ? nA : cA + (size_t)(t + 2) * kstep; const char* b2 = last ? nB : cB + (size_t)(t + 2) * kstep;
            const char* a3 = a2 + kstep; const char* b3 = b2 + kstep;
            if (last && has_next) S.a_ready(nxt);
            if constexpr (SP2) {
            PG8_LDB(B0, 0, 0); PG8_LDB(B1, 0, 1); PG8_SCHED; PG8_LDA(At, 0, 0); PG8_STAGE(PG8_SA(1, 1), a1 + hstep, voffA);
            PG8_WAIT_V(8); PG8_WAIT_L(0); PG8_BAR; PG8_MMA(0, 0, At, B0); PG8_MMA(0, 1, At, B1); PG8_BAR; PG8_SCHED;
            PG8_LDA(At, 0, 1); PG8_STAGE(PG8_SB(0, 0), b2, voffB); PG8_STAGE(PG8_SB(0, 1), b2 + hstep, voffB); PG8_STAGE(PG8_SA(0, 0), a2, voffA);
            PG8_WAIT_V(8); PG8_WAIT_L(0); PG8_BAR; PG8_MMA(1, 0, At, B0); PG8_MMA(1, 1, At, B1); PG8_BAR; PG8_SCHED;
            PG8_LDB(B0, 1, 0); PG8_LDB(B1, 1, 1); PG8_SCHED; PG8_LDA(At, 1, 0); PG8_STAGE(PG8_SA(0, 1), a2 + hstep, voffA);
            PG8_WAIT_V(8); PG8_WAIT_L(0); PG8_BAR; PG8_MMA(0, 0, At, B0); PG8_MMA(0, 1, At, B1); PG8_BAR; PG8_SCHED;
            PG8_LDA(At, 1, 1); PG8_STAGE(PG8_SB(1, 0), b3, voffB); PG8_STAGE(PG8_SB(1, 1), b3 + hstep, voffB); PG8_STAGE(PG8_SA(1, 0), a3, voffA);
            PG8_WAIT_V(8); PG8_WAIT_L(0); PG8_BAR; PG8_MMA(1, 0, At, B0); PG8_MMA(1, 1, At, B1); PG8_BAR; PG8_SCHED;
            } else {
            PG8_LDB(B0, 0, 0); PG8_SCHED; PG8_LDA(At, 0, 0); PG8_STAGE(PG8_SA(1, 1), a1 + hstep, voffA);
            PG8_WAIT_L(8); PG8_BAR; PG8_WAIT_L(0); PG8_MMA(0, 0, At, B0); PG8_BAR; PG8_SCHED;
            PG8_LDB(B1, 0, 1); PG8_STAGE(PG8_SB(0, 0), b2, voffB);
            PG8_BAR; PG8_WAIT_L(0); PG8_MMA(0, 1, At, B1); PG8_BAR;
            PG8_LDA(At, 0, 1); PG8_STAGE(PG8_SA(0, 0), a2, voffA);
            PG8_BAR; PG8_WAIT_L(0); PG8_MMA(1, 0, At, B0); PG8_BAR; PG8_SCHED;
            PG8_STAGE(PG8_SB(0, 1), b2 + hstep, voffB);
            PG8_WAIT_V(6); PG8_BAR; PG8_MMA(1, 1, At, B1); PG8_BAR;
            PG8_LDB(B0, 1, 0); PG8_SCHED; PG8_LDA(At, 1, 0); PG8_STAGE(PG8_SA(0, 1), a2 + hstep, voffA);
            PG8_WAIT_L(8); PG8_BAR; PG8_WAIT_L(0); PG8_MMA(0, 0, At, B0); PG8_BAR; PG8_SCHED;
            PG8_LDB(B1, 1, 1); PG8_STAGE(PG8_SB(1, 0), b3, voffB);
            PG8_BAR; PG8_WAIT_L(0); PG8_MMA(0, 1, At, B1); PG8_BAR;
            PG8_LDA(At, 1, 1); PG8_STAGE(PG8_SA(1, 0), a3, voffA);
            PG8_BAR; PG8_WAIT_L(0); PG8_MMA(1, 0, At, B0); PG8_BAR; PG8_SCHED;
            PG8_STAGE(PG8_SB(1, 1), b3 + hstep, voffB);
            PG8_WAIT_V(6); PG8_BAR; PG8_MMA(1, 1, At, B1); PG8_BAR;
            }
        }
        if constexpr (ALIGN_EPI) { if (wr == 0) PG8_BAR; }
        if constexpr (!Epi::AFTER_DRAIN) { E(acc, cur, wr, wc, fr, fq); S.done(cur); }
        if (!has_next) break;
#pragma unroll
        for (int a = 0; a < 2; ++a)
#pragma unroll
            for (int b = 0; b < 2; ++b)
#pragma unroll
                for (int m = 0; m < 4; ++m)
#pragma unroll
                    for (int n = 0; n < 2; ++n) acc[a][b][m][n] = (f32x4){0.f, 0.f, 0.f, 0.f};
        cur = nxt; cA = nA; cB = nB; ++ui;
        if constexpr (ALIGN_EPI) { if (wr == 1) PG8_BAR; }
    }
    PG8_WAIT_V(0);
    if constexpr (!ALIGN_EPI) { if (wr == 0) PG8_BAR; }
    PG8_BAR;
    if constexpr (Epi::AFTER_DRAIN) { E.fused(acc, cur, wr, wc, fr, fq, lds, wid, lane); S.done(cur); }
#undef PG8_SA
#undef PG8_SB
#undef PG8_STAGE
#undef PG8_LDA
#undef PG8_LDB
#undef PG8_MMA
#undef PG8_WAIT_V
#undef PG8_WAIT_L
#undef PG8_BAR
#undef PG8_SCHED
}
}
constexpr int DM = 2048, FF = 5632, NQKV = 4096, SEQ = 4096, NMETA = 16, SP = SEQ + NMETA  , SKP = 4160  , NB = 2;
constexpr int MAIN = NB * SEQ;
constexpr int ROW_META = MAIN, ROW_SAMP = MAIN + 16, MROWS = MAIN + 64;
constexpr int DB = 8, DS = 4, PAST = 16384, PAGE = 128, NPAGE = PAST / PAGE, NH = 8, HD = 128, AW = 1024, PW = 1024;
constexpr float EPS = 1e-6f;
constexpr int NWAVES = 8;
#ifndef MK_N_LAUNCHES
#define MK_N_LAUNCHES 1
#endif
constexpr int NPH = 10;
constexpr int N_LAUNCHES = MK_N_LAUNCHES;
#ifndef MK_FAST_GEMM
#define MK_FAST_GEMM 1
#endif
#ifndef MK_FAST_ATTN
#define MK_FAST_ATTN 1
#endif
constexpr bool FAST_GEMM = MK_FAST_GEMM;

constexpr size_t O_YP = 0, O_YS = O_YP + (size_t)MAIN * DM, O_KP = O_YS + (size_t)32 * DM, O_VP = O_KP + (size_t)NB * SP * 1024, O_PP = O_VP + (size_t)NB * SP * 1024,
                 O_KS = O_PP + (size_t)NB * 15 * 1024, O_VS = O_KS + (size_t)32 * 1024, O_PS = O_VS + (size_t)32 * 1024, O_END = O_PS + (size_t)DB * 15 * 1024;

constexpr size_t MiB = 1u << 20;
#ifndef MK_XSYNC
#define MK_XSYNC 0
#endif
#ifndef MK_REPEAT
#define MK_REPEAT 0
#endif
#ifndef MK_ROLES
#define MK_ROLES 0x55888888u
#define MK_LFIRST 0xFFFFu
#endif
constexpr size_t WS_CTL = 0, CTL_ZERO_BYTES = MK_XSYNC ? 256 * 1024 : 64 * 1024;
constexpr size_t WS_WGU1 = 2 * MiB, WS_WD1 = 46 * MiB, WS_WIN = 68 * MiB, WS_WOUT = 84 * MiB, WS_WGU2 = 92 * MiB, WS_WD2 = 136 * MiB;
constexpr size_t WS_XA = 158 * MiB, WS_ACT = 191 * MiB, WS_X1 = 280 * MiB, WS_Q = 345 * MiB, WS_QS = 361 * MiB, WS_KB = 362 * MiB, WS_VB = 379 * MiB, WS_PB = 396 * MiB;
constexpr size_t WS_KS = 413 * MiB, WS_VS = 415 * MiB, WS_PSN = 417 * MiB, WS_CAT = 418 * MiB, WS_OPART = 451 * MiB, WS_SSQ = 470 * MiB, WS_SLAB = 476 * MiB, WS_END = 486 * MiB;
static_assert(WS_WGU1 + (size_t)2 * FF * DM * 2 <= WS_WD1 && WS_WD1 + (size_t)DM * FF * 2 <= WS_WIN && WS_WIN + (size_t)NQKV * DM * 2 <= WS_WOUT && WS_WOUT + (size_t)DM * DM * 2 <= WS_WGU2, "ws map 1");
static_assert(WS_XA + (size_t)MROWS * DM * 2 <= WS_ACT && WS_ACT + (size_t)MROWS * FF * 2 <= WS_X1 && WS_X1 + (size_t)MROWS * DM * 4 <= WS_Q && WS_Q + (size_t)MAIN * 1024 * 2 <= WS_QS, "ws map 2");
static_assert(WS_KB + (size_t)NB * SKP * 1024 * 2 <= WS_VB && WS_VB + (size_t)NB * SKP * 1024 * 2 <= WS_PB && WS_PB + (size_t)NB * SP * 1024 * 2 <= WS_KS && WS_CAT + (size_t)MROWS * DM * 2 <= WS_OPART, "ws map 3");
constexpr int SSQ_PAD = 1;
constexpr size_t SSQ_BYTES = (size_t)4 * MROWS * SSQ_PAD * 4;
static_assert(WS_SSQ + SSQ_BYTES <= WS_SLAB, "ssq");
constexpr int CW_TMO = 0, CW_CODE = 1, CW_BAR = 4096, CW_SSQ = 16384, CW_DCNT = 14336;


constexpr int RING_OFF = 0, RING_BYTES = 131072;
constexpr int LDSCTL_OFF = RING_BYTES, MISC_OFF = LDSCTL_OFF + 320;
constexpr int LDS_BYTES = 147456;

#define GAS __attribute__((address_space(1)))
#define LAS __attribute__((address_space(3)))
typedef unsigned short bf16;
typedef unsigned v4u __attribute__((ext_vector_type(4)));
typedef unsigned v2u __attribute__((ext_vector_type(2)));
typedef float f32x4 __attribute__((ext_vector_type(4)));
typedef short bf16x8 __attribute__((ext_vector_type(8)));
typedef GAS unsigned gu32;
#define RLX_AGENT __ATOMIC_RELAXED, __HIP_MEMORY_SCOPE_AGENT
#define LDS_WAIT() asm volatile("s_waitcnt lgkmcnt(0)" ::: "memory")
#define VM_WAIT() asm volatile("s_waitcnt vmcnt(0)" ::: "memory")
__device__ __forceinline__ unsigned f2bf(float f) { unsigned u = __builtin_bit_cast(unsigned, f); return (u + 0x7fffu + ((u >> 16) & 1u)) >> 16; }
__device__ __forceinline__ unsigned pk2(float lo, float hi) { unsigned r; asm volatile("v_cvt_pk_bf16_f32 %0, %1, %2" : "=v"(r) : "v"(lo), "v"(hi)); return r; }
__device__ __forceinline__ float bf2f(unsigned short x) { return __builtin_bit_cast(float, (unsigned)x << 16); }
__device__ __forceinline__ float bflo(unsigned w) { return __builtin_bit_cast(float, w << 16); }
__device__ __forceinline__ float bfhi(unsigned w) { return __builtin_bit_cast(float, w & 0xffff0000u); }
__device__ __forceinline__ float wave_sum(float v) {
#pragma unroll
    for (int o = 1; o < 64; o <<= 1) v += __shfl_xor(v, o);
    return v;
}
__device__ __forceinline__ float wave_max(float v) {
#pragma unroll
    for (int o = 1; o < 64; o <<= 1) v = fmaxf(v, __shfl_xor(v, o));
    return v;
}
__device__ __forceinline__ unsigned lane_now() { unsigned l; asm volatile("v_mbcnt_lo_u32_b32 %0, -1, 0\n\tv_mbcnt_hi_u32_b32 %0, -1, %0" : "=v"(l)); return l; }
#define XB_TMO      128
#define XB_XCNT(j)  (256  + 64 * (j))
#define XB_XSUB(j)  (1280 + 64 * (j))
#define XB_XGEN(j)  (2304 + 64 * (j))
#define XB_TOP      3328
#define XB_TOPGEN   3392
#define XCD_BAR_WORDS 3456
#define XB_SPIN_CAP (1u << 18)

__device__ __forceinline__ unsigned xb_ld(unsigned* p)              { return __hip_atomic_load(p, __ATOMIC_RELAXED, __HIP_MEMORY_SCOPE_AGENT); }
__device__ __forceinline__ unsigned xb_add(unsigned* p, unsigned v) { return __hip_atomic_fetch_add(p, v, __ATOMIC_RELAXED, __HIP_MEMORY_SCOPE_AGENT); }
__device__ __forceinline__ unsigned xb_xcc_id() { return (unsigned)__builtin_amdgcn_s_getreg((3 << 11) | 20) & 0xFu; }
#define XB_SPIN(cond, bar) do { unsigned _sp = 0; while (cond) { __builtin_amdgcn_s_sleep(1); \
    if ((++_sp & 255u) == 0u) { if (xb_ld(&(bar)[XB_TMO])) break; if (_sp > XB_SPIN_CAP) { atomicAdd(&(bar)[XB_TMO], 1u); break; } } } } while (0)

struct XcdBarrier {
    unsigned* bar; unsigned x;
    volatile LAS unsigned* st;
};

__device__ __forceinline__ XcdBarrier xcd_barrier_post(unsigned* bar, volatile LAS unsigned* st) {
    XcdBarrier b; b.bar = bar; b.x = xb_xcc_id(); b.st = st;
    if (threadIdx.x == 0) (void)xb_add(&bar[XB_XCNT(b.x)], 1u);
    return b;
}
__device__ __forceinline__ void xcd_barrier_complete(unsigned* bar, unsigned x, unsigned& nloc, unsigned& nx) {
    const unsigned G = gridDim.x * gridDim.y * gridDim.z;
    unsigned sum, cnt, mine, sp = 0u;
    for (;;) {
        sum = 0u; cnt = 0u; mine = 0u;
#pragma unroll
        for (unsigned j = 0; j < 16; ++j) { const unsigned c = xb_ld(&bar[XB_XCNT(j)]); sum += c; cnt += (c > 0u) ? 1u : 0u; mine = (j == x) ? c : mine; }
        if (sum == G) break;
        __builtin_amdgcn_s_sleep(1);
        if ((++sp & 255u) == 0u) { if (xb_ld(&bar[XB_TMO])) break; if (sp > XB_SPIN_CAP) { atomicAdd(&bar[XB_TMO], 1u); break; } }
    }
    nloc = mine > 0u ? mine : 1u; nx = cnt > 0u ? cnt : 1u;
}

__device__ __forceinline__ void xcd_barrier(const XcdBarrier& b) {
    asm volatile("s_waitcnt vmcnt(0)" ::: "memory");
    __syncthreads();
    if (threadIdx.x == 0) {
        unsigned* bar = b.bar;
        __builtin_amdgcn_s_waitcnt(0);
        unsigned nloc = b.st[0], nx = b.st[1];
        if (nloc == 0u) { xcd_barrier_complete(bar, b.x, nloc, nx); b.st[0] = nloc; b.st[1] = nx; }
        const unsigned old = xb_add(&bar[XB_XSUB(b.x)], 1u);
        const unsigned gen = old / nloc;
        if (old + 1u == (gen + 1u) * nloc) {
            __builtin_amdgcn_fence(__ATOMIC_RELEASE, "agent");
            asm volatile("s_waitcnt vmcnt(0)" ::: "memory");
            const unsigned og = xb_add(&bar[XB_TOP], 1u);
            const unsigned tg = og / nx;
            if (og + 1u == (tg + 1u) * nx) xb_add(&bar[XB_TOPGEN], 1u);
            else XB_SPIN(xb_ld(&bar[XB_TOPGEN]) == tg, bar);
            __builtin_amdgcn_fence(__ATOMIC_ACQUIRE, "agent");
            xb_add(&bar[XB_XGEN(b.x)], 1u);
            asm volatile("s_waitcnt vmcnt(0)" ::: "memory");
        } else {
            XB_SPIN(xb_ld(&bar[XB_XGEN(b.x)]) == gen, bar);
            __builtin_amdgcn_fence(__ATOMIC_ACQUIRE, "agent");
            asm volatile("s_waitcnt vmcnt(0)" ::: "memory");
        }
    }
    __syncthreads();
}
struct Frame {
    LAS unsigned char* lds;
    volatile LAS unsigned* MISC;
    gu32* ctl;
    unsigned tid, lane; int wave, vcu, G;
    float* out; unsigned char* ws;
};
enum { I_XP = 0, I_XS, I_CK, I_CV, I_SPOOL, I_PT, I_META, I_NF1, I_WG1, I_WU1, I_WD1, I_NMIX, I_WIN, I_WPOOL, I_PSCALE, I_LQ1, I_LK1, I_LQ2, I_LK2, I_SUBLN, I_WOUT, I_NF2, I_WG2, I_WU2, I_WD2, I_NFIN };
#define WSP(T, off) ((T*)(F.ws + (off)))
__device__ __forceinline__ const float* inp(const Frame& F, int i) {
    volatile LAS unsigned* t = (volatile LAS unsigned*)(F.lds + LDSCTL_OFF);
    const unsigned lo = __builtin_amdgcn_readfirstlane(t[2 * i]), hi = __builtin_amdgcn_readfirstlane(t[2 * i + 1]);
    return (const float*)(const GAS float*)(((unsigned long long)hi << 32) | lo);
}
__device__ __forceinline__ float* ssq_ptr(const Frame& F, int k) { return (float*)(F.ws + WS_SSQ) + (size_t)k * MROWS * SSQ_PAD; }
__device__ __forceinline__ const float* x0_row(const Frame& F, int row) {
    if (row < MAIN) return inp(F, I_XP) + (size_t)row * DM;
    if (row < ROW_SAMP) return inp(F, I_META) + (size_t)(row - ROW_META) * DM;
    if (row < ROW_SAMP + 32) return inp(F, I_XS) + (size_t)(row - ROW_SAMP) * DM;
    return nullptr;
}
__device__ __forceinline__ float lam_get(const Frame& F) { return __builtin_bit_cast(float, (unsigned)F.MISC[16]); }
__device__ __forceinline__ float lam_value(const Frame& F) {
    const float a = wave_sum(inp(F, I_LQ1)[F.lane] * inp(F, I_LK1)[F.lane]), b = wave_sum(inp(F, I_LQ2)[F.lane] * inp(F, I_LK2)[F.lane]);
    return __expf(a) - __expf(b) + 0.2f;
}

struct TrItem { const float* W; bf16* WT; const float* gain; int N, ldk, koff, map, k0, n0; };
__device__ __forceinline__ int rowmap_rt(int map, int n) { return map == 0 ? n : (n >> 7) * 256 + (n & 127) + (map == 2 ? 128 : 0); }
__device__ __forceinline__ void tr_load(const TrItem& P, float (&wv)[32], unsigned lane) {
    const float* wp = P.W + (size_t)(P.k0 + (lane >> 5)) * P.N + P.n0 + (lane & 31);
#pragma unroll
    for (int i = 0; i < 32; ++i) wv[i] = __builtin_nontemporal_load(wp + (size_t)(2 * i) * P.N);
}
__device__ __forceinline__ void tr_store(const TrItem& P, const float (&wv)[32], LAS float* scr, unsigned lane) {
#pragma unroll
    for (int i = 0; i < 32; ++i) scr[(2 * i + (lane >> 5)) * 33 + (lane & 31)] = wv[i];
    LDS_WAIT(); asm volatile("" ::: "memory");
    const int c = lane & 7;
    f32x4 g0 = {1.f, 1.f, 1.f, 1.f}, g1 = g0;
    if (P.gain) { g0 = *(const GAS f32x4*)(P.gain + P.k0 + 8 * c); g1 = *(const GAS f32x4*)(P.gain + P.k0 + 8 * c + 4); }
#pragma unroll
    for (int j = 0; j < 4; ++j) { const int n = (lane >> 3) + 8 * j; const LAS float* s = scr + (8 * c) * 33 + n;
        v4u o; o.x = pk2(s[0 * 33] * g0.x, s[1 * 33] * g0.y); o.y = pk2(s[2 * 33] * g0.z, s[3 * 33] * g0.w); o.z = pk2(s[4 * 33] * g1.x, s[5 * 33] * g1.y); o.w = pk2(s[6 * 33] * g1.z, s[7 * 33] * g1.w);
        *(GAS v4u*)(P.WT + (size_t)rowmap_rt(P.map, P.n0 + n) * P.ldk + P.koff + P.k0 + 8 * c) = o; }
    LDS_WAIT(); asm volatile("" ::: "memory");
}
__device__ __forceinline__ void poolfold_tile(Frame& F, int tile) {
    const float* wp = inp(F, I_WPOOL); const float* ps = inp(F, I_PSCALE); const float* wout = inp(F, I_WOUT); bf16* WOUT = WSP(bf16, WS_WOUT);
    const int kb = tile >> 3, nb = tile & 7, k0 = kb * 32, g = k0 >> 8, i0 = k0 & 255, n0 = nb * 256;
    const unsigned tid = F.tid;
    LAS float* AT = (LAS float*)(F.lds + RING_OFF);
    LAS float* Bs = AT + 256 * 32;
    { const int i = tid >> 4, j0 = (tid & 15) * 16; const float* src = wp + ((size_t)(g * 256 + i0 + i)) * 256 + j0; const float* sc = ps + g * 256 + j0;
#pragma unroll
      for (int q = 0; q < 4; ++q) { const f32x4 a = *(const GAS f32x4*)(src + 4 * q), s4 = *(const GAS f32x4*)(sc + 4 * q);
          AT[(j0 + 4 * q + 0) * 32 + i] = a.x * s4.x; AT[(j0 + 4 * q + 1) * 32 + i] = a.y * s4.y; AT[(j0 + 4 * q + 2) * 32 + i] = a.z * s4.z; AT[(j0 + 4 * q + 3) * 32 + i] = a.w * s4.w; } }
    const float* bsrc = wout + (size_t)(g * 256) * DM + n0;
    f32x4 st[4];
#define PF_LOAD(c) do { _Pragma("unroll") for (int q = 0; q < 4; ++q) st[q] = *(const GAS f32x4*)(bsrc + (size_t)(32 * (c) + (tid >> 6) + 8 * q) * DM + (tid & 63) * 4); } while (0)
#define PF_WRITE(buf) do { _Pragma("unroll") for (int q = 0; q < 4; ++q) *(LAS f32x4*)(Bs + (buf) * 8192 + ((tid >> 6) + 8 * q) * 256 + (tid & 63) * 4) = st[q]; } while (0)
    PF_LOAD(0); PF_WRITE(0); PF_LOAD(1);
    __syncthreads();
    float acc[8][2];
#pragma unroll
    for (int r = 0; r < 8; ++r) { acc[r][0] = 0.f; acc[r][1] = 0.f; }
    const int ig = tid >> 7, np = tid & 127;
#pragma unroll 1
    for (int c = 0; c < 8; ++c) {
        const LAS float* Bc = Bs + (c & 1) * 8192 + np * 2; const LAS float* Ac = AT + (32 * c) * 32 + ig * 8;
#pragma unroll 8
        for (int j = 0; j < 32; ++j) { const f32x4 a0 = *(const LAS f32x4*)(Ac + j * 32), a1 = *(const LAS f32x4*)(Ac + j * 32 + 4); const float b0 = Bc[j * 256], b1 = Bc[j * 256 + 1];
            acc[0][0] += a0.x * b0; acc[0][1] += a0.x * b1; acc[1][0] += a0.y * b0; acc[1][1] += a0.y * b1; acc[2][0] += a0.z * b0; acc[2][1] += a0.z * b1; acc[3][0] += a0.w * b0; acc[3][1] += a0.w * b1;
            acc[4][0] += a1.x * b0; acc[4][1] += a1.x * b1; acc[5][0] += a1.y * b0; acc[5][1] += a1.y * b1; acc[6][0] += a1.z * b0; acc[6][1] += a1.z * b1; acc[7][0] += a1.w * b0; acc[7][1] += a1.w * b1; }
        if (c + 1 < 8) { PF_WRITE((c + 1) & 1); if (c + 2 < 8) PF_LOAD(c + 2); }
        __syncthreads();
    }
#undef PF_LOAD
#undef PF_WRITE
#pragma unroll
    for (int q = 0; q < 2; ++q) { v4u o; o.x = pk2(acc[0][q], acc[1][q]); o.y = pk2(acc[2][q], acc[3][q]); o.z = pk2(acc[4][q], acc[5][q]); o.w = pk2(acc[6][q], acc[7][q]);
        *(GAS v4u*)(WOUT + (size_t)(n0 + np * 2 + q) * DM + k0 + ig * 8) = o; }
}
__device__ __forceinline__ void rms_row_to_bf16(const float* xrow, const float* g, bf16* orow, int lane) {
    GAS unsigned long long* o8 = (GAS unsigned long long*)orow + lane;
    if (!xrow) {
#pragma unroll
        for (int j = 0; j < 8; ++j) o8[64 * j] = 0ull;
        return; }
    const GAS f32x4* xr = (const GAS f32x4*)xrow + lane;
    f32x4 v[8]; float s = 0.f;
#pragma unroll
    for (int j = 0; j < 8; ++j) { v[j] = xr[64 * j]; s += (v[j].x * v[j].x + v[j].y * v[j].y) + (v[j].z * v[j].z + v[j].w * v[j].w); }
    const float rs = rsqrtf(wave_sum(s) * (1.f / DM) + EPS);
#pragma unroll
    for (int j = 0; j < 8; ++j) { const f32x4 gv = ((const GAS f32x4*)g)[lane + 64 * j];
        o8[64 * j] = (unsigned long long)pk2(v[j].x * rs * gv.x, v[j].y * rs * gv.y) | ((unsigned long long)pk2(v[j].z * rs * gv.z, v[j].w * rs * gv.w) << 32); }
}
constexpr int TI_GU = (DM / 64) * (FF / 32), TI_DN = (FF / 64) * (DM / 32), TI_IN = (DM / 64) * (NQKV / 32), TI_OUT = (1024 / 64) * (DM / 32);
constexpr int TR_GU1_END = 2 * TI_GU, TR_D1_END = TR_GU1_END + TI_DN, TR_IN_END = TR_D1_END + TI_IN, TR_OUT_END = TR_IN_END + TI_OUT, TR_GU2_END = TR_OUT_END + 2 * TI_GU, TR_END = TR_GU2_END + TI_DN;
__device__ __forceinline__ TrItem tr_item(Frame& F, int it) {
    TrItem P; int r = it, nblk;
    if (r < TI_GU) { P = TrItem{inp(F, I_WG1), WSP(bf16, WS_WGU1), nullptr, FF, DM, 0, 1, 0, 0}; }
    else if ((r -= TI_GU) < TI_GU) { P = TrItem{inp(F, I_WU1), WSP(bf16, WS_WGU1), nullptr, FF, DM, 0, 2, 0, 0}; }
    else if ((r -= TI_GU) < TI_DN) { P = TrItem{inp(F, I_WD1), WSP(bf16, WS_WD1), nullptr, DM, FF, 0, 0, 0, 0}; }
    else if ((r -= TI_DN) < TI_IN) { P = TrItem{inp(F, I_WIN), WSP(bf16, WS_WIN), inp(F, I_NMIX), NQKV, DM, 0, 0, 0, 0}; }
    else if ((r -= TI_IN) < TI_OUT) { P = TrItem{inp(F, I_WOUT) + (size_t)1024 * DM, WSP(bf16, WS_WOUT), nullptr, DM, DM, 1024, 0, 0, 0}; }
    else if ((r -= TI_OUT) < TI_GU) { P = TrItem{inp(F, I_WG2), WSP(bf16, WS_WGU2), inp(F, I_NF2), FF, DM, 0, 1, 0, 0}; }
    else if ((r -= TI_GU) < TI_GU) { P = TrItem{inp(F, I_WU2), WSP(bf16, WS_WGU2), inp(F, I_NF2), FF, DM, 0, 2, 0, 0}; }
    else { r -= TI_GU; P = TrItem{inp(F, I_WD2), WSP(bf16, WS_WD2), nullptr, DM, FF, 0, 0, 0, 0}; }
    nblk = P.N / 32; P.k0 = 64 * (r / nblk); P.n0 = 32 * (r % nblk); return P;
}
__device__ __forceinline__ void tr_range(Frame& F, int first, int last, int part, int nparts) {
    LAS float* scr = (LAS float*)(F.lds + RING_OFF + F.wave * 16384);
    if (first + part < last) {
        float wv[32], wn[32];
        TrItem cur = tr_item(F, first + part); tr_load(cur, wv, F.lane);
#pragma unroll 1
        for (int it = first + part; it < last; it += nparts) {
            const bool more = it + nparts < last; TrItem nxt = cur;
            if (more) { nxt = tr_item(F, it + nparts); tr_load(nxt, wn, F.lane); }
            tr_store(cur, wv, scr, F.lane);
            if (more) { cur = nxt;
#pragma unroll
                for (int i = 0; i < 32; ++i) wv[i] = wn[i]; }
        }
    }
}
__device__ __forceinline__ void tr_window(Frame& F, int first, int last, int wg_first) {
    const int c = (int)blockIdx.x, wf = wg_first < F.G ? wg_first : 0;
    if (c >= wf) tr_range(F, first, last, (c - wf) * NWAVES + F.wave, (F.G - wf) * NWAVES);
}
__device__ __forceinline__ void p0_prologue(Frame& F) {
    const int gw = F.vcu * NWAVES + F.wave, NGW = F.G * NWAVES;
    for (int tile = F.vcu; tile < 256; tile += F.G) poolfold_tile(F, tile);
    tr_range(F, 0, TR_GU1_END, gw, NGW);
    { const int gt = F.vcu * NWAVES * 64 + F.tid, NT = F.G * NWAVES * 64; f32x4* z = (f32x4*)(F.ws + WS_SSQ);
      for (int i = gt; i < (int)(SSQ_BYTES / 16); i += NT) z[i] = (f32x4){0.f, 0.f, 0.f, 0.f}; }
    {
        const float* g = inp(F, I_NF1);
        f32x4 v[8], w[8]; const float* xr = gw < MROWS ? x0_row(F, gw) : nullptr;
        if (xr) {
#pragma unroll
            for (int j = 0; j < 8; ++j) v[j] = ((const GAS f32x4*)xr)[F.lane + 64 * j]; }
#pragma unroll 1
        for (int m = gw; m < MROWS; m += NGW) {
            const int mn = m + NGW; const float* xn = mn < MROWS ? x0_row(F, mn) : nullptr;
            if (xn) {
#pragma unroll
                for (int j = 0; j < 8; ++j) w[j] = ((const GAS f32x4*)xn)[F.lane + 64 * j]; }
            GAS unsigned long long* o8 = (GAS unsigned long long*)(WSP(bf16, WS_XA) + (size_t)m * DM) + F.lane;
            if (!xr) {
#pragma unroll
                for (int j = 0; j < 8; ++j) o8[64 * j] = 0ull;
            } else {
                float s = 0.f;
#pragma unroll
                for (int j = 0; j < 8; ++j) s += (v[j].x * v[j].x + v[j].y * v[j].y) + (v[j].z * v[j].z + v[j].w * v[j].w);
                const float rs = rsqrtf(wave_sum(s) * (1.f / DM) + EPS);
#pragma unroll
                for (int j = 0; j < 8; ++j) { const f32x4 gv = ((const GAS f32x4*)g)[F.lane + 64 * j];
                    o8[64 * j] = (unsigned long long)pk2(v[j].x * rs * gv.x, v[j].y * rs * gv.y) | ((unsigned long long)pk2(v[j].z * rs * gv.z, v[j].w * rs * gv.w) << 32); }
            }
            xr = xn;
#pragma unroll
            for (int j = 0; j < 8; ++j) v[j] = w[j];
        }
    }
    { const int gt = F.vcu * NWAVES * 64 + F.tid, NT = F.G * NWAVES * 64;
      for (int i = gt; i < DB * 11 * 256; i += NT) { const int c4 = i & 255, r = (i >> 8) % 11, b = i / (11 * 256);
          ((f32x4*)(F.out + O_PS + ((size_t)b * 15 + r) * 1024))[c4] = ((const f32x4*)(inp(F, I_SPOOL) + ((size_t)b * 15 + 4 + r) * 1024))[c4]; } }
}

struct RSwiglu {
    static constexpr bool HAS_SSQ = false;
    bf16* act; const float* ssq;
    struct Pre { float q; };
    __device__ __forceinline__ void pre(int row, int, Pre& p) const { p.q = ssq ? ssq[row * SSQ_PAD] : 0.f; }
    __device__ __forceinline__ float tile(int row, int colbase, const float (&v)[2][8], const Pre& p) const {
        const float rs = ssq ? rsqrtf(p.q * (1.f / DM) + EPS) : 1.f;
        const int ff = (colbase >> 8) * 128 + (colbase & 127);
        float a[8];
#pragma unroll
        for (int j = 0; j < 8; ++j) { const float g = v[0][j] * rs, u = v[1][j] * rs; a[j] = g * u * __builtin_amdgcn_rcpf(1.f + __builtin_amdgcn_exp2f(g * -1.4426950408889634f)); }
        v4u o; o.x = pk2(a[0], a[1]); o.y = pk2(a[2], a[3]); o.z = pk2(a[4], a[5]); o.w = pk2(a[6], a[7]);
        *(GAS v4u*)(act + (size_t)row * FF + ff) = o; return 0.f;
    }
};
struct RResid {
    static constexpr bool HAS_SSQ = true;
    const Frame* Fp; int mode;
    float alpha;
    struct Pre { f32x4 a0, a1, b0, b1; v4u w0, w1; };
    __device__ __forceinline__ float resid_inplace(float (&v)[2][8], const Pre& p) const {
        float s = 0.f;
#pragma unroll
        for (int h = 0; h < 2; ++h) { const v4u w = h ? p.w1 : p.w0; const float rr_[8] = {bflo(w.x), bfhi(w.x), bflo(w.y), bfhi(w.y), bflo(w.z), bfhi(w.z), bflo(w.w), bfhi(w.w)};
#pragma unroll
            for (int j = 0; j < 8; ++j) { v[h][j] = rr_[j] + alpha * v[h][j]; s += v[h][j] * v[h][j]; } }
        return s;
    }
    __device__ __forceinline__ void pre(int row, int colbase, Pre& p) const {
        const Frame& F = *Fp;
        if (mode == 0) { const float* res = x0_row(F, row); p.a0 = p.a1 = p.b0 = p.b1 = (f32x4){0.f, 0.f, 0.f, 0.f};
            if (res) { p.a0 = *(const GAS f32x4*)(res + colbase); p.a1 = *(const GAS f32x4*)(res + colbase + 4); p.b0 = *(const GAS f32x4*)(res + colbase + 128); p.b1 = *(const GAS f32x4*)(res + colbase + 132); } }
        else { const bf16* xa = WSP(bf16, WS_XA) + (size_t)row * DM + colbase; p.w0 = *(const GAS v4u*)xa; p.w1 = *(const GAS v4u*)(xa + 128); }
    }
    __device__ __forceinline__ float tile(int row, int colbase, const float (&v)[2][8], const Pre& p) const {
        const Frame& F = *Fp;
        bf16* xa = WSP(bf16, WS_XA) + (size_t)row * DM;
        float* dst = mode != 2 ? nullptr : (row < MAIN ? F.out + O_YP + (size_t)row * DM : (row >= ROW_SAMP && row < ROW_SAMP + 32) ? F.out + O_YS + (size_t)(row - ROW_SAMP) * DM : nullptr);
        float s = 0.f;
#pragma unroll
        for (int h = 0; h < 2; ++h) { const int col = colbase + 128 * h;
            f32x4 r0, r1;
            if (mode == 0) { r0 = h ? p.b0 : p.a0; r1 = h ? p.b1 : p.a1; }
            else { const v4u w = h ? p.w1 : p.w0; r0 = (f32x4){bflo(w.x), bfhi(w.x), bflo(w.y), bfhi(w.y)}; r1 = (f32x4){bflo(w.z), bfhi(w.z), bflo(w.w), bfhi(w.w)}; }
            f32x4 a = {r0.x + alpha * v[h][0], r0.y + alpha * v[h][1], r0.z + alpha * v[h][2], r0.w + alpha * v[h][3]};
            f32x4 b = {r1.x + alpha * v[h][4], r1.y + alpha * v[h][5], r1.z + alpha * v[h][6], r1.w + alpha * v[h][7]};
            s += (a.x * a.x + a.y * a.y) + (a.z * a.z + a.w * a.w) + (b.x * b.x + b.y * b.y) + (b.z * b.z + b.w * b.w);
            if (mode == 2) { if (dst) { *(GAS f32x4*)(dst + col) = a; *(GAS f32x4*)(dst + col + 4) = b; } }
            else { v4u o; o.x = pk2(a.x, a.y); o.y = pk2(a.z, a.w); o.z = pk2(b.x, b.y); o.w = pk2(b.z, b.w); *(GAS v4u*)(xa + col) = o; } }
        return s;
    }
};
struct RProj {
    static constexpr bool HAS_SSQ = false;
    const Frame* Fp;
    __device__ __forceinline__ void put(int row, int col, const float (&x)[8]) const {
        const Frame& F = *Fp;
        const int t = col >> 10, c = col & 1023;
        v4u o; o.x = pk2(x[0], x[1]); o.y = pk2(x[2], x[3]); o.z = pk2(x[4], x[5]); o.w = pk2(x[6], x[7]);
        const f32x4 fa = {x[0], x[1], x[2], x[3]}, fb = {x[4], x[5], x[6], x[7]};
        if (row < MAIN) {
            const int b = row >> 12, tt = row & 4095;
            if (t == 0) { *(GAS v4u*)(WSP(bf16, WS_PB) + ((size_t)b * SP + 16 + tt) * 1024 + c) = o;
                if (tt >= SEQ - 15) { float* d = F.out + O_PP + ((size_t)b * 15 + (tt - (SEQ - 15))) * 1024 + c; *(GAS f32x4*)d = fa; *(GAS f32x4*)(d + 4) = fb; } }
            else if (t == 1) { *(GAS v4u*)(WSP(bf16, WS_Q) + (size_t)row * 1024 + c) = o; }
            else { *(GAS v4u*)(WSP(bf16, t == 2 ? WS_KB : WS_VB) + ((size_t)b * SKP + 16 + tt) * 1024 + c) = o;
                float* d = F.out + (t == 2 ? O_KP : O_VP) + ((size_t)b * SP + 16 + tt) * 1024 + c; *(GAS f32x4*)d = fa; *(GAS f32x4*)(d + 4) = fb; }
        } else if (row < ROW_SAMP) {
            const int i = row - ROW_META;
#pragma unroll
            for (int b = 0; b < NB; ++b) {
                if (t == 0) { *(GAS v4u*)(WSP(bf16, WS_PB) + ((size_t)b * SP + i) * 1024 + c) = o; }
                else if (t >= 2) { *(GAS v4u*)(WSP(bf16, t == 2 ? WS_KB : WS_VB) + ((size_t)b * SKP + i) * 1024 + c) = o;
                    float* d = F.out + (t == 2 ? O_KP : O_VP) + ((size_t)b * SP + i) * 1024 + c; *(GAS f32x4*)d = fa; *(GAS f32x4*)(d + 4) = fb; } }
        } else if (row < ROW_SAMP + 32) {
            const int j = row - ROW_SAMP, b = j >> 2, tt = j & 3;
            if (t == 0) { float* d = WSP(float, WS_PSN) + (size_t)j * 1024 + c; *(GAS f32x4*)d = fa; *(GAS f32x4*)(d + 4) = fb;
                float* e = F.out + O_PS + ((size_t)b * 15 + 11 + tt) * 1024 + c; *(GAS f32x4*)e = fa; *(GAS f32x4*)(e + 4) = fb; }
            else if (t == 1) { *(GAS v4u*)(WSP(bf16, WS_QS) + (size_t)j * 1024 + c) = o; }
            else { float* d = WSP(float, t == 2 ? WS_KS : WS_VS) + ((size_t)b * 64 + tt) * 1024 + c; *(GAS f32x4*)d = fa; *(GAS f32x4*)(d + 4) = fb;
                float* e = F.out + (t == 2 ? O_KS : O_VS) + (size_t)j * 1024 + c; *(GAS f32x4*)e = fa; *(GAS f32x4*)(e + 4) = fb; }
        }
    }
    struct Pre { float q; };
    __device__ __forceinline__ void pre(int row, int, Pre& p) const { p.q = ssq_ptr(*Fp, 0)[row * SSQ_PAD]; }
    __device__ __forceinline__ float tile(int row, int colbase, const float (&v)[2][8], const Pre& p) const {
        const float rs = rsqrtf(p.q * (1.f / DM) + EPS);
        float x[8];
#pragma unroll
        for (int h = 0; h < 2; ++h) {
#pragma unroll
            for (int j = 0; j < 8; ++j) x[j] = v[h][j] * rs;
            put(row, colbase + 128 * h, x); }
        return 0.f;
    }
};
struct SyncOrder {
    pg8::StaticOrder S; unsigned* cnt; unsigned nloc, xcc; int full_rounds; mutable int ui;
    __device__ bool next(int i, pg8::Unit& u) const { return S.next(i, u); }
    __device__ __forceinline__ void a_ready(const pg8::Unit&) const {
        const int i = ui++;
        if (i >= 1 && i < full_rounds) {
            if (threadIdx.x == 0) { unsigned* c = cnt + 64 * (xcc * 8 + i); __hip_atomic_fetch_add(c, 1u, RLX_AGENT); unsigned sp = 0;
                while (__hip_atomic_load(c, RLX_AGENT) < nloc) { __builtin_amdgcn_s_sleep(1); if (++sp > (1u << 16)) break; } }
            __builtin_amdgcn_s_barrier();
        }
    }
    __device__ __forceinline__ void done(const pg8::Unit&) const {}
};
struct RepOrder {
    pg8::StaticOrder S;
    int sh;
    __device__ bool next(int i, pg8::Unit& u) const { return S.next(i >> sh, u); }
    __device__ __forceinline__ void a_ready(const pg8::Unit&) const {}
    __device__ __forceinline__ void done(const pg8::Unit&) const {}
};
template <class R, int SKIP1 = 0> struct EpiFast {
    static constexpr bool PERM = true, AFTER_DRAIN = false;
    R r; float* ssq_dst; mutable int cnt; float* ssq_dummy;
    __device__ __forceinline__ void operator()(const pg8::f32x4 (&acc)[2][2][4][2], const pg8::Unit& u, int wr, int wc, int fr, int fq) const {
        float* sdst = ssq_dst;
        if constexpr (SKIP1 == 1) { const int msk = ((MK_REPEAT >> 15) & 1) ? 3 : 1; if (((cnt++) & msk) != msk) return; }
        if constexpr (SKIP1 == 2) { if (((cnt++) & 1) == 0) sdst = ssq_dummy; }
        const int colbase = u.pn * 256 + wc * 32 + 8 * fq, rowb = u.pm * 256 + wr * 64 + fr;
        typename R::Pre pp[2];
        r.pre(rowb, colbase, pp[0]);
#pragma unroll
        for (int i = 0; i < 8; ++i) {
            const int ai = i >> 2, m = i & 3, row = rowb + ai * 128 + m * 16;
            if (i + 1 < 8) r.pre(rowb + ((i + 1) >> 2) * 128 + ((i + 1) & 3) * 16, colbase, pp[(i + 1) & 1]);
            float v[2][8];
#pragma unroll
            for (int bj = 0; bj < 2; ++bj)
#pragma unroll
                for (int n = 0; n < 2; ++n)
#pragma unroll
                    for (int j = 0; j < 4; ++j) v[bj][4 * n + j] = acc[ai][bj][m][n][j];
            float s = r.tile(row, colbase, v, pp[i & 1]);
            if constexpr (R::HAS_SSQ) { s += __shfl_xor(s, 16); s += __shfl_xor(s, 32); if (fq == 0) __hip_atomic_fetch_add(sdst + row * SSQ_PAD, s, RLX_AGENT); }
        }
    }
};
template <class R> struct EpiDrain {
    static constexpr bool PERM = true, AFTER_DRAIN = true;
    R r; float* ssq_dst;
    __device__ __forceinline__ void operator()(const pg8::f32x4 (&)[2][2][4][2], const pg8::Unit&, int, int, int, int) const {}
    __device__ __forceinline__ void fused(const pg8::f32x4 (&acc)[2][2][4][2], const pg8::Unit& u, int wr, int wc, int fr, int fq, LAS unsigned char* lds, int wid, int lane) const {
        const int colbase = u.pn * 256 + wc * 32 + 8 * fq, rowb = u.pm * 256 + wr * 64 + fr;
        LAS float* tmp = (LAS float*)lds;
        typename R::Pre pp[2];
        r.pre(rowb, colbase, pp[0]);
#pragma unroll
        for (int i = 0; i < 8; ++i) {
            const int ai = i >> 2, m = i & 3, row = rowb + ai * 128 + m * 16;
            if (i + 1 < 8) r.pre(rowb + ((i + 1) >> 2) * 128 + ((i + 1) & 3) * 16, colbase, pp[(i + 1) & 1]);
            float v[2][8];
#pragma unroll
            for (int bj = 0; bj < 2; ++bj)
#pragma unroll
                for (int n = 0; n < 2; ++n)
#pragma unroll
                    for (int j = 0; j < 4; ++j) v[bj][4 * n + j] = acc[ai][bj][m][n][j];
            float s = r.tile(row, colbase, v, pp[i & 1]);
            s += __shfl_xor(s, 16); s += __shfl_xor(s, 32);
            if (fq == 0) tmp[wc * 256 + ai * 128 + wr * 64 + m * 16 + fr] = s;
        }
        __syncthreads();
        if (threadIdx.x < 256) { const int t = threadIdx.x; __hip_atomic_fetch_add(ssq_dst + (u.pm * 256 + t) * SSQ_PAD, (tmp[t] + tmp[256 + t]) + (tmp[512 + t] + tmp[768 + t]), RLX_AGENT); }
        __syncthreads();
    }
};
struct EpiFinal {
    static constexpr bool PERM = true, AFTER_DRAIN = true;
    const Frame* Fp; float* ssq; unsigned* cnt; const float* nf;
    __device__ __forceinline__ void operator()(const pg8::f32x4 (&)[2][2][4][2], const pg8::Unit&, int, int, int, int) const {}
    __device__ __forceinline__ void fused(const pg8::f32x4 (&acc_)[2][2][4][2], const pg8::Unit& u, int wr, int wc, int fr, int fq, LAS unsigned char* lds, int wid, int lane) const {
        const Frame& F = *Fp;
        auto& acc = const_cast<pg8::f32x4 (&)[2][2][4][2]>(acc_);
        const int colbase = u.pn * 256 + wc * 32 + 8 * fq, rowb = u.pm * 256 + wr * 64 + fr;
        v4u rw[2][2];
        { const bf16* res = WSP(bf16, WS_XA) + (size_t)rowb * DM + colbase; rw[0][0] = *(const GAS v4u*)res; rw[0][1] = *(const GAS v4u*)(res + 128); }
#pragma unroll
        for (int i = 0; i < 8; ++i) {
            const int ai = i >> 2, m = i & 3, row = rowb + ai * 128 + m * 16;
            if (i + 1 < 8) { const bf16* res = WSP(bf16, WS_XA) + (size_t)(rowb + ((i + 1) >> 2) * 128 + ((i + 1) & 3) * 16) * DM + colbase; rw[(i + 1) & 1][0] = *(const GAS v4u*)res; rw[(i + 1) & 1][1] = *(const GAS v4u*)(res + 128); }
            float s = 0.f;
#pragma unroll
            for (int bj = 0; bj < 2; ++bj) { const v4u w = rw[i & 1][bj];
#pragma unroll
                for (int n = 0; n < 2; ++n) { const f32x4 r4 = n == 0 ? (f32x4){bflo(w.x), bfhi(w.x), bflo(w.y), bfhi(w.y)} : (f32x4){bflo(w.z), bfhi(w.z), bflo(w.w), bfhi(w.w)}; f32x4 x = acc[ai][bj][m][n];
                    x.x = r4.x + 0.5f * x.x; x.y = r4.y + 0.5f * x.y; x.z = r4.z + 0.5f * x.z; x.w = r4.w + 0.5f * x.w; acc[ai][bj][m][n] = x;
                    s += (x.x * x.x + x.y * x.y) + (x.z * x.z + x.w * x.w); } }
            s += __shfl_xor(s, 16); s += __shfl_xor(s, 32);
            if (fq == 0) ((LAS float*)lds)[wc * 256 + ai * 128 + wr * 64 + m * 16 + fr] = s;
        }
        __syncthreads();
        if (threadIdx.x < 256) { const int t = threadIdx.x; const LAS float* tmp = (const LAS float*)lds; __hip_atomic_fetch_add(ssq + (u.pm * 256 + t) * SSQ_PAD, (tmp[t] + tmp[256 + t]) + (tmp[512 + t] + tmp[768 + t]), RLX_AGENT); }
        asm volatile("s_waitcnt vmcnt(0)" ::: "memory");
        __syncthreads();
        if (threadIdx.x == 0) {
            unsigned* c = cnt + 64 * u.pm;
            __hip_atomic_fetch_add(c, 1u, RLX_AGENT);
            unsigned sp = 0;
            while (__hip_atomic_load(c, RLX_AGENT) < (unsigned)(DM / 256)) { __builtin_amdgcn_s_sleep(1); if (++sp > (1u << 22)) break; }
        }
        __syncthreads();
        f32x4 g[2][2];
#pragma unroll
        for (int bj = 0; bj < 2; ++bj)
#pragma unroll
            for (int n = 0; n < 2; ++n) g[bj][n] = *(const GAS f32x4*)(nf + colbase + 128 * bj + 4 * n);
        float sq[8];
#pragma unroll
        for (int i = 0; i < 8; ++i) sq[i] = __hip_atomic_load(ssq + (rowb + (i >> 2) * 128 + (i & 3) * 16) * SSQ_PAD, RLX_AGENT);
#pragma unroll
        for (int i = 0; i < 8; ++i) {
            const int ai = i >> 2, m = i & 3, row = rowb + ai * 128 + m * 16;
            const float rs = rsqrtf(sq[i] * (1.f / DM) + EPS);
            float* y = F.out + O_YP + (size_t)row * DM + colbase;
#pragma unroll
            for (int bj = 0; bj < 2; ++bj)
#pragma unroll
                for (int n = 0; n < 2; ++n) { const f32x4 x = acc[ai][bj][m][n], gg = g[bj][n]; f32x4 o = {x.x * rs * gg.x, x.y * rs * gg.y, x.z * rs * gg.z, x.w * rs * gg.w};
                    *(GAS f32x4*)(y + 128 * bj + 4 * n) = o; }
        }
    }
};
constexpr int CW_TCNT = 12288;
static_assert((CW_TCNT + 64 * 16 + 16) * 4 <= (int)CTL_ZERO_BYTES && WS_SLAB + (size_t)64 * 8 * 4096 * 4 <= WS_END, "tail slabs");
template <class R>
__device__ __forceinline__ void gemm_simple_unit(Frame& F, const bf16* A, const bf16* Bt, int K, int N, int row0, int pn, int wc, int slice, int nsl, const R& r, float* ssq_dst, bool final_tail = false) {
    const int lane = F.lane, wid = F.wave, fr = lane & 15, fq = lane >> 4;
    const int nks = K / 32 / nsl, ks0 = slice * nks;
    f32x4 acc[4][2][2];
#pragma unroll
    for (int m = 0; m < 4; ++m)
#pragma unroll
        for (int bj = 0; bj < 2; ++bj)
#pragma unroll
            for (int n = 0; n < 2; ++n) acc[m][bj][n] = (f32x4){0.f, 0.f, 0.f, 0.f};
    const bf16* ap = A + (size_t)(row0 + fr) * K + ks0 * 32 + fq * 8;
    const bf16* bp = Bt + (size_t)(pn * 256 + wc * 32 + 8 * (fr >> 2) + (fr & 3)) * K + ks0 * 32 + fq * 8;
    bf16x8 a0[4], b0[2][2], a1[4], b1[2][2];
#define GS_LOAD(a_, b_, j_) do { _Pragma("unroll") for (int m = 0; m < 4; ++m) a_[m] = *(const GAS bf16x8*)(ap + (size_t)(16 * m) * K + (j_) * 32); \
        _Pragma("unroll") for (int bj = 0; bj < 2; ++bj) _Pragma("unroll") for (int n = 0; n < 2; ++n) b_[bj][n] = *(const GAS bf16x8*)(bp + (size_t)(bj * 128 + 4 * n) * K + (j_) * 32); } while (0)
#define GS_MMA(a_, b_) do { _Pragma("unroll") for (int m = 0; m < 4; ++m) _Pragma("unroll") for (int bj = 0; bj < 2; ++bj) _Pragma("unroll") for (int n = 0; n < 2; ++n) \
        acc[m][bj][n] = __builtin_amdgcn_mfma_f32_16x16x32_bf16(b_[bj][n], a_[m], acc[m][bj][n], 0, 0, 0); } while (0)
    if (wid < nks) GS_LOAD(a0, b0, wid);
    for (int j = wid; j < nks; j += 16) {
        if (j + 8 < nks) GS_LOAD(a1, b1, j + 8);
        GS_MMA(a0, b0);
        if (j + 16 < nks) GS_LOAD(a0, b0, j + 16);
        if (j + 8 < nks) GS_MMA(a1, b1);
    }
#undef GS_LOAD
#undef GS_MMA
    LAS float* part = (LAS float*)(F.lds + RING_OFF);
#pragma unroll
    for (int m = 0; m < 4; ++m)
#pragma unroll
        for (int bj = 0; bj < 2; ++bj)
#pragma unroll
            for (int n = 0; n < 2; ++n) *(LAS f32x4*)(part + ((wid * 64 + 16 * m + fr) * 64 + bj * 32 + 8 * fq + 4 * n)) = acc[m][bj][n];
    __syncthreads();
    const int rr = F.tid >> 2, sub = F.tid & 3, colbase = pn * 256 + wc * 32 + 8 * sub;
    float v[2][8];
    if (F.tid < 256) {
#pragma unroll
        for (int bj = 0; bj < 2; ++bj)
#pragma unroll
            for (int j = 0; j < 8; ++j) v[bj][j] = 0.f;
#pragma unroll
        for (int w = 0; w < 8; ++w)
#pragma unroll
            for (int bj = 0; bj < 2; ++bj) { const f32x4 p0 = *(LAS f32x4*)(part + ((w * 64 + rr) * 64 + bj * 32 + 8 * sub)), p1 = *(LAS f32x4*)(part + ((w * 64 + rr) * 64 + bj * 32 + 8 * sub + 4));
                v[bj][0] += p0.x; v[bj][1] += p0.y; v[bj][2] += p0.z; v[bj][3] += p0.w; v[bj][4] += p1.x; v[bj][5] += p1.y; v[bj][6] += p1.z; v[bj][7] += p1.w; }
    }
    if (nsl == 1) {
        if (F.tid < 256) { typename R::Pre p_; r.pre(row0 + rr, colbase, p_); float s = r.tile(row0 + rr, colbase, v, p_); if constexpr (R::HAS_SSQ) { s += __shfl_xor(s, 1); s += __shfl_xor(s, 2); if (sub == 0) __hip_atomic_fetch_add(ssq_dst + (row0 + rr) * SSQ_PAD, s, RLX_AGENT); } }
    } else {
        const int cu = pn * 4 + wc;
        const __amdgpu_buffer_rsrc_t srs = __builtin_amdgcn_make_buffer_rsrc((void*)(F.ws + WS_SLAB), 0, 64 * 8 * 16384, 0x00020000);
        const int sbase = __builtin_amdgcn_readfirstlane(cu * 8 * 16384), tq = (int)(F.tid & 255) * 16;
        unsigned* cnt = (unsigned*)(F.ws + WS_CTL) + CW_TCNT + 16 * cu;
        if (F.tid < 256) {
#pragma unroll
            for (int q = 0; q < 4; ++q) { const f32x4 d = {v[q >> 1][(q & 1) * 4 + 0], v[q >> 1][(q & 1) * 4 + 1], v[q >> 1][(q & 1) * 4 + 2], v[q >> 1][(q & 1) * 4 + 3]};
                __builtin_amdgcn_raw_buffer_store_b128(__builtin_bit_cast(v4u, d), srs, q * 4096 + tq, sbase + slice * 16384, 16); }
        }
        asm volatile("s_waitcnt vmcnt(0)" ::: "memory");
        __syncthreads();
        if (F.tid == 0) { const unsigned old = __hip_atomic_fetch_add(cnt, 1u, RLX_AGENT); F.MISC[20] = (old == (unsigned)(nsl - 1)) ? 1u : 0u; }
        __syncthreads();
        if (F.MISC[20] != 0u) {
            if (F.tid < 256) {
#pragma unroll
                for (int bj = 0; bj < 2; ++bj)
#pragma unroll
                    for (int j = 0; j < 8; ++j) v[bj][j] = 0.f;
#pragma unroll
                for (int s4 = 0; s4 < 8; s4 += 4) {
                    v4u t_[4][4];
                    if (s4 < nsl) {
#pragma unroll
                        for (int q = 0; q < 4; ++q)
#pragma unroll
                            for (int e = 0; e < 4; ++e) t_[q][e] = __builtin_amdgcn_raw_buffer_load_b128(srs, e * 4096 + tq, sbase + (s4 + q) * 16384, 16);
#pragma unroll
                        for (int q = 0; q < 4; ++q)
#pragma unroll
                            for (int e = 0; e < 4; ++e) { const f32x4 d = __builtin_bit_cast(f32x4, t_[q][e]); v[e >> 1][(e & 1) * 4 + 0] += d.x; v[e >> 1][(e & 1) * 4 + 1] += d.y; v[e >> 1][(e & 1) * 4 + 2] += d.z; v[e >> 1][(e & 1) * 4 + 3] += d.w; }
                    }
                }
                if (final_tail) {
                    if constexpr (R::HAS_SSQ) { typename R::Pre p_; r.pre(row0 + rr, colbase, p_); float s = r.resid_inplace(v, p_); s += __shfl_xor(s, 1); s += __shfl_xor(s, 2); if (sub == 0) __hip_atomic_fetch_add(ssq_dst + (row0 + rr) * SSQ_PAD, s, RLX_AGENT); }
                } else {
                typename R::Pre p_; r.pre(row0 + rr, colbase, p_); float s = r.tile(row0 + rr, colbase, v, p_); if constexpr (R::HAS_SSQ) { s += __shfl_xor(s, 1); s += __shfl_xor(s, 2); if (sub == 0) __hip_atomic_fetch_add(ssq_dst + (row0 + rr) * SSQ_PAD, s, RLX_AGENT); }
                }
            }
            if (F.tid == 0) __hip_atomic_store(cnt, 0u, RLX_AGENT);
            if (final_tail) {
                asm volatile("s_waitcnt vmcnt(0)" ::: "memory");
                __syncthreads();
                unsigned* fc = (unsigned*)(F.ws + WS_CTL) + CW_TCNT + 64 * 16;
                if (F.tid == 0) { __hip_atomic_fetch_add(fc, 1u, RLX_AGENT); unsigned sp = 0;
                    while (__hip_atomic_load(fc, RLX_AGENT) < (unsigned)((N / 256) * 4)) { __builtin_amdgcn_s_sleep(1); if (++sp > (1u << 22)) break; } }
                __syncthreads();
                const int row = row0 + rr;
                if (F.tid < 256 && row >= ROW_SAMP && row < ROW_SAMP + 32) {
                    const float rs = rsqrtf(__hip_atomic_load(ssq_dst + row * SSQ_PAD, RLX_AGENT) * (1.f / DM) + EPS);
                    const float* nf = inp(F, I_NFIN) + colbase; float* y = F.out + O_YS + (size_t)(row - ROW_SAMP) * DM + colbase;
#pragma unroll
                    for (int h = 0; h < 2; ++h) { const f32x4 g0 = *(const GAS f32x4*)(nf + 128 * h), g1 = *(const GAS f32x4*)(nf + 128 * h + 4);
                        *(GAS f32x4*)(y + 128 * h) = (f32x4){v[h][0] * rs * g0.x, v[h][1] * rs * g0.y, v[h][2] * rs * g0.z, v[h][3] * rs * g0.w};
                        *(GAS f32x4*)(y + 128 * h + 4) = (f32x4){v[h][4] * rs * g1.x, v[h][5] * rs * g1.y, v[h][6] * rs * g1.z, v[h][7] * rs * g1.w}; }
                }
            }
        }
    }
    __syncthreads();
}
#ifndef MK_REPEAT
#define MK_REPEAT 0
#endif
#ifndef MK_XSYNC
#define MK_XSYNC 0
#endif
constexpr int CW_XS = 32768;
constexpr int CW_PCNT = 8192;
static_assert((CW_PCNT + 64 * 32) * 4 <= (int)CTL_ZERO_BYTES, "ctl counters");
__device__ __forceinline__ void run_gemm_final_main(Frame& F, const bf16* A, const bf16* Bt) {
    pg8::Gemm g{A, Bt, MAIN, DM, FF}; pg8::StaticOrder S; S.init(MAIN, DM, F.G, (int)blockIdx.x);
    EpiFinal E{&F, ssq_ptr(F, 2), (unsigned*)(F.ws + WS_CTL) + CW_PCNT, inp(F, I_NFIN)};
    pg8::gemm_phase<EpiFinal, pg8::StaticOrder, false, true>(F.lds + RING_OFF, g, S, E);
}
template <class R, int PH>
__device__ __forceinline__ void run_gemm(Frame& F, const bf16* A, const bf16* Bt, int N, int K, const R& r, float* ssq_dst, int tail_off, bool skip_main = false, bool final_tail = false) {
    const bool one_unit = (MAIN / 256) * (N / 256) <= F.G;
    if constexpr (FAST_GEMM) if (!skip_main) {
        pg8::Gemm g{A, Bt, MAIN, N, K}; pg8::StaticOrder S; S.init(MAIN, N, F.G, (int)blockIdx.x);
        float* sdum = ssq_ptr(F, 3);
        if constexpr (((MK_REPEAT >> PH) & 1) != 0) { RepOrder RS{S, ((MK_REPEAT >> 15) & 1) ? 2 : 1}; EpiFast<R, 1> E{r, ssq_dst, 0, sdum}; pg8::gemm_phase<EpiFast<R, 1>, RepOrder, true, true>(F.lds + RING_OFF, g, RS, E); }
        else if constexpr (((MK_REPEAT >> (PH + 16)) & 1) != 0) { RepOrder RS{S, 1}; EpiFast<R, 2> E{r, ssq_dst, 0, sdum}; pg8::gemm_phase<EpiFast<R, 2>, RepOrder, true, true>(F.lds + RING_OFF, g, RS, E); }
        else if constexpr (MK_XSYNC != 0 && (PH == 1 || PH == 7 || PH == 3)) {
            const unsigned nloc = F.MISC[8];
            SyncOrder SS{S, (unsigned*)(F.ws + WS_CTL) + CW_XS + (PH == 1 ? 0 : PH == 3 ? 8192 : 16384), nloc ? nloc : 1u, xb_xcc_id(), (MAIN / 256) * (N / 256) / F.G, 0};
            EpiFast<R> E{r, ssq_dst, 0, sdum}; pg8::gemm_phase<EpiFast<R>, SyncOrder, true, true>(F.lds + RING_OFF, g, SS, E); }
        else if constexpr (R::HAS_SSQ) { if (one_unit) { EpiDrain<R> E{r, ssq_dst}; pg8::gemm_phase<EpiDrain<R>, pg8::StaticOrder, false, true>(F.lds + RING_OFF, g, S, E); } }
        else { EpiFast<R> E{r, ssq_dst, 0, sdum}; pg8::gemm_phase<EpiFast<R>, pg8::StaticOrder, true, true>(F.lds + RING_OFF, g, S, E); }
    }
    const int rb0 = (FAST_GEMM && (skip_main || !R::HAS_SSQ || one_unit)) ? MAIN / 64 : 0, nrb = MROWS / 64 - rb0, ncu = (N / 256) * 4, nun = nrb * ncu;
    const int nsl = (FAST_GEMM && tail_off == 0 && rb0 != 0) ? (256 / ncu > 8 ? 8 : 256 / ncu) : 1;
    const int tfirst = tail_off < F.G ? tail_off : 0;
    _Pragma("unroll 1") for (int rep_ = 0; rep_ < ((((MK_REPEAT >> 14) & 1) != 0 && PH != 6) ? 2 : 1); ++rep_)
    if ((int)blockIdx.x >= tfirst) for (int u = (int)blockIdx.x - tfirst; u < nun * nsl; u += F.G - tfirst) {
        const int uu = u / nsl, slice = u % nsl, rb = rb0 + uu / ncu, cu = uu % ncu;
        gemm_simple_unit<R>(F, A, Bt, K, N, rb * 64, cu >> 2, cu & 3, slice, nsl, r, (((MK_REPEAT >> 14) & 1) != 0 && PH != 6 && rep_ == 0) ? ssq_ptr(F, 3) : ssq_dst, final_tail && nsl > 1);
    }
}
namespace dattn {
typedef short bf16x8 __attribute__((ext_vector_type(8)));
typedef short s16x4 __attribute__((ext_vector_type(4)));
typedef float f32x16 __attribute__((ext_vector_type(16)));
typedef float f32x4 __attribute__((ext_vector_type(4)));
typedef unsigned u32x4 __attribute__((ext_vector_type(4)));
constexpr int NW = 8, QBLK = 32, KVBLK = 64, QB = 128, D = 128, PITCH = 1024;
constexpr int SHM_V = KVBLK * D * 2, SHM_K = KVBLK * D * 2;
constexpr int LDS_X = 2 * SHM_V + 2 * SHM_K;
constexpr int LDS_WSF = MISC_OFF + 256;
static_assert(LDS_X + 65536 <= RING_BYTES && LDS_WSF + NW * 512 + 16 <= LDS_BYTES, "attention LDS map");
constexpr float SCALE = 0.125f, THR = 8.f;
constexpr int NSPLIT = 4, OPW = 132;

#define KSWZ(row, colB) ((row) * 256 + ((colB) ^ (((row) & 7) << 4)))
#define SBAR() __builtin_amdgcn_sched_barrier(0)
__device__ __forceinline__ int v_st(int k, int c) { const int kk = (k & ~0xC) | ((k & 4) << 1) | ((k & 8) >> 1); return ((kk >> 3) * 4 + (c >> 5)) * 512 + ((kk & 7) * 32 + (c & 31)) * 2; }
__device__ __forceinline__ int v_rd_base(int lane) { return ((lane & 3) << 3) | (((lane >> 2) & 3) << 6) | (((lane >> 4) & 1) << 5) | (((lane >> 5) & 1) << 8); }
constexpr int v_rd_off(int d0, int ks, int half) { return d0 * 512 + ks * 4096 + half * 2048; }
__device__ __forceinline__ int crow(int r, int hi) { return (r & 3) + 8 * (r >> 2) + 4 * hi; }
__device__ __forceinline__ unsigned cvtpk(float lo, float hi) { unsigned r; asm volatile("v_cvt_pk_bf16_f32 %0, %1, %2" : "=v"(r) : "v"(lo), "v"(hi)); return r; }
__device__ __forceinline__ bf16x8 pack8(f32x4 a, f32x4 b) { u32x4 w = {cvtpk(a[0], a[1]), cvtpk(a[2], a[3]), cvtpk(b[0], b[1]), cvtpk(b[2], b[3])}; return *reinterpret_cast<bf16x8*>(&w); }
__device__ __forceinline__ void mask_tile(f32x16& p0, f32x16& p1, int dq) {
    const float NEG = -__builtin_inff();
#pragma unroll
    for (int r = 0; r < 16; ++r) { const int c = (r & 3) + 8 * (r >> 2); if (dq - c < 0) p0[r] = NEG; if (dq - c - 32 < 0) p1[r] = NEG; }
}
__device__ __forceinline__ void partialSM(f32x16& p0, f32x16& p1, float& m_reg, float& mn, float& alpha, float T0, float T1) {
    float pm0 = p0[0], pm1 = p1[0];
#pragma unroll
    for (int r = 1; r < 16; ++r) { pm0 = fmaxf(pm0, p0[r]); pm1 = fmaxf(pm1, p1[r]); }
    float pmax = fmaxf(pm0 + T0, pm1 + T1);
    { auto rr = __builtin_amdgcn_permlane32_swap(__float_as_uint(pmax), __float_as_uint(pmax), false, false);
      pmax = fmaxf(__uint_as_float(rr[0]), __uint_as_float(rr[1])); }
    constexpr float C2 = 1.4426950408889634f * SCALE;
    if (__builtin_expect(__all((pmax - m_reg) * SCALE <= THR), 1)) { mn = m_reg; alpha = 1.f; }
    else { mn = fmaxf(m_reg, pmax); alpha = __builtin_amdgcn_exp2f((m_reg - mn) * C2); m_reg = mn; }
    const float L0 = (T0 - mn) * C2, L1 = (T1 - mn) * C2;
#pragma unroll
    for (int r = 0; r < 16; ++r) p0[r] = fmaf(p0[r], C2, L0);
#pragma unroll
    for (int r = 0; r < 16; ++r) p1[r] = fmaf(p1[r], C2, L1);
#pragma unroll
    for (int r = 0; r < 16; ++r) p0[r] = __builtin_amdgcn_exp2f(p0[r]);
}
__device__ __forceinline__ void finishSM(f32x16& p0, f32x16& p1, float alpha, float& l_reg, bf16x8& pa0, bf16x8& pa1, bf16x8& pa2, bf16x8& pa3) {
#pragma unroll
    for (int r = 0; r < 16; ++r) p1[r] = __builtin_amdgcn_exp2f(p1[r]);
    float ps = 0;
#pragma unroll
    for (int r = 0; r < 16; ++r) ps += p0[r];
#pragma unroll
    for (int r = 0; r < 16; ++r) ps += p1[r];
    { auto rr = __builtin_amdgcn_permlane32_swap(__float_as_uint(ps), __float_as_uint(ps), false, false);
      ps = __uint_as_float(rr[0]) + __uint_as_float(rr[1]); }
    l_reg = l_reg * alpha + ps;
#define PK4(P, B_, OUT) do { unsigned a0 = cvtpk(P[B_+0], P[B_+1]), a1 = cvtpk(P[B_+2], P[B_+3]);                          \
        unsigned b0 = cvtpk(P[B_+4], P[B_+5]), b1 = cvtpk(P[B_+6], P[B_+7]);                                             \
        auto r0 = __builtin_amdgcn_permlane32_swap(a0, b0, false, false); auto r1 = __builtin_amdgcn_permlane32_swap(a1, b1, false, false); \
        u32x4 w = {r0[0], r1[0], r0[1], r1[1]}; OUT = *reinterpret_cast<bf16x8*>(&w); } while (0)
    PK4(p0, 0, pa0); PK4(p0, 8, pa1); PK4(p1, 0, pa2); PK4(p1, 8, pa3);
#undef PK4
}
template <int KB>
__device__ __forceinline__ void qkt(f32x16& p0, f32x16& p1, const char* K_lds, int r32, int hi, int sub, const bf16x8* qr, const float* cvp_) {
    unsigned cvo = (unsigned)(uintptr_t)cvp_; asm volatile("" : "+v"(cvo));
    const __attribute__((address_space(3))) float* cvp = (const __attribute__((address_space(3))) float*)cvo;
    f32x16 cvec;
#pragma unroll
    for (int q4 = 0; q4 < 4; ++q4) { const f32x4 t = *(const __attribute__((address_space(3))) f32x4*)(cvp + 4 * q4); cvec[4 * q4] = t[0]; cvec[4 * q4 + 1] = t[1]; cvec[4 * q4 + 2] = t[2]; cvec[4 * q4 + 3] = t[3]; }
    const char* kb[4];
#pragma unroll
    for (int dd = 0; dd < 4; ++dd) kb[dd] = K_lds + KB * SHM_K + KSWZ(r32, (dd * 16 + hi * 8) * 2) + sub * 128;
#pragma unroll
    for (int dd = 0; dd < 4; ++dd) {
        bf16x8 b0 = *reinterpret_cast<const bf16x8*>(kb[dd]);
        bf16x8 b1 = *reinterpret_cast<const bf16x8*>(kb[dd] + 32 * 256);
        if (dd == 0) { p0 = __builtin_amdgcn_mfma_f32_32x32x16_bf16(b0, qr[0], cvec, 0, 0, 0); p1 = __builtin_amdgcn_mfma_f32_32x32x16_bf16(b1, qr[0], cvec, 0, 0, 0); }
        else { p0 = __builtin_amdgcn_mfma_f32_32x32x16_bf16(b0, qr[dd], p0, 0, 0, 0); p1 = __builtin_amdgcn_mfma_f32_32x32x16_bf16(b1, qr[dd], p1, 0, 0, 0); } }
}
template <int VB>
__device__ __forceinline__ void pv_tile(f32x16* o, int vb0, bf16x8 pa0, bf16x8 pa1, bf16x8 pa2, bf16x8 pa3) {
#define TRRD(dst, off) asm volatile("ds_read_b64_tr_b16 %0, %1 offset:%2" : "=&v"(dst) : "v"(vb0), "i"(off) : "memory")
#define PV_D0(d0) do { s16x4 l0, l1, l2, l3, h0, h1, h2, h3; constexpr int b_ = VB * SHM_V + v_rd_off(d0, 0, 0); \
        TRRD(l0, b_); TRRD(h0, b_ + 2048); TRRD(l1, b_ + 4096); TRRD(h1, b_ + 6144); TRRD(l2, b_ + 8192); TRRD(h2, b_ + 10240); TRRD(l3, b_ + 12288); TRRD(h3, b_ + 14336); \
        asm volatile("s_waitcnt lgkmcnt(0)" ::: "memory"); SBAR();   \
        o[d0] = __builtin_amdgcn_mfma_f32_32x32x16_bf16(pa0, (bf16x8){l0[0], l0[1], l0[2], l0[3], h0[0], h0[1], h0[2], h0[3]}, o[d0], 0, 0, 0);   \
        o[d0] = __builtin_amdgcn_mfma_f32_32x32x16_bf16(pa1, (bf16x8){l1[0], l1[1], l1[2], l1[3], h1[0], h1[1], h1[2], h1[3]}, o[d0], 0, 0, 0);   \
        o[d0] = __builtin_amdgcn_mfma_f32_32x32x16_bf16(pa2, (bf16x8){l2[0], l2[1], l2[2], l2[3], h2[0], h2[1], h2[2], h2[3]}, o[d0], 0, 0, 0);   \
        o[d0] = __builtin_amdgcn_mfma_f32_32x32x16_bf16(pa3, (bf16x8){l3[0], l3[1], l3[2], l3[3], h3[0], h3[1], h3[2], h3[3]}, o[d0], 0, 0, 0); } while (0)
    PV_D0(0); PV_D0(1); PV_D0(2); PV_D0(3);
#undef PV_D0
#undef TRRD
}

struct Blk { const bf16* Q; const void* K; const void* V; const float* Kn; const float* Vn; const int* pt; void* O; int P0, t0, NT; float A; };
template <bool DEC> __device__ __forceinline__ const void* tile_ptr(const Blk& b, const void* base, const float* nw, int t) {
    const int gt = b.t0 + t;
    if constexpr (!DEC) { return (const bf16*)base + (size_t)gt * KVBLK * PITCH; }
    else { if (gt >= PAST / KVBLK) return nw; const int pg = ((const __attribute__((address_space(4))) int*)(unsigned long long)b.pt)[gt >> 1];   return (const float*)base + ((size_t)pg * PAGE + (gt & 1) * KVBLK) * PITCH; }
}
struct Seam { bf16x8 qr[4]; bf16x8 st_v0, st_v1, st_k0, st_k1; f32x4 sf0, sf1, sf2, sf3; };
#define VMW() asm volatile("s_waitcnt vmcnt(0)" ::: "memory")
#define VMWN(n) asm volatile("s_waitcnt vmcnt(%0)" :: "i"(n) : "memory")
#define ROWH(p, half) ((const bf16*)(p) + (half) * 32 * PITCH + toff)
#define ROWF(p, half) ((const float*)(p) + (half) * 32 * PITCH + toff)
#define SLOAD_H(Kp, Vp) do { S.st_v0 = *(const bf16x8*)ROWH(Vp, 0); S.st_v1 = *(const bf16x8*)ROWH(Vp, 1); S.st_k0 = *(const bf16x8*)ROWH(Kp, 0); S.st_k1 = *(const bf16x8*)ROWH(Kp, 1); } while (0)
#define SWRITE_HK(bf) do { *(bf16x8*)(K_lds + (bf) * SHM_K + kws) = S.st_k0; *(bf16x8*)(K_lds + (bf) * SHM_K + kws + 32 * 256) = S.st_k1; } while (0)
#define SWRITE_HV(bf) do { *(bf16x8*)(V_lds + (bf) * SHM_V + vst0) = S.st_v0; *(bf16x8*)(V_lds + (bf) * SHM_V + vst0 + 8192) = S.st_v1; } while (0)
#define SWRITE_H(bf) do { SWRITE_HV(bf); SWRITE_HK(bf); } while (0)
#define SLOAD_F(p) do { S.sf0 = *(const f32x4*)ROWF(p, 0); S.sf1 = *(const f32x4*)(ROWF(p, 0) + 4); S.sf2 = *(const f32x4*)ROWF(p, 1); S.sf3 = *(const f32x4*)(ROWF(p, 1) + 4); } while (0)
#define SWRITE_KF(bf) do { *(bf16x8*)(K_lds + (bf) * SHM_K + kws) = pack8(S.sf0, S.sf1); *(bf16x8*)(K_lds + (bf) * SHM_K + kws + 32 * 256) = pack8(S.sf2, S.sf3); } while (0)
#define SWRITE_VF(bf) do { *(bf16x8*)(V_lds + (bf) * SHM_V + vst0) = pack8(S.sf0, S.sf1); *(bf16x8*)(V_lds + (bf) * SHM_V + vst0 + 8192) = pack8(S.sf2, S.sf3); } while (0)
#define QLOAD(blk) do { const bf16* q_ = (blk).Q + (unsigned)((DEC ? (r32 & 3) : ((wid & 3) * QBLK + r32)) * PITCH + sub * 64 + hi * 8); \
        _Pragma("unroll") for (int d0 = 0; d0 < 4; ++d0) S.qr[d0] = *(const bf16x8*)(q_ + d0 * 16); } while (0)
template <bool DEC>
__device__ __forceinline__ void attn_prime(const Blk& cur, char* lds, Seam& S) {
    const int tid = threadIdx.x, wid = __builtin_amdgcn_readfirstlane(tid >> 6), lane = tid & 63, r32 = lane & 31, hi = lane >> 5, sub = wid >> 2;
    const int sr = tid >> 4, sc = (tid & 15) * 8, kws = KSWZ(sr, sc * 2); char* K_lds = lds + 2 * SHM_V;
    const unsigned toff = (unsigned)(sr * PITCH + sc);
    QLOAD(cur);
    const void* k0 = tile_ptr<DEC>(cur, cur.K, cur.Kn, 0); const void* v0 = tile_ptr<DEC>(cur, cur.V, cur.Vn, 0);
    if constexpr (DEC) { SLOAD_F(k0); VMW(); SWRITE_KF(0); SBAR(); SLOAD_F(v0); }
    else { SLOAD_H(k0, v0); VMW(); SWRITE_HK(0); }
    __syncthreads();
}
template <bool DEC>
__device__ __forceinline__ void attn_block(const Blk& cur, const Blk& nxt, float lam, const float* gain, char* lds, Seam& S) {
    constexpr bool F32 = DEC;
    const int tid = threadIdx.x, wid = __builtin_amdgcn_readfirstlane(tid >> 6), lane = tid & 63, r32 = lane & 31, hi = lane >> 5, sub = wid >> 2;
    const bool act = DEC ? ((wid & 3) == sub) : true;
    const int NT = cur.NT;
    const int qlo = cur.P0 + (DEC ? 0 : (wid & 3) * QBLK);
    char* V_lds = lds; char* K_lds = lds + 2 * SHM_V;
    float* ws = (float*)(lds + LDS_WSF) + wid * 128; float* li_l = ws, * al_l = ws + 32;
    float m_reg = -1e30f, l_reg = 0; f32x16 o[4] = {};
    const int sr = tid >> 4, sc = (tid & 15) * 8, vst0 = v_st(sr, sc), kws = KSWZ(sr, sc * 2);
    const unsigned toff = (unsigned)(sr * PITCH + sc);
    const int vb0 = (int)(uintptr_t)V_lds + v_rd_base(lane);
    const float A = cur.A;
    const float* cvec = ws + 64 + hi * 16;
    if (r32 < 16) ws[64 + lane - 16 * hi] = A * (float)crow(lane & 15, hi);
    asm volatile("s_waitcnt lgkmcnt(0)" ::: "memory");
#define RESC(a) do { if (__any((a) < 1.f)) { if (hi == 0) al_l[r32] = (a); asm volatile("s_waitcnt lgkmcnt(0)" ::: "memory");              \
                     _Pragma("unroll") for (int d_ = 0; d_ < 4; ++d_) _Pragma("unroll") for (int r = 0; r < 16; ++r) o[d_][r] *= al_l[crow(r, hi)]; } } while (0)
#define KBASE(t) ((cur.t0 + (t)) * KVBLK)
#define KP(t) tile_ptr<DEC>(cur, cur.K, cur.Kn, (t))
#define VP(t) tile_ptr<DEC>(cur, cur.V, cur.Vn, (t))
#define TOFF(t) (A * (float)(KBASE(t) - cur.P0))
#define MASKT(P0_, P1_, t) do { const int kb_ = KBASE(t); if (kb_ + KVBLK - 1 > qlo) { unsigned l_; asm volatile("v_mbcnt_lo_u32_b32 %0, -1, 0\n\tv_mbcnt_hi_u32_b32 %0, -1, %0" : "=v"(l_)); mask_tile(P0_, P1_, qlo + (int)(l_ & 31u) - 4 * (int)(l_ >> 5) - kb_); } } while (0)
#define PSM(P0_, P1_, mnX, alX, t) do { const float t0_ = TOFF(t); partialSM(P0_, P1_, m_reg, mnX, alX, t0_, t0_ + 32.f * A); } while (0)
    constexpr int NQL = 4;
#define SEAM_K0() do { VMWN(NQL); if constexpr (F32) { SWRITE_KF(0); SBAR(); SLOAD_F(nv0); } else { SWRITE_HK(0); } SBAR(); } while (0)
    const void* nk0 = tile_ptr<DEC>(nxt, nxt.K, nxt.Kn, 0); const void* nv0 = tile_ptr<DEC>(nxt, nxt.V, nxt.Vn, 0);
    f32x16 pA0, pA1, pB0, pB1; float mnA, mnB, alA = 1.f, alB = 1.f; bf16x8 pa0, pa1, pa2, pa3;
    if constexpr (F32) { VMW(); SWRITE_VF(0); SBAR(); } else { SWRITE_HV(0); SBAR(); }
    if (NT > 1) { if constexpr (F32) SLOAD_F(KP(1)); else SLOAD_H(KP(1), VP(1)); }
    SBAR(); if (act) qkt<0>(pA0, pA1, K_lds, r32, hi, sub, S.qr, cvec);
    if constexpr (F32) { if (NT > 1) { VMW(); SWRITE_KF(1); SBAR(); SLOAD_F(VP(1)); } }
    if (act) { MASKT(pA0, pA1, 0); PSM(pA0, pA1, mnA, alA, 0); }
    if (NT > 1) { VMW(); if constexpr (F32) { SWRITE_VF(1); SBAR(); if (NT > 2) SLOAD_F(KP(2)); } else SWRITE_H(1); }
    __syncthreads();
#define HALF_STEP(PX0, PX1, mnX, alX, PY0, PY1, alY, t, KB, VB, SB) do {                                                      \
        SBAR(); if (act) qkt<KB>(PX0, PX1, K_lds, r32, hi, sub, S.qr, cvec);                                                   \
        if (act) finishSM(PY0, PY1, alY, l_reg, pa0, pa1, pa2, pa3); SBAR();                                                   \
        if ((t) + 1 < NT) { if constexpr (F32) { VMW(); SWRITE_KF(SB); SBAR(); SLOAD_F(VP((t) + 1)); }                       \
                            else { SLOAD_H(KP((t) + 1), VP((t) + 1)); } SBAR(); }                                             \
        if (act) { pv_tile<VB>(o, vb0, pa0, pa1, pa2, pa3); MASKT(PX0, PX1, (t)); PSM(PX0, PX1, mnX, alX, (t)); }             \
        __syncthreads();                                                                                                      \
        if ((t) + 1 < NT) { VMW(); if constexpr (F32) { SWRITE_VF(SB); SBAR(); if ((t) + 2 < NT) SLOAD_F(KP((t) + 2)); }     \
                            else { SWRITE_H(SB); } }                                                                          \
        if (act) RESC(alX); __syncthreads(); } while (0)
    for (int t = 1; t + 1 < NT; t += 2) {
        HALF_STEP(pB0, pB1, mnB, alB, pA0, pA1, alA, t, 1, 0, 0);
        HALF_STEP(pA0, pA1, mnA, alA, pB0, pB1, alB, t + 1, 0, 1, 1);
    }
    const bool even = (NT & 1) == 0;
    if (even) { SBAR(); if (act) qkt<1>(pB0, pB1, K_lds, r32, hi, sub, S.qr, cvec); SBAR(); }
    if constexpr (F32) { SLOAD_F(nk0); SBAR(); } else { SLOAD_H(nk0, nv0); SBAR(); }
    QLOAD(nxt);
    SBAR();
    if (act) finishSM(pA0, pA1, alA, l_reg, pa0, pa1, pa2, pa3);
    SBAR();
    if (act) pv_tile<0>(o, vb0, pa0, pa1, pa2, pa3);
    if (even) { if (act) { MASKT(pB0, pB1, NT - 1); PSM(pB0, pB1, mnB, alB, NT - 1); } __syncthreads(); if (act) { RESC(alB);
        finishSM(pB0, pB1, alB, l_reg, pa0, pa1, pa2, pa3); SBAR(); pv_tile<1>(o, vb0, pa0, pa1, pa2, pa3); } }
    SBAR(); SEAM_K0();
    if (act && hi == 0) li_l[r32] = l_reg;
    asm volatile("s_waitcnt lgkmcnt(0)" ::: "memory");
    if constexpr (DEC) {
        if (act) {
            float* op = (float*)cur.O + (size_t)sub * 4 * OPW;
            if (hi == 0) {
#pragma unroll
                for (int r = 0; r < 4; ++r)
#pragma unroll
                    for (int d0 = 0; d0 < 4; ++d0) op[(unsigned)(r * OPW + d0 * 32 + r32)] = o[d0][r];
                if (r32 < 4) { op[(unsigned)(r32 * OPW + 128)] = m_reg; op[(unsigned)(r32 * OPW + 129)] = l_reg; }
            }
        }
        __syncthreads();
    } else {
        int lane_o = lane; asm volatile("" : "+v"(lane_o));
        float rli[16];
#pragma unroll
        for (int r = 0; r < 16; ++r) rli[r] = __builtin_amdgcn_rcpf(li_l[crow(r, hi)]);
        float* X = (float*)(lds + LDS_X) + (wid & 3) * 4096 + lane_o;
        if (sub == 1) {
#pragma unroll
            for (int d0 = 0; d0 < 4; ++d0)
#pragma unroll
                for (int r = 0; r < 16; ++r) X[(d0 * 16 + r) * 64] = lam * (o[d0][r] * rli[r]);
        }
        __syncthreads();
        if (sub == 0) {
            float ssr[16];
#pragma unroll
            for (int r = 0; r < 16; ++r) { float s = 0.f;
#pragma unroll
                for (int d0 = 0; d0 < 4; ++d0) { const float x = o[d0][r] * rli[r] - X[(d0 * 16 + r) * 64]; o[d0][r] = x; s += x * x; }
                ssr[r] = s; }
#pragma unroll
            for (int r = 0; r < 16; ++r) {
#pragma unroll
                for (int off = 1; off < 32; off <<= 1) ssr[r] += __shfl_xor(ssr[r], off); }
            float g[4];
#pragma unroll
            for (int d0 = 0; d0 < 4; ++d0) g[d0] = gain[d0 * 32 + (lane_o & 31)] * 0.8f;
            const int r32o = lane_o & 31, hio = lane_o >> 5;
            char* Ow = (char*)cur.O + (unsigned)((((wid & 3) * QBLK + 4 * hio) * DM + r32o) * 2);
#pragma unroll
            for (int r = 0; r < 16; ++r) { const int orow = (r & 3) + 8 * (r >> 2); const float rn = rsqrtf(ssr[r] * (1.f / D) + EPS);
#pragma unroll
                for (int d0 = 0; d0 < 4; ++d0) { const float v = o[d0][r] * rn * g[d0]; const float vn = __shfl_xor(v, 1);
                    if ((r32 & 1) == 0) *(unsigned*)(Ow + (orow * DM + d0 * 32) * 2) = cvtpk(v, vn); } }
        }
        __syncthreads();
    }
#undef RESC
#undef KBASE
#undef KP
#undef VP
#undef TOFF
#undef MASKT
#undef PSM
#undef SEAM_K0
#undef HALF_STEP
}
struct DmaOff { unsigned k0, k1, v0, v1; };
__device__ __forceinline__ DmaOff dma_off(int wid, int lane) {
    DmaOff d; unsigned ko[2], vo[2];
#pragma unroll
    for (int i = 0; i < 2; ++i) {
        const int row = (2 * wid + i) * 4 + (lane >> 4), colB = ((lane & 15) * 16) ^ ((row & 7) << 4);
        ko[i] = (unsigned)(row * PITCH + (colB >> 1));
        const int bk = (2 * wid + i) * 2 + (lane >> 5), kk = (bk >> 2) * 8 + ((lane & 31) >> 2), c = (bk & 3) * 32 + (lane & 3) * 8, k = (kk & ~0xC) | ((kk & 4) << 1) | ((kk & 8) >> 1);
        vo[i] = (unsigned)(k * PITCH + c); }
    d.k0 = ko[0]; d.k1 = ko[1]; d.v0 = vo[0]; d.v1 = vo[1]; return d;
}
#define DMA16(gp, lp) __builtin_amdgcn_global_load_lds((const unsigned*)(gp), (__attribute__((address_space(3))) unsigned*)(unsigned)(uintptr_t)(lp), 16, 0, 0)
#define DMA_K(Kp, bf) do { DMA16((const bf16*)(Kp) + dof.k0, K_lds + (bf) * SHM_K + wid * 2048); DMA16((const bf16*)(Kp) + dof.k1, K_lds + (bf) * SHM_K + wid * 2048 + 1024); } while (0)
#define DMA_V(Vp, bf) do { DMA16((const bf16*)(Vp) + dof.v0, V_lds + (bf) * SHM_V + wid * 2048); DMA16((const bf16*)(Vp) + dof.v1, V_lds + (bf) * SHM_V + wid * 2048 + 1024); } while (0)
__device__ __forceinline__ void attn_prime_p(const Blk& cur, char* lds, Seam& S) {
    constexpr bool DEC = false;
    const int tid = threadIdx.x, wid = __builtin_amdgcn_readfirstlane(tid >> 6), lane = tid & 63, r32 = lane & 31, hi = lane >> 5, sub = wid >> 2;
    char* V_lds = lds; char* K_lds = lds + 2 * SHM_V;
    const DmaOff dof = dma_off(wid, lane);
    QLOAD(cur);
    DMA_K(tile_ptr<false>(cur, cur.K, cur.Kn, 0), 0); DMA_V(tile_ptr<false>(cur, cur.V, cur.Vn, 0), 0);
}
__device__ __forceinline__ void attn_block_p(const Blk& cur, const Blk& nxt, float lam, const float* gain, char* lds, Seam& S) {
    constexpr bool DEC = false;
    const int tid = threadIdx.x, wid = __builtin_amdgcn_readfirstlane(tid >> 6), lane = tid & 63, r32 = lane & 31, hi = lane >> 5, sub = wid >> 2;
    constexpr bool act = true;
    const int NT = cur.NT;
    const int qlo = cur.P0 + (DEC ? 0 : (wid & 3) * QBLK);
    char* V_lds = lds; char* K_lds = lds + 2 * SHM_V;
    float* ws = (float*)(lds + LDS_WSF) + wid * 128; float* li_l = ws, * al_l = ws + 32;
    float m_reg = -1e30f, l_reg = 0; f32x16 o[4] = {};
    const DmaOff dof = dma_off(wid, lane);
    const int vb0 = (int)(uintptr_t)V_lds + v_rd_base(lane);
    const float A = cur.A;
    const float* cvec = ws + 64 + hi * 16;
    if (r32 < 16) ws[64 + lane - 16 * hi] = A * (float)crow(lane & 15, hi);
    asm volatile("s_waitcnt lgkmcnt(0)" ::: "memory");
#define RESC(a) do { if (__any((a) < 1.f)) { if (hi == 0) al_l[r32] = (a); asm volatile("s_waitcnt lgkmcnt(0)" ::: "memory");              \
                     _Pragma("unroll") for (int d_ = 0; d_ < 4; ++d_) _Pragma("unroll") for (int r = 0; r < 16; ++r) o[d_][r] *= al_l[crow(r, hi)]; } } while (0)
#define KBASE(t) ((cur.t0 + (t)) * KVBLK)
#define KP(t) tile_ptr<DEC>(cur, cur.K, cur.Kn, (t))
#define VP(t) tile_ptr<DEC>(cur, cur.V, cur.Vn, (t))
#define TOFF(t) (A * (float)(KBASE(t) - cur.P0))
#define MASKT(P0_, P1_, t) do { const int kb_ = KBASE(t); if (kb_ + KVBLK - 1 > qlo) { unsigned l_; asm volatile("v_mbcnt_lo_u32_b32 %0, -1, 0\n\tv_mbcnt_hi_u32_b32 %0, -1, %0" : "=v"(l_)); mask_tile(P0_, P1_, qlo + (int)(l_ & 31u) - 4 * (int)(l_ >> 5) - kb_); } } while (0)
#define PSM(P0_, P1_, mnX, alX, t) do { const float t0_ = TOFF(t); partialSM(P0_, P1_, m_reg, mnX, alX, t0_, t0_ + 32.f * A); } while (0)
    const void* nk0 = tile_ptr<DEC>(nxt, nxt.K, nxt.Kn, 0); const void* nv0 = tile_ptr<DEC>(nxt, nxt.V, nxt.Vn, 0);
    f32x16 pA0, pA1, pB0, pB1; float mnA, mnB, alA = 1.f, alB = 1.f; bf16x8 pa0, pa1, pa2, pa3;
    VMW(); __syncthreads();
    if (NT > 1) { DMA_K(KP(1), 1); DMA_V(VP(1), 1); }
    SBAR(); qkt<0>(pA0, pA1, K_lds, r32, hi, sub, S.qr, cvec);
    MASKT(pA0, pA1, 0); PSM(pA0, pA1, mnA, alA, 0);
    if (NT > 1) VMW();
    __syncthreads();
#define HALF_STEP(PX0, PX1, mnX, alX, PY0, PY1, alY, t, KB, VB, SB) do {                                                      \
        SBAR(); if ((t) + 1 < NT) { DMA_K(KP((t) + 1), SB); SBAR(); }                                                          \
        qkt<KB>(PX0, PX1, K_lds, r32, hi, sub, S.qr, cvec);                                                                    \
        finishSM(PY0, PY1, alY, l_reg, pa0, pa1, pa2, pa3); SBAR();                                                            \
        pv_tile<VB>(o, vb0, pa0, pa1, pa2, pa3); MASKT(PX0, PX1, (t)); PSM(PX0, PX1, mnX, alX, (t));                           \
        __syncthreads();                                                                                                      \
        if ((t) + 1 < NT) { DMA_V(VP((t) + 1), SB); SBAR(); }                                                                  \
        RESC(alX);                                                                                                            \
        if ((t) + 1 < NT) VMWN(2); else VMW();                                                                                 \
        __syncthreads(); } while (0)
    for (int t = 1; t + 1 < NT; t += 2) {
        HALF_STEP(pB0, pB1, mnB, alB, pA0, pA1, alA, t, 1, 0, 0);
        HALF_STEP(pA0, pA1, mnA, alA, pB0, pB1, alB, t + 1, 0, 1, 1);
    }
    const bool even = (NT & 1) == 0;
    if (even) { SBAR(); qkt<1>(pB0, pB1, K_lds, r32, hi, sub, S.qr, cvec); SBAR(); }
    QLOAD(nxt);
    SBAR();
    finishSM(pA0, pA1, alA, l_reg, pa0, pa1, pa2, pa3);
    SBAR();
    pv_tile<0>(o, vb0, pa0, pa1, pa2, pa3);
    if (even) { MASKT(pB0, pB1, NT - 1); PSM(pB0, pB1, mnB, alB, NT - 1); }
    VMW(); __syncthreads();
    DMA_K(nk0, 0); DMA_V(nv0, 0); SBAR();
    if (even) { RESC(alB); finishSM(pB0, pB1, alB, l_reg, pa0, pa1, pa2, pa3); SBAR(); pv_tile<1>(o, vb0, pa0, pa1, pa2, pa3); }
    SBAR();
    if (hi == 0) li_l[r32] = l_reg;
    asm volatile("s_waitcnt lgkmcnt(0)" ::: "memory");
    if constexpr (DEC) {
        if (act) {
            float* op = (float*)cur.O + (size_t)sub * 4 * OPW;
            if (hi == 0) {
#pragma unroll
                for (int r = 0; r < 4; ++r)
#pragma unroll
                    for (int d0 = 0; d0 < 4; ++d0) op[(unsigned)(r * OPW + d0 * 32 + r32)] = o[d0][r];
                if (r32 < 4) { op[(unsigned)(r32 * OPW + 128)] = m_reg; op[(unsigned)(r32 * OPW + 129)] = l_reg; }
            }
        }
        __syncthreads();
    } else {
        int lane_o = lane; asm volatile("" : "+v"(lane_o));
        float rli[16];
#pragma unroll
        for (int r = 0; r < 16; ++r) rli[r] = __builtin_amdgcn_rcpf(li_l[crow(r, hi)]);
        float* X = (float*)(lds + LDS_X) + (wid & 3) * 4096 + lane_o;
        if (sub == 1) {
#pragma unroll
            for (int d0 = 0; d0 < 4; ++d0)
#pragma unroll
                for (int r = 0; r < 16; ++r) X[(d0 * 16 + r) * 64] = lam * (o[d0][r] * rli[r]);
        }
        __syncthreads();
        if (sub == 0) {
            float ssr[16];
#pragma unroll
            for (int r = 0; r < 16; ++r) { float s = 0.f;
#pragma unroll
                for (int d0 = 0; d0 < 4; ++d0) { const float x = o[d0][r] * rli[r] - X[(d0 * 16 + r) * 64]; o[d0][r] = x; s += x * x; }
                ssr[r] = s; }
#pragma unroll
            for (int r = 0; r < 16; ++r) {
#pragma unroll
                for (int off = 1; off < 32; off <<= 1) ssr[r] += __shfl_xor(ssr[r], off); }
            float g[4];
#pragma unroll
            for (int d0 = 0; d0 < 4; ++d0) g[d0] = gain[d0 * 32 + (lane_o & 31)] * 0.8f;
            const int r32o = lane_o & 31, hio = lane_o >> 5;
            char* Ow = (char*)cur.O + (unsigned)((((wid & 3) * QBLK + 4 * hio) * DM + r32o) * 2);
#pragma unroll
            for (int r = 0; r < 16; ++r) { const int orow = (r & 3) + 8 * (r >> 2); const float rn = rsqrtf(ssr[r] * (1.f / D) + EPS);
#pragma unroll
                for (int d0 = 0; d0 < 4; ++d0) { const float v = o[d0][r] * rn * g[d0]; const float vn = __shfl_xor(v, 1);
                    if ((r32 & 1) == 0) *(unsigned*)(Ow + (orow * DM + d0 * 32) * 2) = cvtpk(v, vn); } }
        }
        __syncthreads();
    }
#undef RESC
#undef KBASE
#undef KP
#undef VP
#undef TOFF
#undef MASKT
#undef PSM
#undef HALF_STEP
}
#undef DMA16
#undef DMA_K
#undef DMA_V

struct StageF { f32x4 k0, k1, k2, k3, v0, v1, v2, v3; };
#define DLOAD(R, Kp, Vp) do { const float* k_ = ROWF(Kp, 0); const float* k2_ = ROWF(Kp, 1); const float* v_ = ROWF(Vp, 0); const float* v2_ = ROWF(Vp, 1); \
        R.k0 = *(const f32x4*)k_; R.k1 = *(const f32x4*)(k_ + 4); R.k2 = *(const f32x4*)k2_; R.k3 = *(const f32x4*)(k2_ + 4); \
        R.v0 = *(const f32x4*)v_; R.v1 = *(const f32x4*)(v_ + 4); R.v2 = *(const f32x4*)v2_; R.v3 = *(const f32x4*)(v2_ + 4); } while (0)
#define DWRITE(R, bf) do { *(bf16x8*)(K_lds + (bf) * SHM_K + kws) = pack8(R.k0, R.k1); *(bf16x8*)(K_lds + (bf) * SHM_K + kws + 32 * 256) = pack8(R.k2, R.k3); \
        *(bf16x8*)(V_lds + (bf) * SHM_V + vst0) = pack8(R.v0, R.v1); *(bf16x8*)(V_lds + (bf) * SHM_V + vst1) = pack8(R.v2, R.v3); } while (0)
template <int KB>
__device__ __forceinline__ void qkt_half(f32x16& p, const char* K_lds, int r32, int hi, int sub, int half, const bf16x8* qr, const float* cvp_) {
    unsigned cvo = (unsigned)(uintptr_t)cvp_; asm volatile("" : "+v"(cvo));
    const __attribute__((address_space(3))) float* cvp = (const __attribute__((address_space(3))) float*)cvo;
    f32x16 cvec;
#pragma unroll
    for (int q4 = 0; q4 < 4; ++q4) { const f32x4 t = *(const __attribute__((address_space(3))) f32x4*)(cvp + 4 * q4); cvec[4 * q4] = t[0]; cvec[4 * q4 + 1] = t[1]; cvec[4 * q4 + 2] = t[2]; cvec[4 * q4 + 3] = t[3]; }
    const char* kb[4];
#pragma unroll
    for (int dd = 0; dd < 4; ++dd) kb[dd] = K_lds + KB * SHM_K + KSWZ(r32, (dd * 16 + hi * 8) * 2) + sub * 128 + half * (32 * 256);
#pragma unroll
    for (int dd = 0; dd < 4; ++dd) { bf16x8 b0 = *reinterpret_cast<const bf16x8*>(kb[dd]);
        if (dd == 0) p = __builtin_amdgcn_mfma_f32_32x32x16_bf16(b0, qr[0], cvec, 0, 0, 0); else p = __builtin_amdgcn_mfma_f32_32x32x16_bf16(b0, qr[dd], p, 0, 0, 0); }
}
__device__ __forceinline__ void softmax_half(f32x16& p, float& m_reg, float& alpha, float& l_reg, float T, bf16x8& pa0, bf16x8& pa1) {
    float pm = p[0];
#pragma unroll
    for (int r = 1; r < 16; ++r) pm = fmaxf(pm, p[r]);
    float pmax = pm + T;
    { auto rr = __builtin_amdgcn_permlane32_swap(__float_as_uint(pmax), __float_as_uint(pmax), false, false);
      pmax = fmaxf(__uint_as_float(rr[0]), __uint_as_float(rr[1])); }
    constexpr float C2 = 1.4426950408889634f * SCALE;
    float mn;
    if (__builtin_expect(__all((pmax - m_reg) * SCALE <= THR), 1)) { mn = m_reg; alpha = 1.f; }
    else { mn = fmaxf(m_reg, pmax); alpha = __builtin_amdgcn_exp2f((m_reg - mn) * C2); m_reg = mn; }
    const float L = (T - mn) * C2;
    float ps = 0.f;
#pragma unroll
    for (int r = 0; r < 16; ++r) { p[r] = __builtin_amdgcn_exp2f(fmaf(p[r], C2, L)); ps += p[r]; }
    { auto rr = __builtin_amdgcn_permlane32_swap(__float_as_uint(ps), __float_as_uint(ps), false, false);
      ps = __uint_as_float(rr[0]) + __uint_as_float(rr[1]); }
    l_reg = l_reg * alpha + ps;
#define PK4(P, B_, OUT) do { unsigned a0 = cvtpk(P[B_+0], P[B_+1]), a1 = cvtpk(P[B_+2], P[B_+3]);                          \
        unsigned b0 = cvtpk(P[B_+4], P[B_+5]), b1 = cvtpk(P[B_+6], P[B_+7]);                                             \
        auto r0 = __builtin_amdgcn_permlane32_swap(a0, b0, false, false); auto r1 = __builtin_amdgcn_permlane32_swap(a1, b1, false, false); \
        u32x4 w = {r0[0], r1[0], r0[1], r1[1]}; OUT = *reinterpret_cast<bf16x8*>(&w); } while (0)
    PK4(p, 0, pa0); PK4(p, 8, pa1);
#undef PK4
}
template <int VB>
__device__ __forceinline__ void pv_half(f32x16* o, int vbh  , bf16x8 pa0, bf16x8 pa1) {
#define TRRD(dst, off) asm volatile("ds_read_b64_tr_b16 %0, %1 offset:%2" : "=&v"(dst) : "v"(vbh), "i"(off) : "memory")
    s16x4 l0[4], h0[4], l1[4], h1[4];
#define PV_RD(d0) do { constexpr int b_ = VB * SHM_V + v_rd_off(d0, 0, 0); TRRD(l0[d0], b_); TRRD(h0[d0], b_ + 2048); TRRD(l1[d0], b_ + 4096); TRRD(h1[d0], b_ + 6144); } while (0)
#define PV_MM(d0, PA, L_, H_) o[d0] = __builtin_amdgcn_mfma_f32_32x32x16_bf16(PA, (bf16x8){L_[d0][0], L_[d0][1], L_[d0][2], L_[d0][3], H_[d0][0], H_[d0][1], H_[d0][2], H_[d0][3]}, o[d0], 0, 0, 0)
    PV_RD(0); PV_RD(1); PV_RD(2); PV_RD(3);
    asm volatile("s_waitcnt lgkmcnt(8)" ::: "memory"); SBAR();
    PV_MM(0, pa0, l0, h0); PV_MM(1, pa0, l0, h0); PV_MM(0, pa1, l1, h1); PV_MM(1, pa1, l1, h1);
    asm volatile("s_waitcnt lgkmcnt(0)" ::: "memory"); SBAR();
    PV_MM(2, pa0, l0, h0); PV_MM(3, pa0, l0, h0); PV_MM(2, pa1, l1, h1); PV_MM(3, pa1, l1, h1);
#undef PV_RD
#undef PV_MM
#undef TRRD
}
struct DecFin { unsigned* cnt; const float* pbase; bf16* dst; const float* gain; float lam; };
__device__ __forceinline__ void dec_unit(const Blk& cur, char* lds, const DecFin& fin) {
    constexpr bool DEC = true;
    const int tid = threadIdx.x, wid = __builtin_amdgcn_readfirstlane(tid >> 6), lane = tid & 63, r32 = lane & 31, hi = lane >> 5, sub = wid >> 2, half = wid & 1;
    const bool act = sub == 0 ? (wid & 3) < 2 : (wid & 3) >= 2;
    const int NT = cur.NT;
    const int qlo = cur.P0, qm = qlo + r32 - 4 * hi - 32 * half;
    char* V_lds = lds; char* K_lds = lds + 2 * SHM_V;
    float* ws = (float*)(lds + LDS_WSF) + wid * 128; float* al_l = ws + 32;
    float m_reg = -1e30f, l_reg = 0; f32x16 o[4] = {};
    const int sr = tid >> 4, sc = (tid & 15) * 8, vst0 = v_st(sr, sc), vst1 = v_st(32 + sr, sc), kws = KSWZ(sr, sc * 2);
    const unsigned toff = (unsigned)(sr * PITCH + sc);
    const int vbh = (int)(uintptr_t)V_lds + v_rd_base(lane) + half * 8192;
    const float A = cur.A;
    const float* cvec = ws + 64 + hi * 16;
    if (r32 < 16) ws[64 + lane - 16 * hi] = A * (float)crow(lane & 15, hi);
    asm volatile("s_waitcnt lgkmcnt(0)" ::: "memory");
    Seam S; QLOAD(cur);
    StageF RA, RB;
#define KP(t) tile_ptr<true>(cur, cur.K, cur.Kn, (t))
#define VP(t) tile_ptr<true>(cur, cur.V, cur.Vn, (t))
#define KBASE(t) ((cur.t0 + (t)) * KVBLK)
#define PGE(t) (((const __attribute__((address_space(4))) int*)(unsigned long long)cur.pt)[((cur.t0 + (t)) >> 1) < NPAGE ? ((cur.t0 + (t)) >> 1) : NPAGE - 1])
#define PGK(pg, t) ((cur.t0 + (t)) >= PAST / KVBLK ? cur.Kn : (const float*)cur.K + ((size_t)(pg) * PAGE + ((cur.t0 + (t)) & 1) * KVBLK) * PITCH)
#define PGV(pg, t) ((cur.t0 + (t)) >= PAST / KVBLK ? cur.Vn : (const float*)cur.V + ((size_t)(pg) * PAGE + ((cur.t0 + (t)) & 1) * KVBLK) * PITCH)
#define COMPUTE(BUF, t) do { f32x16 p; float al; bf16x8 pa0, pa1; \
        qkt_half<BUF>(p, K_lds, r32, hi, sub, half, S.qr, cvec); \
        const int kb_ = KBASE(t); \
        if (kb_ + KVBLK - 1 > qlo) { const float NEG = -__builtin_inff(); _Pragma("unroll") for (int r = 0; r < 16; ++r) { const int c = (r & 3) + 8 * (r >> 2); if (qm - kb_ - c < 0) p[r] = NEG; } } \
        softmax_half(p, m_reg, al, l_reg, A * (float)(kb_ + 32 * half - cur.P0), pa0, pa1); \
        if (__any(al < 1.f)) { if (hi == 0) al_l[r32] = al; asm volatile("s_waitcnt lgkmcnt(0)" ::: "memory"); \
            _Pragma("unroll") for (int d_ = 0; d_ < 4; ++d_) _Pragma("unroll") for (int r = 0; r < 16; ++r) o[d_][r] *= al_l[crow(r, hi)]; } \
        SBAR(); pv_half<BUF>(o, vbh, pa0, pa1); } while (0)
    DLOAD(RA, KP(0), VP(0)); if (NT > 1) DLOAD(RB, KP(1), VP(1));
    SBAR(); DWRITE(RA, 0); SBAR(); if (NT > 2) DLOAD(RA, KP(2), VP(2));
    __syncthreads();
    int t = 0;
#pragma unroll 1
    for (; t + 4 < NT; t += 2) {
        const int pg3 = PGE(t + 3), pg4 = PGE(t + 4); SBAR();
        if (act) COMPUTE(0, t);
        SBAR(); DWRITE(RB, 1); SBAR(); DLOAD(RB, PGK(pg3, t + 3), PGV(pg3, t + 3));
        __syncthreads();
        if (act) COMPUTE(1, t + 1);
        SBAR(); DWRITE(RA, 0); SBAR(); DLOAD(RA, PGK(pg4, t + 4), PGV(pg4, t + 4));
        __syncthreads();
    }
#pragma unroll 1
    for (; t < NT; t += 2) {
        if (act) COMPUTE(0, t);
        SBAR();
        if (t + 1 < NT) { DWRITE(RB, 1); SBAR(); if (t + 3 < NT) DLOAD(RB, KP(t + 3), VP(t + 3)); }
        __syncthreads();
        if (t + 1 < NT) {
            if (act) COMPUTE(1, t + 1);
            SBAR();
            if (t + 2 < NT) { DWRITE(RA, 0); SBAR(); if (t + 4 < NT) DLOAD(RA, KP(t + 4), VP(t + 4)); }
            __syncthreads();
        }
    }
    if (act && hi == 0) {
        float* op = (float*)cur.O + (size_t)(half * 2 + sub) * 4 * OPW;
#pragma unroll
        for (int r = 0; r < 4; ++r)
#pragma unroll
            for (int d0 = 0; d0 < 4; ++d0) __hip_atomic_store(op + (unsigned)(r * OPW + d0 * 32 + r32), o[d0][r], RLX_AGENT);
        if (r32 < 4) { __hip_atomic_store(op + (unsigned)(r32 * OPW + 128), m_reg, RLX_AGENT); __hip_atomic_store(op + (unsigned)(r32 * OPW + 129), l_reg, RLX_AGENT); }
    }
    asm volatile("s_waitcnt vmcnt(0)" ::: "memory");
    __syncthreads();
    volatile __attribute__((address_space(3))) unsigned* flag = (volatile __attribute__((address_space(3))) unsigned*)(unsigned)(uintptr_t)(lds + LDS_WSF + NW * 512);
    if (tid == 0) { const unsigned old = __hip_atomic_fetch_add(fin.cnt, 1u, RLX_AGENT); *flag = (old == (unsigned)(NSPLIT - 1)) ? 1u : 0u; }
    __syncthreads();
    if (*flag != 0u && wid < 4) {
        constexpr float C2 = 1.4426950408889634f * SCALE; constexpr int NS = 2 * NSPLIT, SET = 2 * 4 * OPW;
        const int q = wid; float res0 = 0.f, res1 = 0.f;
#pragma unroll
        for (int sb = 0; sb < 2; ++sb) {
            const float* op = fin.pbase + (size_t)(sb * 4 + q) * OPW;
            float mm[NS], ll[NS], x0[NS], x1[NS];
#pragma unroll
            for (int s = 0; s < NS; ++s) { mm[s] = __hip_atomic_load(op + (size_t)s * SET + 128, RLX_AGENT); ll[s] = __hip_atomic_load(op + (size_t)s * SET + 129, RLX_AGENT);
                x0[s] = __hip_atomic_load(op + (size_t)s * SET + lane, RLX_AGENT); x1[s] = __hip_atomic_load(op + (size_t)s * SET + 64 + lane, RLX_AGENT); }
            float M = -1e30f;
#pragma unroll
            for (int s = 0; s < NS; ++s) M = fmaxf(M, mm[s]);
            float L = 0.f, a0 = 0.f, a1 = 0.f;
#pragma unroll
            for (int s = 0; s < NS; ++s) { const float w = __builtin_amdgcn_exp2f((mm[s] - M) * C2); L += w * ll[s]; a0 += w * x0[s]; a1 += w * x1[s]; }
            const float il = 1.f / L;
            if (sb == 0) { res0 = a0 * il; res1 = a1 * il; } else { res0 -= fin.lam * a0 * il; res1 -= fin.lam * a1 * il; }
        }
        float ss = res0 * res0 + res1 * res1;
#pragma unroll
        for (int off = 1; off < 64; off <<= 1) ss += __shfl_xor(ss, off);
        const float rn = rsqrtf(ss * (1.f / D) + EPS) * 0.8f;
        bf16* dst = fin.dst + (size_t)q * DM;
        dst[lane] = (bf16)(cvtpk(res0 * rn * fin.gain[lane], 0.f) & 0xffffu); dst[64 + lane] = (bf16)(cvtpk(res1 * rn * fin.gain[64 + lane], 0.f) & 0xffffu);
    }
    __syncthreads();
#undef KP
#undef VP
#undef KBASE
#undef PGE
#undef PGK
#undef PGV
#undef COMPUTE
}
#undef DLOAD
#undef DWRITE
#undef VMW
#undef VMWN
#undef ROWH
#undef ROWF
#undef SLOAD_H
#undef SWRITE_HK
#undef SWRITE_HV
#undef SWRITE_H
#undef SLOAD_F
#undef SWRITE_KF
#undef SWRITE_VF
#undef QLOAD
#undef KSWZ
#undef SBAR
}

__device__ __forceinline__ dattn::Blk prompt_blk(Frame& F, int bh, int qb) {
    const int b = bh >> 3, h = bh & 7; dattn::Blk k;
    k.Q = WSP(bf16, WS_Q) + ((size_t)b * SEQ + (size_t)qb * dattn::QB) * 1024 + h * HD;
    k.K = WSP(bf16, WS_KB) + (size_t)b * SKP * 1024 + h * HD; k.V = WSP(bf16, WS_VB) + (size_t)b * SKP * 1024 + h * HD;
    k.Kn = nullptr; k.Vn = nullptr; k.pt = nullptr;
    k.O = WSP(bf16, WS_CAT) + ((size_t)b * SEQ + (size_t)qb * dattn::QB) * DM + AW + h * HD;
    k.P0 = NMETA + qb * dattn::QB; k.t0 = 0; k.NT = (k.P0 + dattn::QB - 1) / 64 + 1; k.A = 8.f * exp2f(-(float)(h + 1));
    return k;
}
__device__ __forceinline__ dattn::Blk decode_blk(Frame& F, int bh, int split) {
    const int b = bh >> 3, h = bh & 7; dattn::Blk k;
    k.Q = WSP(bf16, WS_QS) + (size_t)(b * 4) * 1024 + h * HD;
    k.K = inp(F, I_CK) + h * HD; k.V = inp(F, I_CV) + h * HD;
    k.Kn = WSP(float, WS_KS) + (size_t)b * 64 * 1024 + h * HD; k.Vn = WSP(float, WS_VS) + (size_t)b * 64 * 1024 + h * HD;
    k.pt = (const int*)inp(F, I_PT) + b * NPAGE;
    k.O = WSP(float, WS_OPART) + (size_t)(bh * dattn::NSPLIT + split) * 2 * (2 * 4 * dattn::OPW);
    k.P0 = PAST; k.t0 = split * (PAST / 64 / dattn::NSPLIT); k.NT = PAST / 64 / dattn::NSPLIT + (split == dattn::NSPLIT - 1 ? 1 : 0); k.A = 8.f * exp2f(-(float)(h + 1));
    return k;
}
template <bool DO_DEC, bool DO_PROMPT> __device__ __forceinline__ void attn_fast_phase(Frame& F) {
    const float lam = lam_get(F);
    const float* gain = inp(F, I_SUBLN);
    char* lds = (char*)F.lds;
    dattn::Seam S;
    const int rsel = F.vcu & 15;
    const int role = (int)((MK_ROLES >> (2 * rsel)) & 3u);
    const bool lfirst = ((MK_LFIRST >> rsel) & 1u) != 0;
#pragma unroll 1
    for (int slot = 0; slot < 3; ++slot) {
        const bool do_dec = slot == (role == 0 ? 0 : 1);
        if (do_dec) {
            if constexpr (DO_DEC) for (int u = F.vcu; u < DB * NH * dattn::NSPLIT; u += F.G) {
                const int bh = u / dattn::NSPLIT;
                const dattn::Blk cur = decode_blk(F, bh, u % dattn::NSPLIT);
                const dattn::DecFin fin{(unsigned*)(F.ws + WS_CTL) + CW_DCNT + 16 * bh, WSP(float, WS_OPART) + (size_t)(bh * dattn::NSPLIT * 2) * (2 * 4 * dattn::OPW),
                                        WSP(bf16, WS_CAT) + (size_t)(ROW_SAMP + (bh >> 3) * 4) * DM + AW + (bh & 7) * HD, gain, lam};
                dattn::dec_unit(cur, lds, fin);
            }
        } else {
            const int first = (role == 1 && slot == 2) ? 1 : 0;
            const int nblk = role == 1 ? 1 : ((role == 0 ? slot == 1 : slot == 0) ? 2 : 0);
            if constexpr (DO_PROMPT) if (nblk > 0) for (int it = F.vcu; it < NB * NH * 16; it += F.G) {
                const int bh = it >> 4, s = it & 15;
                const int qa = lfirst ? 31 - s : s, qb = lfirst ? s : 31 - s;
                dattn::Blk cur = prompt_blk(F, bh, first == 0 ? qa : qb);
                dattn::attn_prime_p(cur, lds, S);
#pragma unroll 1
                for (int bp = 0; bp < nblk; ++bp) {
                    const dattn::Blk nxt = prompt_blk(F, bh, qb);
                    dattn::attn_block_p(cur, nxt, lam, gain, lds, S);
                    cur = nxt;
                }
                asm volatile("s_waitcnt vmcnt(0)" ::: "memory"); __syncthreads();
            }
        }
    }
}
__device__ __forceinline__ void feat_pass(Frame& F) {
    const int gt = F.vcu * NWAVES * 64 + F.tid, NT = F.G * NWAVES * 64;
    bf16* cat = WSP(bf16, WS_CAT);
    for (int idx = gt; idx < (MAIN / 8) * 128; idx += NT) {
        const int cg = idx & 127, rc = idx >> 7, row0 = rc * 8, b = row0 >> 12, pos0 = 16 + (row0 & 4095), c0 = cg * 8, g = c0 >> 8, w = 2 << g;
        const bf16* base = WSP(bf16, WS_PB) + ((size_t)b * SP + pos0 - 15) * 1024 + c0;
        v4u x[23];
#pragma unroll
        for (int i = 0; i < 23; ++i) x[i] = *(const GAS v4u*)(base + (size_t)i * 1024);
        const float inv = 1.f / (float)w;
        float sum[8];
#pragma unroll
        for (int j = 0; j < 8; ++j) sum[j] = 0.f;
#pragma unroll
        for (int i = 0; i < 15; ++i) if (i >= 16 - w) {
            sum[0] += bflo(x[i].x); sum[1] += bfhi(x[i].x); sum[2] += bflo(x[i].y); sum[3] += bfhi(x[i].y); sum[4] += bflo(x[i].z); sum[5] += bfhi(x[i].z); sum[6] += bflo(x[i].w); sum[7] += bfhi(x[i].w); }
#pragma unroll
        for (int r = 0; r < 8; ++r) {
            const v4u xc = x[15 + r];
            const float cur[8] = {bflo(xc.x), bfhi(xc.x), bflo(xc.y), bfhi(xc.y), bflo(xc.z), bfhi(xc.z), bflo(xc.w), bfhi(xc.w)};
            float f[8];
#pragma unroll
            for (int j = 0; j < 8; ++j) { sum[j] += cur[j]; f[j] = sum[j] * inv - cur[j]; }
            v4u o; o.x = pk2(f[0], f[1]); o.y = pk2(f[2], f[3]); o.z = pk2(f[4], f[5]); o.w = pk2(f[6], f[7]);
            *(GAS v4u*)(cat + (size_t)(row0 + r) * DM + c0) = o;
            v4u y = x[r];
            if (w == 8) y = x[8 + r]; else if (w == 4) y = x[12 + r]; else if (w == 2) y = x[14 + r];
            sum[0] -= bflo(y.x); sum[1] -= bfhi(y.x); sum[2] -= bflo(y.y); sum[3] -= bfhi(y.y); sum[4] -= bflo(y.z); sum[5] -= bfhi(y.z); sum[6] -= bflo(y.w); sum[7] -= bfhi(y.w); }
    }
    for (int idx = gt; idx < 32 * 256; idx += NT) {
        const int cq = idx & 255, j = idx >> 8, b = j >> 2, t = j & 3, c0 = cq * 4, g = c0 >> 8, w = 2 << g;
        const float* sp = inp(F, I_SPOOL) + (size_t)b * 15 * 1024 + c0; const float* pn = WSP(float, WS_PSN) + (size_t)(b * 4) * 1024 + c0;
        f32x4 x[16];
#pragma unroll
        for (int i = 0; i < 16; ++i) { const int ri = t + i; x[i] = *(const GAS f32x4*)(ri < 15 ? sp + (size_t)ri * 1024 : pn + (size_t)(ri - 15) * 1024); }
        f32x4 sum = {0.f, 0.f, 0.f, 0.f};
#pragma unroll
        for (int i = 0; i < 16; ++i) if (i >= 16 - w) { sum.x += x[i].x; sum.y += x[i].y; sum.z += x[i].z; sum.w += x[i].w; }
        const float inv = 1.f / (float)w; const f32x4 a = x[15];
        v2u o; o.x = pk2(sum.x * inv - a.x, sum.y * inv - a.y); o.y = pk2(sum.z * inv - a.z, sum.w * inv - a.w);
        *(GAS v2u*)(cat + (size_t)(ROW_SAMP + j) * DM + c0) = o;
    }
}
__device__ __forceinline__ void attn_simple_task(Frame& F, int rt, int h, float lam, LAS float* wl) {
    const int lane = F.lane; const bool samp = rt >= MAIN;
    int b, pos; const bf16* qrow;
    if (!samp) { b = rt >> 12; pos = 16 + (rt & 4095); qrow = WSP(bf16, WS_Q) + (size_t)rt * 1024 + h * HD; }
    else { const int j = rt - MAIN; b = j >> 2; pos = PAST + (j & 3); qrow = WSP(bf16, WS_QS) + (size_t)j * 1024 + h * HD; }
    wl[lane] = bf2f(qrow[lane]); wl[64 + lane] = bf2f(qrow[64 + lane]);
    LDS_WAIT(); asm volatile("" ::: "memory");
    const float slope = exp2f(-(float)(h + 1));
    const int* pt = (const int*)inp(F, I_PT) + b * NPAGE;
    float res0 = 0.f, res1 = 0.f;
#pragma unroll 1
    for (int sub = 0; sub < 2; ++sub) {
        float m = -1e30f, l = 0.f, o0 = 0.f, o1 = 0.f;
        const LAS float* qs = wl + sub * 64;
#pragma unroll 1
        for (int kb = 0; kb <= pos; kb += 64) {
            const int key = kb + lane; const bool valid = key <= pos; const int kk = valid ? key : pos;
            float s = 0.f;
            if (!samp) {
                const bf16* kr = WSP(bf16, WS_KB) + ((size_t)b * SKP + kk) * 1024 + h * HD + sub * 64;
#pragma unroll
                for (int c = 0; c < 8; ++c) { const v4u x = *(const GAS v4u*)(kr + 8 * c);
                    s += qs[8 * c] * bflo(x.x) + qs[8 * c + 1] * bfhi(x.x) + qs[8 * c + 2] * bflo(x.y) + qs[8 * c + 3] * bfhi(x.y) + qs[8 * c + 4] * bflo(x.z) + qs[8 * c + 5] * bfhi(x.z) + qs[8 * c + 6] * bflo(x.w) + qs[8 * c + 7] * bfhi(x.w); }
            } else {
                const float* kr = kk < PAST ? inp(F, I_CK) + (((size_t)pt[kk >> 7] * PAGE + (kk & 127)) * NH + h) * HD + sub * 64 : WSP(float, WS_KS) + ((size_t)b * 64 + (kk - PAST)) * 1024 + h * HD + sub * 64;
#pragma unroll
                for (int c = 0; c < 16; ++c) { const f32x4 x = *(const GAS f32x4*)(kr + 4 * c); s += qs[4 * c] * x.x + qs[4 * c + 1] * x.y + qs[4 * c + 2] * x.z + qs[4 * c + 3] * x.w; }
            }
            s = valid ? s * 0.125f - slope * (float)(pos - key) : -1e30f;
            const float mn = fmaxf(m, wave_max(s)), a = __expf(m - mn), p = valid ? __expf(s - mn) : 0.f;
            l = l * a + wave_sum(p); m = mn; o0 *= a; o1 *= a;
            const int nk = (pos - kb + 1) < 64 ? (pos - kb + 1) : 64;
#pragma unroll 4
            for (int j = 0; j < nk; ++j) { const float pj = __shfl(p, j); const int kj = kb + j;
                if (!samp) { const bf16* vr = WSP(bf16, WS_VB) + ((size_t)b * SKP + kj) * 1024 + h * HD; o0 += pj * bf2f(vr[lane]); o1 += pj * bf2f(vr[64 + lane]); }
                else { const float* vr = kj < PAST ? inp(F, I_CV) + (((size_t)pt[kj >> 7] * PAGE + (kj & 127)) * NH + h) * HD : WSP(float, WS_VS) + ((size_t)b * 64 + (kj - PAST)) * 1024 + h * HD; o0 += pj * vr[lane]; o1 += pj * vr[64 + lane]; } }
        }
        const float il = 1.f / l;
        if (sub == 0) { res0 = o0 * il; res1 = o1 * il; } else { res0 -= lam * o0 * il; res1 -= lam * o1 * il; }
    }
    const float ss = wave_sum(res0 * res0 + res1 * res1), rn = rsqrtf(ss * (1.f / HD) + EPS) * 0.8f;
    const int row = samp ? ROW_SAMP + (rt - MAIN) : rt;
    bf16* dst = WSP(bf16, WS_CAT) + (size_t)row * DM + AW + h * HD;
    dst[lane] = (bf16)f2bf(res0 * rn * inp(F, I_SUBLN)[lane]); dst[64 + lane] = (bf16)f2bf(res1 * rn * inp(F, I_SUBLN)[64 + lane]);
    LDS_WAIT(); asm volatile("" ::: "memory");
}
__device__ __forceinline__ void attn_simple_phase(Frame& F, bool do_samp, bool do_prompt) {
    const float lam = lam_get(F);
    LAS float* wl = (LAS float*)(F.lds + RING_OFF) + F.wave * 128;
    const int gw = F.vcu * NWAVES + F.wave, NGW = F.G * NWAVES;
    for (int it = gw; it < (MAIN + 32) * NH; it += NGW) {
        int rt, h;
        if (it < 32 * NH) { rt = MAIN + (it >> 3); h = it & 7; }
        else { const int k = it - 32 * NH; h = k & 7; const int r = k >> 3; rt = (r & 1) * SEQ + (SEQ - 1 - (r >> 1)); }
        if (rt >= MAIN ? do_samp : do_prompt) attn_simple_task(F, rt, h, lam, wl);
    }
}
__device__ __forceinline__ void final_norm(Frame& F, int first) {
    const int gw = F.vcu * NWAVES + F.wave, NGW = F.G * NWAVES; const unsigned lane = lane_now();
    const float* ssq = ssq_ptr(F, 2);
    for (int m = first + gw; m < MAIN + 32; m += NGW) {
        const int row = m < MAIN ? m : ROW_SAMP + (m - MAIN);
        float* y = m < MAIN ? F.out + O_YP + (size_t)m * DM : F.out + O_YS + (size_t)(m - MAIN) * DM;
        const float rs = rsqrtf(ssq[row * SSQ_PAD] * (1.f / DM) + EPS);
        GAS f32x4* yr = (GAS f32x4*)y + lane;
#pragma unroll
        for (int j = 0; j < 8; ++j) { const f32x4 gv = ((const GAS f32x4*)inp(F, I_NFIN))[lane + 64 * j]; f32x4 v = yr[64 * j]; v.x *= rs * gv.x; v.y *= rs * gv.y; v.z *= rs * gv.z; v.w *= rs * gv.w; yr[64 * j] = v; }
    }
}

struct Args { const float* in[26]; float* out; unsigned char* ws; int ph_lo, ph_hi, li, pad; };
__global__ void __launch_bounds__(NWAVES * 64, 2) hymba_fwd(Args args) {
    extern __shared__ __attribute__((aligned(16))) unsigned char lds[];
    Frame F;
    F.lds = (LAS unsigned char*)lds;
    F.MISC = (volatile LAS unsigned*)(F.lds + MISC_OFF);
    F.tid = threadIdx.x; F.lane = F.tid & 63; F.wave = __builtin_amdgcn_readfirstlane(F.tid >> 6);
    F.G = gridDim.x; { const int bx = blockIdx.x; F.vcu = (F.G % 8 == 0) ? (bx % 8) * (F.G / 8) + bx / 8 : bx; }
    F.ws = args.ws; F.out = args.out; F.ctl = (gu32*)(args.ws + WS_CTL);
    for (int u = F.tid; u < (LDS_BYTES - LDSCTL_OFF) / 4; u += NWAVES * 64) ((LAS unsigned*)(F.lds + LDSCTL_OFF))[u] = 0u;
    __syncthreads();
    if (F.tid == 0) { volatile LAS unsigned* t = (volatile LAS unsigned*)(F.lds + LDSCTL_OFF);
#pragma unroll
        for (int i = 0; i < 26; ++i) { const unsigned long long p = (unsigned long long)args.in[i]; t[2 * i] = (unsigned)p; t[2 * i + 1] = (unsigned)(p >> 32); } }
    __syncthreads();
    if (F.wave == 0) { const float lam = lam_value(F); if (F.lane == 0) F.MISC[16] = __builtin_bit_cast(unsigned, lam); }
    __syncthreads();
    XcdBarrier bar; bar.bar = (unsigned*)(F.ctl + CW_BAR); bar.x = 0; bar.st = nullptr;
    if (N_LAUNCHES == 1) bar = xcd_barrier_post((unsigned*)(F.ctl + CW_BAR), F.MISC + 8);
#define GRID_BAR() do { if (N_LAUNCHES == 1) { xcd_barrier(bar); if constexpr (((MK_REPEAT >> 13) & 1) != 0) xcd_barrier(bar); } } while (0)
    const int lo = args.ph_lo, hi = args.ph_hi;
#define IN(k) (lo <= (k) && (k) < hi)
#define BOTH(k) (IN(k) && IN((k) + 1))

#ifndef MK_REPEAT
#define MK_REPEAT 0
#endif
    constexpr int TR_W1_END = TR_D1_END + 768, TR_W2_END = TR_OUT_END, TR_W3_END = TR_W2_END, TR_W4_END = TR_W3_END, TR_W6_END = TR_GU2_END;
    static_assert(TR_W1_END <= TR_IN_END && TR_W4_END <= TR_GU2_END && TR_W6_END <= TR_END, "conversion windows");
#define REP(k) (((MK_REPEAT >> (k)) & 1) ? 2 : 1)
    if (IN(0)) { _Pragma("unroll 1") for (int rep = 0; rep < REP(0); ++rep) { p0_prologue(F); if (rep + 1 < REP(0)) __syncthreads(); } if (BOTH(0)) GRID_BAR(); }
    if (IN(1)) { RSwiglu r{WSP(bf16, WS_ACT), nullptr}; run_gemm<RSwiglu, 1>(F, WSP(bf16, WS_XA), WSP(bf16, WS_WGU1), 2 * FF, DM, r, nullptr, F.G / 2); tr_window(F, TR_GU1_END, TR_W1_END, F.G / 2); if (BOTH(1)) GRID_BAR(); }
    if (IN(2)) { RResid r{&F, 0, 0.5f}; run_gemm<RResid, 2>(F, WSP(bf16, WS_ACT), WSP(bf16, WS_WD1), DM, FF, r, ssq_ptr(F, 0), 0); tr_window(F, TR_W1_END, TR_W2_END, 32); if (BOTH(2)) GRID_BAR(); }
    if (IN(3)) { RProj r{&F}; run_gemm<RProj, 3>(F, WSP(bf16, WS_XA), WSP(bf16, WS_WIN), NQKV, DM, r, nullptr, 0); tr_window(F, TR_W2_END, TR_W3_END, 64); if (BOTH(3)) GRID_BAR(); }
    if (IN(4)) { _Pragma("unroll 1") for (int rep = 0; rep < REP(4); ++rep) { feat_pass(F);
        if constexpr (MK_FAST_ATTN == 1) attn_fast_phase<true, true>(F);
        else if constexpr (MK_FAST_ATTN == 2) { attn_fast_phase<false, true>(F); attn_simple_phase(F, true, false); }
        else if constexpr (MK_FAST_ATTN == 3) { attn_fast_phase<true, false>(F); attn_simple_phase(F, false, true); }
        else attn_simple_phase(F, true, true); }
        tr_window(F, TR_W3_END, TR_W4_END, 0);
        if (BOTH(4)) GRID_BAR(); }
    if (IN(6)) { RResid r{&F, 1, 1.f}; run_gemm<RResid, 6>(F, WSP(bf16, WS_CAT), WSP(bf16, WS_WOUT), DM, DM, r, ssq_ptr(F, 1), 0); tr_window(F, TR_W4_END, TR_W6_END, 32); if (BOTH(6)) GRID_BAR(); }
    if (IN(7)) { RSwiglu r{WSP(bf16, WS_ACT), ssq_ptr(F, 1)}; run_gemm<RSwiglu, 7>(F, WSP(bf16, WS_XA), WSP(bf16, WS_WGU2), 2 * FF, DM, r, nullptr, F.G / 2); tr_window(F, TR_W6_END, TR_END, F.G / 2); if (BOTH(7)) GRID_BAR(); }
    const bool fuse_final = FAST_GEMM && F.G == 256 && ((MK_REPEAT >> 8) & 1) == 0;
    if (IN(8)) { RResid r{&F, 2, 0.5f};
        if (fuse_final) { run_gemm_final_main(F, WSP(bf16, WS_ACT), WSP(bf16, WS_WD2)); run_gemm<RResid, 8>(F, WSP(bf16, WS_ACT), WSP(bf16, WS_WD2), DM, FF, r, ssq_ptr(F, 2), 0, true, true); }
        else run_gemm<RResid, 8>(F, WSP(bf16, WS_ACT), WSP(bf16, WS_WD2), DM, FF, r, ssq_ptr(F, 2), 0);
        if (BOTH(8) && !fuse_final) GRID_BAR(); }
    if (IN(9) && !fuse_final) { final_norm(F, 0); }
#undef IN
#undef BOTH
}

extern "C" void kernel_launch(void* const* d_in, const int* in_sizes, int n_in, void* d_out, int out_size, void* d_ws, size_t ws_size, hipStream_t stream) {
    static int grid = 0;
    if (grid == 0) {
        if (n_in != 26 || (size_t)out_size != O_END || ws_size < WS_END) { fprintf(stderr, "kernel_launch: unexpected shapes (n_in %d, out %d, ws %zu); nothing launched\n", n_in, out_size, ws_size); grid = -1; return; }
        int dev = 0, cus = 0, per_cu = 0;
        if (hipGetDevice(&dev) != hipSuccess || hipDeviceGetAttribute(&cus, hipDeviceAttributeMultiprocessorCount, dev) != hipSuccess) { grid = -1; return; }
        if (hipFuncSetAttribute((const void*)hymba_fwd, hipFuncAttributeMaxDynamicSharedMemorySize, LDS_BYTES) != hipSuccess) { fprintf(stderr, "kernel_launch: hipFuncSetAttribute failed\n"); grid = -1; return; }
        if (hipOccupancyMaxActiveBlocksPerMultiprocessor(&per_cu, (const void*)hymba_fwd, NWAVES * 64, LDS_BYTES) != hipSuccess || per_cu < 1) { fprintf(stderr, "kernel_launch: occupancy query says %d blocks per CU\n", per_cu); }
        (void)hipGetLastError();
        grid = cus;
#if defined(MK_FORCE_GRID)
        grid = MK_FORCE_GRID;
#endif
    }
    if (grid < 0) return;
    if (hipMemsetAsync((char*)d_ws + WS_CTL, 0, CTL_ZERO_BYTES, stream) != hipSuccess) return;
    Args a{};
    for (int i = 0; i < 26; ++i) a.in[i] = (const float*)d_in[i];
    a.out = (float*)d_out; a.ws = (unsigned char*)d_ws;
    for (int li = 0; li < N_LAUNCHES; ++li) {
        a.ph_lo = (N_LAUNCHES == 1) ? 0 : li; a.ph_hi = (N_LAUNCHES == 1) ? NPH : li + 1; a.li = li; a.pad = 0;
        hipLaunchKernelGGL(hymba_fwd, dim3(grid), dim3(NWAVES * 64), LDS_BYTES, stream, a);
        if (hipPeekAtLastError() != hipSuccess) { fprintf(stderr, "kernel_launch: launch %d failed\n", li); break; }
#if defined(MK_DUP_PHASE)
        if (N_LAUNCHES == NPH && li == MK_DUP_PHASE) {
            if (li == 2) hipMemsetAsync((char*)d_ws + WS_SSQ, 0, (size_t)MROWS * SSQ_PAD * 4, stream);
            if (li == 8) { hipMemsetAsync((char*)d_ws + WS_SSQ + (size_t)2 * MROWS * SSQ_PAD * 4, 0, (size_t)MROWS * SSQ_PAD * 4, stream); hipMemsetAsync((char*)d_ws + WS_CTL + (size_t)CW_PCNT * 4, 0, 64 * 32 * 4, stream); }
            hipLaunchKernelGGL(hymba_fwd, dim3(grid), dim3(NWAVES * 64), LDS_BYTES, stream, a);
        }
#endif
    }
}
```
